# Optimizing an MI355X kernel written in HIP

```python
import math
import jax, jax.numpy as jnp
from jax import lax
import numpy as np

D_MODEL = 1024
BATCH = 8
SEQ = 2048
DEPTH = 4

CHUNK = 64
N_EVEN = (DEPTH + 1) // 2
N_ODD = DEPTH // 2
EPS = 1e-6

RET_HEADS = 4
RET_DK = D_MODEL // 8
RET_DV = 2 * RET_DK
ROPE_BASE = 10000.0
A_QK = RET_HEADS * RET_DK
A_V = RET_HEADS * RET_DV

SG_GROUPS = 4
SG_CH = D_MODEL // 8
SG_WIDTH = SG_GROUPS * SG_CH
SG_LEN = 128

EVEN_IN = 2 * A_QK + 2 * A_V + 2 * SG_WIDTH
EVEN_MIX = A_V + SG_WIDTH

ATT_HEADS = 16
ATT_DH = D_MODEL // ATT_HEADS
BAND_CHUNKS = 9
BAND_LEN = BAND_CHUNKS * CHUNK
MAX_REL = 256
REL_SIZE = (CHUNK - 1) + MAX_REL + 1

N_EXPERTS = 32
TOP_K = 4
D_FF = D_MODEL
SWIGLU_ALPHA = 1.702
SWIGLU_LIMIT = 7.0
MOE_BLOCK = 128

kernel_name = "hybrid_retention_gmlp_bandattn_moe"


def rms_norm(x, g):
    x32 = x.astype(jnp.float32)
    y = x32 * lax.rsqrt(jnp.mean(jnp.square(x32), axis=-1, keepdims=True) + EPS)
    return (y * g.astype(jnp.float32)).astype(x.dtype)


def layer_norm(x, g, b):
    x32 = x.astype(jnp.float32)
    mu = jnp.mean(x32, axis=-1, keepdims=True)
    var = jnp.mean(jnp.square(x32 - mu), axis=-1, keepdims=True)
    y = (x32 - mu) * lax.rsqrt(var + EPS)
    return (y * g.astype(jnp.float32) + b.astype(jnp.float32)).astype(x.dtype)


def head_group_norm(x):
    x32 = x.astype(jnp.float32)
    mu = jnp.mean(x32, axis=-1, keepdims=True)
    var = jnp.mean(jnp.square(x32 - mu), axis=-1, keepdims=True)
    return ((x32 - mu) * lax.rsqrt(var + EPS)).astype(x.dtype)


def rotary(x, pos):
    half = x.shape[-1] // 2
    inv = ROPE_BASE ** (-jnp.arange(half, dtype=jnp.float32) / half)
    ang = pos[:, None] * inv[None, :]
    cos = jnp.cos(ang)[None, :, None, :].astype(x.dtype)
    sin = jnp.sin(ang)[None, :, None, :].astype(x.dtype)
    x1, x2 = x[..., :half], x[..., half:]
    return jnp.concatenate([x1 * cos - x2 * sin, x1 * sin + x2 * cos], axis=-1)


def retention(q, k, v):
    B_, S_, H, dk = q.shape
    dv = v.shape[-1]
    dt = q.dtype
    nC = S_ // CHUNK
    log_g = jnp.log1p(-jnp.exp2(-5.0 - jnp.arange(H, dtype=jnp.float32)))
    idx = jnp.arange(CHUNK, dtype=jnp.float32)
    intra_decay = jnp.exp(log_g[:, None, None] * jnp.abs(idx[:, None] - idx[None, :]))
    q_decay = jnp.exp(log_g[:, None] * (idx[None, :] + 1.0))
    k_decay = jnp.exp(log_g[:, None] * (CHUNK - 1.0 - idx[None, :]))
    chunk_decay = jnp.exp(log_g * CHUNK).astype(dt)

    qc = q.reshape(B_, nC, CHUNK, H, dk)
    kc = k.reshape(B_, nC, CHUNK, H, dk) * (dk ** -0.5)
    vc = v.reshape(B_, nC, CHUNK, H, dv)

    s = jnp.einsum('bnqhd,bnkhd->bhnqk', qc, kc) * intra_decay[:, None].astype(dt)
    intra = jnp.einsum('bhnqk,bnkhe->bnqhe', s, vc)

    kv = jnp.einsum('bnkhd,bnkhe->nbhde',
                    kc * k_decay.T[None, None, :, :, None].astype(dt), vc)

    def step(state, kv_n):
        return state * chunk_decay[None, :, None, None] + kv_n, state

    _, states = lax.scan(step, jnp.zeros((B_, H, dk, dv), dt), kv)
    inter = jnp.einsum('bnqhd,nbhde->bnqhe',
                       qc * q_decay.T[None, None, :, :, None].astype(dt), states)
    return (intra + inter).reshape(B_, S_, H, dv)


def spatial_gate(u, z, ln_g, ln_b, w_s, b_s):
    B_, S_, _ = z.shape
    z = layer_norm(z, ln_g, ln_b)
    nP = S_ // SG_LEN
    cpos = jnp.arange(SG_LEN) // CHUNK
    mask = cpos[:, None] >= cpos[None, :]
    w = jnp.where(mask[None], w_s, jnp.zeros((), w_s.dtype))
    zb = z.reshape(B_, nP, SG_LEN, SG_GROUPS, SG_CH)
    mixed = jnp.einsum('gij,bnjgc->bnigc', w, zb) + b_s.T[None, None, :, :, None]
    return u * mixed.reshape(B_, S_, SG_WIDTH)


def even_mixer(h, w_in, w_out, sg_ln_g, sg_ln_b, sg_w, sg_b):
    B_, S_, _ = h.shape
    proj = h @ w_in
    o1 = A_QK
    o2 = o1 + A_QK
    o3 = o2 + A_V
    o4 = o3 + A_V
    o5 = o4 + SG_WIDTH
    q, k, v, gate, u, z = jnp.split(proj, [o1, o2, o3, o4, o5], axis=-1)
    pos = jnp.arange(S_, dtype=jnp.float32)
    q = rotary(q.reshape(B_, S_, RET_HEADS, RET_DK), pos)
    k = rotary(k.reshape(B_, S_, RET_HEADS, RET_DK), pos)
    v = v.reshape(B_, S_, RET_HEADS, RET_DV)
    ret = head_group_norm(retention(q, k, v)).reshape(B_, S_, A_V)
    a_out = jax.nn.silu(gate) * ret
    b_out = spatial_gate(jax.nn.gelu(u), jax.nn.gelu(z), sg_ln_g, sg_ln_b, sg_w, sg_b)
    return jnp.concatenate([a_out, b_out], axis=-1) @ w_out


def band_attention(q, k, v, q_g, k_g, rel_bias):
    B_, S_, H, Dh = q.shape
    nC = S_ // CHUNK
    pad = (BAND_CHUNKS - 1) * CHUNK
    q = rms_norm(q, q_g)
    k = rms_norm(k, k_g)
    kpad = jnp.pad(k, ((0, 0), (pad, 0), (0, 0), (0, 0)))
    vpad = jnp.pad(v, ((0, 0), (pad, 0), (0, 0), (0, 0)))
    qc = jnp.transpose(q.reshape(B_, nC, CHUNK, H, Dh), (1, 0, 2, 3, 4))

    kpos = jnp.arange(BAND_LEN) - pad
    rel = jnp.arange(CHUNK)[:, None] - kpos[None, :]
    rel_idx = jnp.clip(rel, -(CHUNK - 1), MAX_REL) + (CHUNK - 1)
    bias = rel_bias[:, rel_idx].astype(jnp.float32)
    scale = Dh ** -0.5

    def one_chunk(args):
        n, qn = args
        start = n * CHUNK
        kb = lax.dynamic_slice_in_dim(kpad, start, BAND_LEN, axis=1)
        vb = lax.dynamic_slice_in_dim(vpad, start, BAND_LEN, axis=1)
        s = jnp.einsum('bqhd,bkhd->bhqk', qn, kb).astype(jnp.float32) * scale + bias[None]
        valid = (start + jnp.arange(BAND_LEN)) >= pad
        s = jnp.where(valid[None, None, None, :], s, -1e30)
        p = jax.nn.softmax(s, axis=-1).astype(vb.dtype)
        return jnp.einsum('bhqk,bkhd->bqhd', p, vb)

    o = lax.map(one_chunk, (jnp.arange(nC), qc))
    return jnp.transpose(o, (1, 0, 2, 3, 4)).reshape(B_, S_, H * Dh)


def odd_mixer(h, w_in, w_out, q_g, k_g, rel_bias):
    B_, S_, _ = h.shape
    q, k, v = jnp.split(h @ w_in, 3, axis=-1)
    shp = (B_, S_, ATT_HEADS, ATT_DH)
    o = band_attention(q.reshape(shp), k.reshape(shp), v.reshape(shp), q_g, k_g, rel_bias)
    return o @ w_out


def moe(h, router_w, router_b, w1, b1, w2, b2):
    B_, S_, D = h.shape
    T = B_ * S_
    xt = h.reshape(T, D)
    logits = xt.astype(jnp.float32) @ router_w.astype(jnp.float32) + router_b.astype(jnp.float32)
    top_vals, top_idx = lax.top_k(logits, TOP_K)
    gates = jax.nn.softmax(top_vals, axis=-1)

    n_assign = T * TOP_K
    flat_e = top_idx.reshape(-1)
    flat_tok = jnp.arange(n_assign, dtype=jnp.int32) // TOP_K
    flat_gate = gates.reshape(-1)
    order = jnp.argsort(flat_e)
    sorted_e = flat_e[order]
    counts = jnp.zeros((N_EXPERTS,), jnp.int32).at[flat_e].add(1)
    padded = ((counts + MOE_BLOCK - 1) // MOE_BLOCK) * MOE_BLOCK
    starts = jnp.cumsum(counts) - counts
    pends = jnp.cumsum(padded)
    pstarts = pends - padded
    dest = pstarts[sorted_e] + (jnp.arange(n_assign, dtype=jnp.int32) - starts[sorted_e])

    cap = ((n_assign + MOE_BLOCK - 1) // MOE_BLOCK) * MOE_BLOCK + N_EXPERTS * MOE_BLOCK
    n_blocks = cap // MOE_BLOCK
    row_tok = jnp.zeros((cap,), jnp.int32).at[dest].set(flat_tok[order])
    row_gate = jnp.zeros((cap,), jnp.float32).at[dest].set(flat_gate[order])
    block_start = jnp.arange(n_blocks, dtype=jnp.int32) * MOE_BLOCK
    block_e = jnp.minimum(jnp.searchsorted(pends, block_start, side='right'), N_EXPERTS - 1)
    xs = xt[row_tok].reshape(n_blocks, MOE_BLOCK, D)

    def expert_block(args):
        e, xb = args
        hid = xb @ w1[e] + b1[e]
        x_glu = jnp.minimum(hid[:, :D_FF], SWIGLU_LIMIT)
        x_lin = jnp.clip(hid[:, D_FF:], -SWIGLU_LIMIT, SWIGLU_LIMIT)
        act = x_glu * jax.nn.sigmoid(SWIGLU_ALPHA * x_glu) * (x_lin + 1.0)
        return act @ w2[e] + b2[e]

    ys = lax.map(expert_block, (block_e, xs)).reshape(cap, D)
    y = jnp.zeros((T, D), ys.dtype).at[row_tok].add(ys * row_gate[:, None].astype(ys.dtype))
    return y.reshape(B_, S_, D).astype(h.dtype)


def setup_inputs(seed: int = 0) -> dict:
    key = jax.random.key(seed)
    ks = jax.random.split(key, 24)

    def nrm(k, shape, scale):
        return jax.random.normal(k, shape, jnp.float32) * scale

    return {
        "x": nrm(ks[0], (BATCH, SEQ, D_MODEL), 1.0),
        "c": nrm(ks[1], (BATCH, D_MODEL), 1.0),
        "ada_w": nrm(ks[2], (DEPTH, D_MODEL, 6 * D_MODEL), 0.5 * D_MODEL ** -0.5),
        "ada_b": nrm(ks[3], (DEPTH, 6 * D_MODEL), 0.02),
        "norm_mix_g": 1.0 + nrm(ks[4], (DEPTH, D_MODEL), 0.02),
        "norm_ffn_g": 1.0 + nrm(ks[5], (DEPTH, D_MODEL), 0.02),
        "ev_w_in": nrm(ks[6], (N_EVEN, D_MODEL, EVEN_IN), D_MODEL ** -0.5),
        "ev_w_out": nrm(ks[7], (N_EVEN, EVEN_MIX, D_MODEL), EVEN_MIX ** -0.5),
        "sg_ln_g": 1.0 + nrm(ks[8], (N_EVEN, SG_WIDTH), 0.02),
        "sg_ln_b": nrm(ks[9], (N_EVEN, SG_WIDTH), 0.02),
        "sg_w": nrm(ks[10], (N_EVEN, SG_GROUPS, SG_LEN, SG_LEN), SG_LEN ** -0.5),
        "sg_b": 1.0 + nrm(ks[11], (N_EVEN, SG_GROUPS, SG_LEN), 0.02),
        "od_w_in": nrm(ks[12], (N_ODD, D_MODEL, 3 * D_MODEL), D_MODEL ** -0.5),
        "od_w_out": nrm(ks[13], (N_ODD, D_MODEL, D_MODEL), D_MODEL ** -0.5),
        "od_q_g": 1.0 + nrm(ks[14], (N_ODD, ATT_DH), 0.02),
        "od_k_g": 1.0 + nrm(ks[15], (N_ODD, ATT_DH), 0.02),
        "od_rel_bias": nrm(ks[16], (N_ODD, ATT_HEADS, REL_SIZE), 0.2),
        "moe_router_w": nrm(ks[17], (DEPTH, D_MODEL, N_EXPERTS), D_MODEL ** -0.5),
        "moe_router_b": nrm(ks[18], (DEPTH, N_EXPERTS), 0.01),
        "moe_w1": nrm(ks[19], (DEPTH, N_EXPERTS, D_MODEL, 2 * D_FF), D_MODEL ** -0.5),
        "moe_b1": nrm(ks[20], (DEPTH, N_EXPERTS, 2 * D_FF), 0.01),
        "moe_w2": nrm(ks[21], (DEPTH, N_EXPERTS, D_FF, D_MODEL), D_FF ** -0.5),
        "moe_b2": nrm(ks[22], (DEPTH, N_EXPERTS, D_MODEL), 0.01),
    }


def reference(x, c, ada_w, ada_b, norm_mix_g, norm_ffn_g, ev_w_in, ev_w_out,
              sg_ln_g, sg_ln_b, sg_w, sg_b, od_w_in, od_w_out, od_q_g, od_k_g,
              od_rel_bias, moe_router_w, moe_router_b, moe_w1, moe_b1, moe_w2, moe_b2):
    c_act = jax.nn.silu(c)
    for l in range(DEPTH):
        mod = c_act @ ada_w[l] + ada_b[l]
        sh1, sc1, g1, sh2, sc2, g2 = jnp.split(mod, 6, axis=-1)
        h = rms_norm(x, norm_mix_g[l]) * (1.0 + sc1[:, None]) + sh1[:, None]
        i = l // 2
        if l % 2 == 0:
            mix = even_mixer(h, ev_w_in[i], ev_w_out[i], sg_ln_g[i], sg_ln_b[i], sg_w[i], sg_b[i])
        else:
            mix = odd_mixer(h, od_w_in[i], od_w_out[i], od_q_g[i], od_k_g[i], od_rel_bias[i])
        x = x + g1[:, None] * mix
        h = rms_norm(x, norm_ffn_g[l]) * (1.0 + sc2[:, None]) + sh2[:, None]
        x = x + g2[:, None] * moe(h, moe_router_w[l], moe_router_b[l], moe_w1[l], moe_b1[l],
                                  moe_w2[l], moe_b2[l])
    return x
```

```cpp
#include <hip/hip_runtime.h>
#include <stdint.h>
#include <stdio.h>

typedef unsigned short bf16;

constexpr int NB = 8, SEQ = 2048, DM = 1024, T_TOK = NB * SEQ, DEPTH = 4;
constexpr int CHUNK = 64, NCH = SEQ / CHUNK;
constexpr int EVEN_IN = 4096, EVEN_MIX = 1536;
constexpr int NEXP = 32, TOPK = 4, DFF = 1024;
constexpr int CAP = T_TOK * TOPK + NEXP * 256;
constexpr float EPS = 1e-6f;

constexpr size_t MiB = 1u << 20;
constexpr size_t WS_CTL = 0;
constexpr size_t WS_MOD = 1 * MiB;
constexpr size_t WS_COS = 2 * MiB;
constexpr size_t WS_SIN = 3 * MiB;
constexpr size_t WS_H = 4 * MiB;
constexpr size_t WS_PROJ = 36 * MiB;
constexpr size_t WS_MIX = 164 * MiB;
constexpr size_t WS_TOPI = 212 * MiB;
constexpr size_t WS_TOPG = 213 * MiB;
constexpr size_t WS_POS = 214 * MiB;
constexpr size_t WS_ROWSLOT = 215 * MiB;
constexpr size_t WS_ROWGATE = 216 * MiB;
constexpr size_t WS_H8 = 220 * MiB;
constexpr size_t WS_WEVIN8 = 240 * MiB;
constexpr size_t WS_XS = 260 * MiB;
constexpr size_t WS_ACT = 364 * MiB;
constexpr size_t WS_YS = 508 * MiB;
constexpr size_t WS_KV = 636 * MiB;
constexpr size_t WS_ST = 772 * MiB;
constexpr size_t WS_XB = 960 * MiB;
constexpr size_t WS_RSLOT = 900 * MiB, WS_RGATE = 904 * MiB;
constexpr int EREG = 16384;
constexpr size_t WS_WEVIN = 2500 * MiB, WS_WEVOUT = 2516 * MiB, WS_WODIN = 2524 * MiB, WS_WODOUT = 2540 * MiB, WS_W1 = 2560 * MiB, WS_W2 = 3072 * MiB;
constexpr int CW_COUNTS = 64;
constexpr int CW_BAR = 4096;
constexpr size_t CTL_ZERO_BYTES = 64 * 1024;

__device__ __forceinline__ int opaque_tid() { int t = threadIdx.x; asm volatile("" : "+v"(t)); return t; }
__device__ __forceinline__ float bf2f(bf16 v) { return __uint_as_float(((unsigned)v) << 16); }
template <int M> __device__ __forceinline__ float xshfl(float v) { return __int_as_float(__builtin_amdgcn_ds_swizzle(__float_as_int(v), (M << 10) | 0x1f)); }
template <int M> __device__ __forceinline__ int xshfl_i(int v) { return __builtin_amdgcn_ds_swizzle(v, (M << 10) | 0x1f); }
__device__ __forceinline__ float sum_halves(float v) { const auto r = __builtin_amdgcn_permlane32_swap(__float_as_uint(v), __float_as_uint(v), false, false); return __uint_as_float(r[0]) + __uint_as_float(r[1]); }
__device__ __forceinline__ float max_halves(float v) { const auto r = __builtin_amdgcn_permlane32_swap(__float_as_uint(v), __float_as_uint(v), false, false); return fmaxf(__uint_as_float(r[0]), __uint_as_float(r[1])); }
__device__ __forceinline__ float wave_sum(float v) { v += xshfl<1>(v); v += xshfl<2>(v); v += xshfl<4>(v); v += xshfl<8>(v); v += xshfl<16>(v); return sum_halves(v); }
#define LAS __attribute__((address_space(3)))
namespace pg8 {
#define PG8_LAS __attribute__((address_space(3)))
typedef unsigned short bf16_t;
typedef short bf16x8 __attribute__((ext_vector_type(8)));
typedef float f32x4 __attribute__((ext_vector_type(4)));
typedef unsigned u32x4 __attribute__((ext_vector_type(4)));
constexpr int BM = 256, BK = 64, HALF = 128, HTB = HALF * BK * 2  , STAGE_BYTES = 8 * HTB, NXCD = 8, WGM = 8;
__host__ __device__ __forceinline__ int lds_byte(int r, int c) { const int st = (r >> 4) * 2 + (c >> 5), rr = r & 15, cc = c & 31, ob = rr * 64 + cc * 2; return st * 1024 + (ob ^ (((ob >> 9) & 1) << 5)); }
__host__ __device__ __forceinline__ void stage_rc(int b, int& R, int& C) { const int st = b / 1024, sb = b % 1024, swz = sb ^ (((sb >> 9) & 1) << 5); R = (st >> 1) * 16 + swz / 64; C = (st & 1) * 32 + (swz % 64) / 2; }
__host__ __device__ __forceinline__ int perm32(int rho) { const int n = rho >> 4, i = rho & 15; return 8 * (i >> 2) + 4 * n + (i & 3); }
__device__ __forceinline__ unsigned stage_voff(int i, int K) { const int t = opaque_tid(); int R, C; stage_rc(t * 16 + i * 8192, R, C); return (unsigned)(R * K + C) * 2u; }
__device__ __forceinline__ unsigned rc2vo(unsigned rc, int K) { return (rc >> 16) * (unsigned)(K * 2) + (rc & 0xffffu); }
struct Unit { int pm, pn; };
struct Gemm { const bf16_t* A; const bf16_t* Bt; int M, N, K, pad; const PG8_LAS unsigned short* gath; };
struct StaticOrder {
    int nM, nN, nwg, G, c;
    __host__ __device__ void init(int M, int N, int G_, int c_) { nM = M / BM; nN = N / BM; nwg = nM * nN; G = G_; c = c_; }
    __host__ __device__ bool next(int i, Unit& u) const {
        const long L = (long)i * G + c; if (L >= nwg) return false;
        int wgid = (int)L; { const int q = nwg / NXCD, r = nwg % NXCD, xcd = wgid % NXCD, off = wgid / NXCD; wgid = (xcd < r ? xcd * (q + 1) : r * (q + 1) + (xcd - r) * q) + off; }
        const int nig = WGM * nN, gid = wgid / nig, fm = gid * WGM, gsz = (nM - fm) < WGM ? (nM - fm) : WGM;
        u.pm = fm + ((wgid % nig) % gsz); u.pn = (wgid % nig) / gsz; return true;
    }
    __device__ __forceinline__ void a_ready(const Unit&) const {}
    __device__ __forceinline__ void done(const Unit&) const {}
};
struct MoeOrder {
    const PG8_LAS int* tab;
    __device__ __forceinline__ bool next(int i, Unit& u) const {
        if (i >= __builtin_amdgcn_readfirstlane(tab[192])) return false;
        u.pm = __builtin_amdgcn_readfirstlane(tab[194 + 2 * i]); u.pn = __builtin_amdgcn_readfirstlane(tab[195 + 2 * i]); return true;
    }
    __device__ __forceinline__ void a_ready(const Unit&) const {}
    __device__ __forceinline__ void done(const Unit&) const {}
};
typedef __bf16 bf16x2_t __attribute__((ext_vector_type(2)));
typedef float f32x2_t __attribute__((ext_vector_type(2)));
__device__ __forceinline__ unsigned cvt_pk_bf16(float lo, float hi) { const f32x2_t v = {lo, hi}; const bf16x2_t b = __builtin_convertvector(v, bf16x2_t); return __builtin_bit_cast(unsigned, b); }
typedef int i32x4_t __attribute__((ext_vector_type(4)));
typedef int i32x8_t __attribute__((ext_vector_type(8)));
__device__ __forceinline__ i32x8_t cat8(const bf16x8 a, const bf16x8 b) { return __builtin_shufflevector((i32x4_t)a, (i32x4_t)b, 0, 1, 2, 3, 4, 5, 6, 7); }
__device__ __forceinline__ unsigned pk4_fp8(float a, float b, float c, float d) { int w = 0; w = __builtin_amdgcn_cvt_pk_fp8_f32(a, b, w, false); w = __builtin_amdgcn_cvt_pk_fp8_f32(c, d, w, true); return (unsigned)w; }
__device__ __forceinline__ u32x4 pack8(const f32x4 a, const f32x4 b) { u32x4 w; w.x = cvt_pk_bf16(a[0], a[1]); w.y = cvt_pk_bf16(a[2], a[3]); w.z = cvt_pk_bf16(b[0], b[1]); w.w = cvt_pk_bf16(b[2], b[3]); return w; }
template <class Epi, class Sched, bool ALIGN_EPI = false, bool SP2 = false, bool FP8 = false, bool GATHER = false>
__device__ __forceinline__ void gemm_phase(PG8_LAS unsigned char* lds, const Gemm g, const Sched& S, const Epi& E) {
    const int tid = opaque_tid(), wid = __builtin_amdgcn_readfirstlane(tid >> 6), lane = tid & 63, wr = wid >> 2, wc = wid & 3, fr = lane & 15, fq = lane >> 4;
    const int K = g.K, nt = K / BK;
    unsigned voffA[2], voffB[2];
#pragma unroll
    for (int i = 0; i < 2; ++i) { int R, C; stage_rc(tid * 16 + i * 8192, R, C); const int Rb = Epi::PERM ? ((R & ~31) + perm32(R & 31)) : R;
        voffA[i] = (unsigned)(R * K + C) * 2u; voffB[i] = (unsigned)(Rb * K + C) * 2u; }
    const size_t kstep = (size_t)(BK * 2);
    const size_t hstep = (size_t)HALF * K * 2;
    const size_t tstep = 2 * hstep;
    const unsigned ldsw = (unsigned)wid * 1024u;
    const int aoff = lds_byte(wr * 64 + fr, fq * 8), boff = lds_byte(wc * 32 + fr, fq * 8);
#define PG8_SA(b, h) (((b) * 2 + (h)) * HTB)
#define PG8_SB(b, h) ((4 + (b) * 2 + (h)) * HTB)
    const __amdgpu_buffer_rsrc_t rsA = __builtin_amdgcn_make_buffer_rsrc((void*)g.A, 0, -1, 0x00020000);
    const unsigned relB = (unsigned)(size_t)((const char*)g.Bt - (const char*)g.A);
#define rsB rsA
    PG8_LAS unsigned* voT = (PG8_LAS unsigned*)(lds + 141312);
    if constexpr (FP8) {
#pragma unroll
        for (int i = 0; i < 2; ++i) { int R, C; stage_rc(tid * 16 + i * 8192, R, C); voT[i * 512 + tid] = ((unsigned)R << 16) | (unsigned)(C * 2); } }
#define PG8_DMA(rs, bufoff, ptr, vo, i) __builtin_amdgcn_raw_ptr_buffer_load_lds(rs, (PG8_LAS void*)(lds + (bufoff) + ldsw + (i) * 8192), 16, (vo), (unsigned)(size_t)(ptr), 0, 0)
#define PG8_VO(arr, i) (FP8 ? rc2vo(voT[(i) * 512 + opaque_tid()], K) : (arr)[i])
#define PG8_STAGE_B(bufoff, ptr) do { _Pragma("unroll") for (int _i = 0; _i < 2; ++_i) PG8_DMA(rsA, bufoff, (ptr) + relB, PG8_VO(voffB, _i), _i); } while (0)
#define PG8_STAGE_A0(bufoff, ptr) do { _Pragma("unroll") for (int _i = 0; _i < 2; ++_i) PG8_DMA(rsA, bufoff, ptr, PG8_VO(voffA, _i), _i); } while (0)
#define PG8_STAGE_A(bufoff, ptr, half, slot) do { if constexpr (GATHER) { _Pragma("unroll") for (int _i = 0; _i < 2; ++_i) { \
        const unsigned rc_ = voT[_i * 512 + opaque_tid()]; const unsigned vo_ = (unsigned)g.gath[(slot) * 256 + (half) * 128 + (rc_ >> 16)] * (unsigned)(K * 2) + (rc_ & 0xffffu); PG8_DMA(rsA, bufoff, ptr, vo_, _i); } } \
        else { PG8_STAGE_A0(bufoff, (ptr) + (half) * hstep); } } while (0)
#define PG8_LDA(dst, b, h) do { _Pragma("unroll") for (int m = 0; m < 4; ++m) _Pragma("unroll") for (int k = 0; k < 2; ++k) dst[m][k] = *(const PG8_LAS bf16x8*)(lds + PG8_SA(b, h) + aoff + m * 2048 + k * 1024); } while (0)
#define PG8_LDB(dst, b, h) do { _Pragma("unroll") for (int n = 0; n < 2; ++n) _Pragma("unroll") for (int k = 0; k < 2; ++k) dst[n][k] = *(const PG8_LAS bf16x8*)(lds + PG8_SB(b, h) + boff + n * 2048 + k * 1024); } while (0)
#define PG8_MMA(ai, bj, At, Bt) do { __builtin_amdgcn_s_setprio(1); _Pragma("unroll") for (int m = 0; m < 4; ++m) _Pragma("unroll") for (int n = 0; n < 2; ++n) { \
        if constexpr (FP8) { acc[ai][bj][m][n] = __builtin_amdgcn_mfma_scale_f32_16x16x128_f8f6f4(cat8(Bt[n][0], Bt[n][1]), cat8(At[m][0], At[m][1]), acc[ai][bj][m][n], 0, 0, 0, 0, 0, 0); } \
        else { _Pragma("unroll") for (int k = 0; k < 2; ++k) acc[ai][bj][m][n] = __builtin_amdgcn_mfma_f32_16x16x32_bf16(Bt[n][k], At[m][k], acc[ai][bj][m][n], 0, 0, 0); } } \
        __builtin_amdgcn_s_setprio(0); } while (0)
#define PG8_WAIT_V(n) asm volatile("s_waitcnt vmcnt(" #n ")" ::: "memory")
#define PG8_WAIT_L(n) asm volatile("s_waitcnt lgkmcnt(" #n ")" ::: "memory")
#define PG8_BAR __builtin_amdgcn_s_barrier()
#define PG8_SCHED __builtin_amdgcn_sched_barrier(0)

#define PG8_PIN_ACC() do { \
        asm volatile("" : "+v"(acc[0][0][0][0]), "+v"(acc[0][0][0][1]), "+v"(acc[0][0][1][0]), "+v"(acc[0][0][1][1]), "+v"(acc[0][0][2][0]), "+v"(acc[0][0][2][1]), "+v"(acc[0][0][3][0]), "+v"(acc[0][0][3][1]), \
                          "+v"(acc[0][1][0][0]), "+v"(acc[0][1][0][1]), "+v"(acc[0][1][1][0]), "+v"(acc[0][1][1][1]), "+v"(acc[0][1][2][0]), "+v"(acc[0][1][2][1]), "+v"(acc[0][1][3][0]), "+v"(acc[0][1][3][1])); \
        asm volatile("" : "+v"(acc[1][0][0][0]), "+v"(acc[1][0][0][1]), "+v"(acc[1][0][1][0]), "+v"(acc[1][0][1][1]), "+v"(acc[1][0][2][0]), "+v"(acc[1][0][2][1]), "+v"(acc[1][0][3][0]), "+v"(acc[1][0][3][1]), \
                          "+v"(acc[1][1][0][0]), "+v"(acc[1][1][0][1]), "+v"(acc[1][1][1][0]), "+v"(acc[1][1][1][1]), "+v"(acc[1][1][2][0]), "+v"(acc[1][1][2][1]), "+v"(acc[1][1][3][0]), "+v"(acc[1][1][3][1])); } while (0)
    Unit cur, nxt; int ui = 0;
    if (!S.next(0, cur)) return;
    f32x4 acc[2][2][4][2];
#pragma unroll
    for (int a = 0; a < 2; ++a)
#pragma unroll
        for (int b = 0; b < 2; ++b)
#pragma unroll
            for (int m = 0; m < 4; ++m)
#pragma unroll
                for (int n = 0; n < 2; ++n) acc[a][b][m][n] = (f32x4){0.f, 0.f, 0.f, 0.f};
    int pf_b = 131072, pf_s = 133120; if constexpr (Epi::PREF) pf_b = Epi::L_BIAS;
    if constexpr (Epi::PREF) { if (wr == 0) E.pref(lds, cur, pf_b, pf_s, wid, lane); PG8_WAIT_V(0); PG8_BAR; E.init_lds(acc, lds, pf_b, wc, fq); }
    else if constexpr (Epi::INIT) E.init(acc, cur, wc, fq);
    else if constexpr (FP8) PG8_PIN_ACC();
    bf16x8 At[4][2], B0[2][2], B1[2][2];
    static_assert(!GATHER || SP2, "GATHER is written for the SP2 loop");
    const char* cA = (const char*)0 + (GATHER ? (size_t)0 : (size_t)cur.pm * tstep); const char* cB = (const char*)0 + (size_t)cur.pn * tstep;
    S.a_ready(cur);
    if constexpr (SP2) {
        PG8_STAGE_B(PG8_SB(0, 0), cB); PG8_STAGE_B(PG8_SB(0, 1), cB + hstep); PG8_STAGE_A(PG8_SA(0, 0), cA, 0, 0); PG8_STAGE_A(PG8_SA(0, 1), cA, 1, 0);
        if (wr == 1) PG8_BAR;
        PG8_WAIT_V(2); PG8_BAR;
        PG8_STAGE_B(PG8_SB(1, 0), cB + kstep); PG8_STAGE_A(PG8_SA(1, 0), cA + kstep, 0, 0); PG8_STAGE_B(PG8_SB(1, 1), cB + hstep + kstep);
        PG8_WAIT_V(6); PG8_BAR;
    } else {
        PG8_STAGE_B(PG8_SB(0, 0), cB); PG8_STAGE_A0(PG8_SA(0, 0), cA); PG8_STAGE_B(PG8_SB(0, 1), cB + hstep); PG8_STAGE_A0(PG8_SA(0, 1), cA + hstep);
        if (wr == 1) PG8_BAR;
        PG8_WAIT_V(4); PG8_BAR;
        PG8_STAGE_B(PG8_SB(1, 0), cB + kstep); PG8_STAGE_A0(PG8_SA(1, 0), cA + kstep); PG8_STAGE_B(PG8_SB(1, 1), cB + hstep + kstep);
        PG8_WAIT_V(6); PG8_BAR;
    }
    for (;;) {
        const bool has_next = S.next(ui + 1, nxt);
        const char* nA = has_next ? (const char*)0 + (GATHER ? (size_t)0 : (size_t)nxt.pm * tstep) : cA; const char* nB = has_next ? (const char*)0 + (size_t)nxt.pn * tstep : cB;
        const int nslot = has_next ? ui + 1 : ui;
        const int pf_nb = pf_b ^ 1024, pf_ns = (pf_s == 133120 + 4096) ? 133120 : pf_s + 2048;
        if constexpr (Epi::PREF) { if (wr == 0 && has_next) E.pref(lds, nxt, pf_nb, pf_ns, wid, lane); }
        for (int t = 0; t < nt; t += 2) {
            const bool last = (t == nt - 2);
            const char* a1 = cA + (size_t)(t + 1) * kstep;
            const char* a2 = last ? nA : cA + (size_t)(t + 2) * kstep; const char* b2 = last ? nB : cB + (size_t)(t + 2) * kstep;
            const char* a3 = a2 + kstep; const char* b3 = b2 + kstep;
            if (last && has_next) S.a_ready(nxt);
            if constexpr (SP2) {
            PG8_LDB(B0, 0, 0); PG8_LDB(B1, 0, 1); PG8_SCHED; PG8_LDA(At, 0, 0); PG8_STAGE_A(PG8_SA(1, 1), a1, 1, ui);
            PG8_WAIT_V(8); PG8_WAIT_L(0); PG8_BAR;
            PG8_MMA(0, 0, At, B0); PG8_MMA(0, 1, At, B1); PG8_BAR; PG8_SCHED;
            PG8_LDA(At, 0, 1); PG8_STAGE_B(PG8_SB(0, 0), b2); PG8_STAGE_B(PG8_SB(0, 1), b2 + hstep); PG8_STAGE_A(PG8_SA(0, 0), a2, 0, (last ? nslot : ui));
            PG8_WAIT_V(8); PG8_WAIT_L(0); PG8_BAR; PG8_MMA(1, 0, At, B0); PG8_MMA(1, 1, At, B1); PG8_BAR; PG8_SCHED;
            PG8_LDB(B0, 1, 0); PG8_LDB(B1, 1, 1); PG8_SCHED; PG8_LDA(At, 1, 0); PG8_STAGE_A(PG8_SA(0, 1), a2, 1, (last ? nslot : ui));
            PG8_WAIT_V(8); PG8_WAIT_L(0); PG8_BAR; PG8_MMA(0, 0, At, B0); PG8_MMA(0, 1, At, B1); PG8_BAR; PG8_SCHED;
            PG8_LDA(At, 1, 1); PG8_STAGE_B(PG8_SB(1, 0), b3); PG8_STAGE_B(PG8_SB(1, 1), b3 + hstep); PG8_STAGE_A(PG8_SA(1, 0), a3, 0, (last ? nslot : ui));
            PG8_WAIT_V(8); PG8_WAIT_L(0); PG8_BAR; PG8_MMA(1, 0, At, B0); PG8_MMA(1, 1, At, B1); PG8_BAR; PG8_SCHED;
            } else {
            PG8_LDB(B0, 0, 0); PG8_SCHED; PG8_LDA(At, 0, 0); PG8_STAGE_A0(PG8_SA(1, 1), a1 + hstep);
            PG8_WAIT_L(8); PG8_BAR; PG8_WAIT_L(0); PG8_MMA(0, 0, At, B0); PG8_BAR; PG8_SCHED;
            PG8_LDB(B1, 0, 1); PG8_STAGE_B(PG8_SB(0, 0), b2);
            PG8_BAR; PG8_WAIT_L(0); PG8_MMA(0, 1, At, B1); PG8_BAR;
            PG8_LDA(At, 0, 1); PG8_STAGE_A0(PG8_SA(0, 0), a2);
            PG8_BAR; PG8_WAIT_L(0); PG8_MMA(1, 0, At, B0); PG8_BAR; PG8_SCHED;
            PG8_STAGE_B(PG8_SB(0, 1), b2 + hstep);
            PG8_WAIT_V(6); PG8_BAR; PG8_MMA(1, 1, At, B1); PG8_BAR;
            PG8_LDB(B0, 1, 0); PG8_SCHED; PG8_LDA(At, 1, 0); PG8_STAGE_A0(PG8_SA(0, 1), a2 + hstep);
            PG8_WAIT_L(8); PG8_BAR; PG8_WAIT_L(0); PG8_MMA(0, 0, At, B0); PG8_BAR; PG8_SCHED;
            PG8_LDB(B1, 1, 1); PG8_STAGE_B(PG8_SB(1, 0), b3);
            PG8_BAR; PG8_WAIT_L(0); PG8_MMA(0, 1, At, B1); PG8_BAR;
            PG8_LDA(At, 1, 1); PG8_STAGE_A0(PG8_SA(1, 0), a3);
            PG8_BAR; PG8_WAIT_L(0); PG8_MMA(1, 0, At, B0); PG8_BAR; PG8_SCHED;
            PG8_STAGE_B(PG8_SB(1, 1), b3 + hstep);
            PG8_WAIT_V(6); PG8_BAR; PG8_MMA(1, 1, At, B1); PG8_BAR;
            }
        }
        if constexpr (ALIGN_EPI) { if (wr == 0) PG8_BAR; }
        if constexpr (Epi::PREF) { E.epi_lds(acc, cur, lds, pf_s, wr, wc, fr, fq); pf_s = pf_ns; S.done(cur); }
        else if constexpr (!Epi::AFTER_DRAIN) { E(acc, cur, wr, wc, fr, fq); S.done(cur); }
        if (!has_next) break;
#pragma unroll
        for (int a = 0; a < 2; ++a)
#pragma unroll
            for (int b = 0; b < 2; ++b)
#pragma unroll
                for (int m = 0; m < 4; ++m)
#pragma unroll
                    for (int n = 0; n < 2; ++n) acc[a][b][m][n] = (f32x4){0.f, 0.f, 0.f, 0.f};
        if constexpr (Epi::PREF) { E.init_lds(acc, lds, pf_nb, wc, fq); pf_b = pf_nb; } else if constexpr (Epi::INIT) E.init(acc, nxt, wc, fq);
        else if constexpr (FP8) PG8_PIN_ACC();
        cur = nxt; cA = nA; cB = nB; ++ui;
        if constexpr (ALIGN_EPI) { if (wr == 1) PG8_BAR; }
    }
    PG8_WAIT_V(0);
    if constexpr (!ALIGN_EPI) { if (wr == 0) PG8_BAR; }
    PG8_BAR;
    if constexpr (Epi::AFTER_DRAIN) { E.fused(acc, cur, wr, wc, fr, fq, lds, wid, lane); S.done(cur); }
#undef PG8_SA
#undef PG8_SB
#undef PG8_DMA
#undef PG8_VO
#undef rsB
#undef PG8_STAGE_B
#undef PG8_STAGE_A0
#undef PG8_STAGE_A
#undef PG8_LDA
#undef PG8_LDB
#undef PG8_MMA
#undef PG8_WAIT_V
#undef PG8_WAIT_L
#undef PG8_BAR
#undef PG8_SCHED
#undef PG8_PIN_ACC
}
}

using pg8::f32x4; using pg8::u32x4; using pg8::Unit;
typedef unsigned u32x2 __attribute__((ext_vector_type(2)));
__device__ __forceinline__ float fsigmoid(float x) { return __builtin_amdgcn_rcpf(1.0f + __builtin_amdgcn_exp2f(-1.4426950408889634f * x)); }
__device__ __forceinline__ float fgelu(float x) { const float u = -2.302208198f * (x + 0.044715f * x * x * x); return x * __builtin_amdgcn_rcpf(1.0f + __builtin_amdgcn_exp2f(u)); }
constexpr float WSCALE = 32.0f, WSCALE_INV = 1.0f / 32.0f;
struct EpiResid {
    static constexpr bool PERM = false, AFTER_DRAIN = false, INIT = false, PREF = false;
    bf16* X; const float* MODl; int g_off; float scale;
    __device__ __forceinline__ void operator()(const f32x4 (&acc)[2][2][4][2], const Unit& u, int wr, int wc, int fr, int fq) const {
        const int row0 = u.pm * 256 + wr * 64 + fr, b = (u.pm * 256) / SEQ, col0 = u.pn * 256 + wc * 32 + 8 * fq;
        const float* gp = MODl + (size_t)b * 6144 + g_off + col0; f32x4 gv[2][2];
#pragma unroll
        for (int bj = 0; bj < 2; ++bj)
#pragma unroll
            for (int n = 0; n < 2; ++n) gv[bj][n] = *(const f32x4*)(gp + bj * 128 + 4 * n) * scale;
#pragma unroll
        for (int ai = 0; ai < 2; ++ai)
#pragma unroll
            for (int m = 0; m < 4; ++m) { bf16* rowp = X + (size_t)(row0 + ai * 128 + m * 16) * DM + col0;
#pragma unroll
                for (int bj = 0; bj < 2; ++bj) { const u32x4 xv = *(const u32x4*)(rowp + bj * 128);
                    const f32x4 x0 = (f32x4){__uint_as_float(xv[0] << 16), __uint_as_float(xv[0] & 0xffff0000u), __uint_as_float(xv[1] << 16), __uint_as_float(xv[1] & 0xffff0000u)};
                    const f32x4 x1 = (f32x4){__uint_as_float(xv[2] << 16), __uint_as_float(xv[2] & 0xffff0000u), __uint_as_float(xv[3] << 16), __uint_as_float(xv[3] & 0xffff0000u)};
                    *(u32x4*)(rowp + bj * 128) = pg8::pack8(x0 + gv[bj][0] * acc[ai][bj][m][0], x1 + gv[bj][1] * acc[ai][bj][m][1]); } }
    }
};
struct EpiEvenIn {
    static constexpr bool PERM = false, AFTER_DRAIN = false, INIT = false, PREF = false;
    bf16* P; const float* COS; const float* SIN; int pn0; float scale;
    __device__ __forceinline__ void operator()(const f32x4 (&acc)[2][2][4][2], const Unit& u, int wr, int wc, int fr, int fq) const {
        const int row0 = u.pm * 256 + wr * 64 + fr, pn = u.pn + pn0;
        if (pn < 4) {
            const float sc = pn >= 2 ? 0.08838834764831845f : 1.0f; const int dlow = 32 * (wc & 1) + 8 * fq, col1 = pn * 256 + 128 * (wc >> 1) + dlow;
#pragma unroll
            for (int ai = 0; ai < 2; ++ai)
#pragma unroll
                for (int m = 0; m < 4; ++m) { const int row = row0 + ai * 128 + m * 16, pos = row & (SEQ - 1);
                    const f32x4 c0 = *(const f32x4*)(COS + pos * 64 + dlow), c1 = *(const f32x4*)(COS + pos * 64 + dlow + 4), s0 = *(const f32x4*)(SIN + pos * 64 + dlow), s1 = *(const f32x4*)(SIN + pos * 64 + dlow + 4);
                    const f32x4 x1a = acc[ai][0][m][0], x1b = acc[ai][0][m][1], x2a = acc[ai][1][m][0], x2b = acc[ai][1][m][1];
                    const f32x4 o1a = (x1a * c0 - x2a * s0) * sc, o1b = (x1b * c1 - x2b * s1) * sc, o2a = (x1a * s0 + x2a * c0) * sc, o2b = (x1b * s1 + x2b * c1) * sc;
                    bf16* rp = P + (size_t)row * EVEN_IN + col1; *(u32x4*)rp = pg8::pack8(o1a, o1b); *(u32x4*)(rp + 64) = pg8::pack8(o2a, o2b); }
        } else {
            const int mode = pn < 8 ? 0 : (pn < 12 ? 1 : 2); const int col0 = pn * 256 + wc * 32 + 8 * fq;
#pragma unroll
            for (int ai = 0; ai < 2; ++ai)
#pragma unroll
                for (int m = 0; m < 4; ++m) { bf16* rp = P + (size_t)(row0 + ai * 128 + m * 16) * EVEN_IN + col0;
#pragma unroll
                    for (int bj = 0; bj < 2; ++bj) { f32x4 v0 = acc[ai][bj][m][0] * scale, v1 = acc[ai][bj][m][1] * scale;
                        if (mode == 1) {
#pragma unroll
                            for (int j = 0; j < 4; ++j) { v0[j] = v0[j] * fsigmoid(v0[j]); v1[j] = v1[j] * fsigmoid(v1[j]); } }
                        else if (mode == 2) {
#pragma unroll
                            for (int j = 0; j < 4; ++j) { v0[j] = fgelu(v0[j]); v1[j] = fgelu(v1[j]); } }
                        *(u32x4*)(rp + bj * 128) = pg8::pack8(v0, v1); } }
        }
    }
};
struct EpiOddIn {
    static constexpr bool PERM = false, AFTER_DRAIN = false, INIT = false, PREF = false;
    bf16* P; const float* qg; const float* kg;
    __device__ __forceinline__ void operator()(const f32x4 (&acc)[2][2][4][2], const Unit& u, int wr, int wc, int fr, int fq) const {
        const int row0 = u.pm * 256 + wr * 64 + fr, pn = u.pn;
        if (pn < 8) {
            const float* g = pn < 4 ? qg : kg; const float sc = pn < 4 ? 0.125f * 1.4426950408889634f : 1.0f; f32x4 gv[2][2];
#pragma unroll
            for (int bj = 0; bj < 2; ++bj)
#pragma unroll
                for (int n = 0; n < 2; ++n) gv[bj][n] = *(const f32x4*)(g + 32 * bj + 8 * fq + 4 * n) * sc;
            const int col0 = pn * 256 + 64 * wc + 8 * fq;
#pragma unroll
            for (int ai = 0; ai < 2; ++ai)
#pragma unroll
                for (int m = 0; m < 4; ++m) { float ss = 0.f;
#pragma unroll
                    for (int bj = 0; bj < 2; ++bj)
#pragma unroll
                        for (int n = 0; n < 2; ++n) { const f32x4 v = acc[ai][bj][m][n]; ss += (v[0] * v[0] + v[1] * v[1]) + (v[2] * v[2] + v[3] * v[3]); }
                    ss += xshfl<16>(ss); ss = sum_halves(ss); ss *= WSCALE_INV * WSCALE_INV;
                    const float r = rsqrtf(ss * (1.0f / 64.0f) + EPS) * WSCALE_INV; bf16* rp = P + (size_t)(row0 + ai * 128 + m * 16) * 3072 + col0;
#pragma unroll
                    for (int bj = 0; bj < 2; ++bj) *(u32x4*)(rp + 32 * bj) = pg8::pack8(acc[ai][bj][m][0] * gv[bj][0] * r, acc[ai][bj][m][1] * gv[bj][1] * r); }
        } else {
            const int col0 = pn * 256 + wc * 32 + 8 * fq;
#pragma unroll
            for (int ai = 0; ai < 2; ++ai)
#pragma unroll
                for (int m = 0; m < 4; ++m) { bf16* rp = P + (size_t)(row0 + ai * 128 + m * 16) * 3072 + col0;
#pragma unroll
                    for (int bj = 0; bj < 2; ++bj) *(u32x4*)(rp + bj * 128) = pg8::pack8(acc[ai][bj][m][0] * WSCALE_INV, acc[ai][bj][m][1] * WSCALE_INV); }
        }
    }
};
struct EpiMoe1 {
    static constexpr bool PERM = false, AFTER_DRAIN = false, INIT = true, PREF = true; static constexpr int L_BIAS = 145408;
    bf16* ACT; const float* b1l;
    __device__ __forceinline__ void init(f32x4 (&acc)[2][2][4][2], const Unit& u, int wc, int fq) const {
        const int e = u.pn >> 3, pnl = u.pn & 7, c0 = 128 * pnl + 32 * wc + 8 * fq; const float* bp = b1l + (size_t)e * 2048 + c0;
#pragma unroll
        for (int n = 0; n < 2; ++n) { const f32x4 bg = *(const f32x4*)(bp + 4 * n) * WSCALE, bl = *(const f32x4*)(bp + 1024 + 4 * n) * WSCALE;
#pragma unroll
            for (int ai = 0; ai < 2; ++ai)
#pragma unroll
                for (int m = 0; m < 4; ++m) { acc[ai][0][m][n] = bg; acc[ai][1][m][n] = bl; } }
    }
    __device__ __forceinline__ void operator()(const f32x4 (&acc)[2][2][4][2], const Unit& u, int wr, int wc, int fr, int fq) const {
        const int pnl = u.pn & 7, c0 = 128 * pnl + 32 * wc + 8 * fq, row0 = u.pm * 256 + wr * 64 + fr;
#pragma unroll
        for (int ai = 0; ai < 2; ++ai)
#pragma unroll
            for (int m = 0; m < 4; ++m) { f32x4 a[2];
#pragma unroll
                for (int n = 0; n < 2; ++n) { const f32x4 hg = acc[ai][0][m][n], hl = acc[ai][1][m][n];
                    f32x4 xg, xl;
#pragma unroll
                    for (int j = 0; j < 4; ++j) { xg[j] = __builtin_amdgcn_fmed3f(hg[j], -1.0e30f, 7.0f * WSCALE); xl[j] = __builtin_amdgcn_fmed3f(hl[j], -7.0f * WSCALE, 7.0f * WSCALE); }
                    const f32x4 ea = xg * (-1.702f * 1.4426950408889634f * WSCALE_INV); f32x4 t;
#pragma unroll
                    for (int j = 0; j < 4; ++j) t[j] = __builtin_amdgcn_exp2f(ea[j]);
                    const f32x4 d = t * (WSCALE * WSCALE) + (WSCALE * WSCALE); f32x4 r;
#pragma unroll
                    for (int j = 0; j < 4; ++j) r[j] = __builtin_amdgcn_rcpf(d[j]);
                    a[n] = (xg * (xl + WSCALE)) * r; }
                uint2 pk; pk.x = pg8::pk4_fp8(a[0][0], a[0][1], a[0][2], a[0][3]); pk.y = pg8::pk4_fp8(a[1][0], a[1][1], a[1][2], a[1][3]);
                *(uint2*)((unsigned char*)ACT + (size_t)(row0 + ai * 128 + m * 16) * DFF + c0) = pk; }
    }
    __device__ __forceinline__ void pref(LAS unsigned char* lds, const Unit& u, int boff, int, int wid, int lane) const {
        const int e = u.pn >> 3, pnl = u.pn & 7, L = wid * 64 + lane;
        const __amdgpu_buffer_rsrc_t rb = __builtin_amdgcn_make_buffer_rsrc((void*)(b1l + (size_t)e * 2048 + 128 * pnl), 0, -1, 0x00020000);
        __builtin_amdgcn_raw_ptr_buffer_load_lds(rb, (LAS void*)(lds + boff + wid * 256), 4, (unsigned)((L & 127) + (L >> 7) * 1024) * 4u, 0u, 0, 0);
    }
    __device__ __forceinline__ void init_lds(f32x4 (&acc)[2][2][4][2], LAS unsigned char* lds, int boff, int wc, int fq) const {
        const LAS float* bp = (const LAS float*)(lds + boff) + 32 * wc + 8 * fq;
#pragma unroll
        for (int n = 0; n < 2; ++n) { const f32x4 bg = *(const LAS f32x4*)(bp + 4 * n) * WSCALE, bl = *(const LAS f32x4*)(bp + 128 + 4 * n) * WSCALE;
#pragma unroll
            for (int ai = 0; ai < 2; ++ai)
#pragma unroll
                for (int m = 0; m < 4; ++m) { acc[ai][0][m][n] = bg; acc[ai][1][m][n] = bl; } }
    }
    __device__ __forceinline__ void epi_lds(const f32x4 (&acc)[2][2][4][2], const Unit& u, LAS unsigned char*, int, int wr, int wc, int fr, int fq) const { (*this)(acc, u, wr, wc, fr, fq); }
};
constexpr float YSCALE = 16.0f, YSCALE_INV = 1.0f / 16.0f;
struct EpiMoe2 {
    static constexpr bool PERM = false, AFTER_DRAIN = false, INIT = true, PREF = true; static constexpr int L_BIAS = 131072;
    bf16* YS; const float* b2l; const int* RSLOT; const float* RGATE; const LAS int* tab;
    __device__ __forceinline__ void init(f32x4 (&acc)[2][2][4][2], const Unit& u, int wc, int fq) const {
        const int e = u.pn >> 2, pnl = u.pn & 3, col0 = 256 * pnl + 32 * wc + 8 * fq; const float* bp = b2l + (size_t)e * 1024 + col0;
#pragma unroll
        for (int bj = 0; bj < 2; ++bj)
#pragma unroll
            for (int n = 0; n < 2; ++n) { const f32x4 bv = *(const f32x4*)(bp + bj * 128 + 4 * n) * WSCALE;
#pragma unroll
                for (int ai = 0; ai < 2; ++ai)
#pragma unroll
                    for (int m = 0; m < 4; ++m) acc[ai][bj][m][n] = bv; }
    }
    __device__ __forceinline__ void operator()(const f32x4 (&acc)[2][2][4][2], const Unit& u, int wr, int wc, int fr, int fq) const {
        const int e = u.pn >> 2, pnl = u.pn & 3, col0 = 256 * pnl + 32 * wc + 8 * fq, rl0 = (u.pm - tab[64 + e]) * 256 + wr * 64 + fr, cnt = tab[160 + e];
        int slot[2][4]; float gt[2][4];
#pragma unroll
        for (int ai = 0; ai < 2; ++ai)
#pragma unroll
            for (int m = 0; m < 4; ++m) { const int rl = rl0 + ai * 128 + m * 16; const bool ok = rl < cnt; slot[ai][m] = ok ? RSLOT[e * EREG + rl] : -1; gt[ai][m] = ok ? RGATE[e * EREG + rl] * WSCALE_INV : 0.f; }
#pragma unroll
        for (int ai = 0; ai < 2; ++ai)
#pragma unroll
            for (int m = 0; m < 4; ++m) { unsigned char* rp = (slot[ai][m] >= 0 ? (unsigned char*)YS + (size_t)slot[ai][m] * DM : (unsigned char*)YS + (size_t)T_TOK * 4 * DM + (size_t)(32u << 20)) + col0; const float g = gt[ai][m] * YSCALE;
#pragma unroll
                for (int bj = 0; bj < 2; ++bj) { const f32x4 y0 = acc[ai][bj][m][0] * g, y1 = acc[ai][bj][m][1] * g; uint2 pk; pk.x = pg8::pk4_fp8(y0[0], y0[1], y0[2], y0[3]); pk.y = pg8::pk4_fp8(y1[0], y1[1], y1[2], y1[3]); *(uint2*)(rp + bj * 128) = pk; } }
    }
    __device__ __forceinline__ void pref(LAS unsigned char* lds, const Unit& u, int boff, int soff, int wid, int lane) const {
        const int e = u.pn >> 2, pnl = u.pn & 3, rl = (u.pm - tab[64 + e]) * 256 + wid * 64 + lane;
        const __amdgpu_buffer_rsrc_t rs = __builtin_amdgcn_make_buffer_rsrc((void*)RSLOT, 0, -1, 0x00020000);
        const unsigned relg = (unsigned)(size_t)((const char*)RGATE - (const char*)RSLOT);
        __builtin_amdgcn_raw_ptr_buffer_load_lds(rs, (LAS void*)(lds + soff + wid * 256), 4, (unsigned)rl * 4u, (unsigned)(e * EREG) * 4u, 0, 0);
        __builtin_amdgcn_raw_ptr_buffer_load_lds(rs, (LAS void*)(lds + soff + 1024 + wid * 256), 4, (unsigned)rl * 4u, (unsigned)(e * EREG) * 4u + relg, 0, 0);
        const __amdgpu_buffer_rsrc_t rb = __builtin_amdgcn_make_buffer_rsrc((void*)(b2l + (size_t)e * 1024 + 256 * pnl), 0, -1, 0x00020000);
        __builtin_amdgcn_raw_ptr_buffer_load_lds(rb, (LAS void*)(lds + boff + wid * 256), 4, (unsigned)(wid * 64 + lane) * 4u, 0u, 0, 0);
    }
    __device__ __forceinline__ void init_lds(f32x4 (&acc)[2][2][4][2], LAS unsigned char* lds, int boff, int wc, int fq) const {
        const LAS float* bp = (const LAS float*)(lds + boff) + 32 * wc + 8 * fq;
#pragma unroll
        for (int bj = 0; bj < 2; ++bj)
#pragma unroll
            for (int n = 0; n < 2; ++n) { const f32x4 bv = *(const LAS f32x4*)(bp + bj * 128 + 4 * n) * WSCALE;
#pragma unroll
                for (int ai = 0; ai < 2; ++ai)
#pragma unroll
                    for (int m = 0; m < 4; ++m) acc[ai][bj][m][n] = bv; }
    }
    __device__ __forceinline__ void epi_lds(const f32x4 (&acc)[2][2][4][2], const Unit& u, LAS unsigned char* lds, int soff, int wr, int wc, int fr, int fq) const {
        const int e = u.pn >> 2, pnl = u.pn & 3, col0 = 256 * pnl + 32 * wc + 8 * fq, r0 = wr * 64 + fr, rl0 = (u.pm - tab[64 + e]) * 256 + r0, cnt = tab[160 + e];
        const LAS int* sl = (const LAS int*)(lds + soff); const LAS float* gl = (const LAS float*)(sl + 256);
        int slot[2][4]; float gt[2][4];
#pragma unroll
        for (int ai = 0; ai < 2; ++ai)
#pragma unroll
            for (int m = 0; m < 4; ++m) { const int r = ai * 128 + m * 16; const bool ok = rl0 + r < cnt; slot[ai][m] = ok ? sl[r0 + r] : -1; gt[ai][m] = ok ? gl[r0 + r] * WSCALE_INV : 0.f; }
#pragma unroll
        for (int ai = 0; ai < 2; ++ai)
#pragma unroll
            for (int m = 0; m < 4; ++m) { unsigned char* rp = (slot[ai][m] >= 0 ? (unsigned char*)YS + (size_t)slot[ai][m] * DM : (unsigned char*)YS + (size_t)T_TOK * 4 * DM + (size_t)(32u << 20)) + col0; const float g = gt[ai][m] * YSCALE;
#pragma unroll
                for (int bj = 0; bj < 2; ++bj) { const f32x4 y0 = acc[ai][bj][m][0] * g, y1 = acc[ai][bj][m][1] * g; uint2 pk; pk.x = pg8::pk4_fp8(y0[0], y0[1], y0[2], y0[3]); pk.y = pg8::pk4_fp8(y1[0], y1[1], y1[2], y1[3]); *(uint2*)(rp + bj * 128) = pk; } }
    }
};

struct EpiNull { static constexpr bool PERM = false, AFTER_DRAIN = false, INIT = false, PREF = false; float* sink;
    __device__ __forceinline__ void operator()(const f32x4 (&acc)[2][2][4][2], const Unit& u, int wr, int wc, int fr, int fq) const { f32x4 s = acc[0][0][0][0];
#pragma unroll
        for (int ai = 0; ai < 2; ++ai)
#pragma unroll
            for (int bj = 0; bj < 2; ++bj)
#pragma unroll
                for (int m = 0; m < 4; ++m)
#pragma unroll
                    for (int n = 0; n < 2; ++n) s = s + acc[ai][bj][m][n];
        if (s[0] + s[1] + s[2] + s[3] == 12345.678f) sink[0] = s[0]; } };
constexpr int LDS_STAGE = 131072, LDS_CTL_OFF = 139264, LDS_BYTES = 147456;
__device__ __forceinline__ int logical_group_base(int mode, int gp) {
    const int pn = gp >> 3, bj = (gp >> 2) & 1, wc = gp & 3;
    if (mode == 1) return pn < 4 ? 256 * pn + 128 * (wc >> 1) + 64 * bj + 32 * (wc & 1) : 32 * gp;
    if (mode == 2) return pn < 8 ? 256 * pn + 64 * wc + 32 * bj : 32 * gp;
    if (mode == 3) return 1024 * bj + 128 * pn + 32 * wc;
    return 32 * gp;
}
__device__ __forceinline__ void load_item(float4 (&v)[16], const float* W, int N, int mode, int kb, int gp, int lane) {
    const float* src = W + (size_t)(128 * kb + (lane >> 3)) * N + logical_group_base(mode, gp) + (lane & 7) * 4;
#pragma unroll
    for (int i = 0; i < 16; ++i) { const f32x4 t = __builtin_nontemporal_load((const f32x4*)(src + (size_t)(8 * i) * N)); v[i] = make_float4(t[0], t[1], t[2], t[3]); }
}
template <bool F8> __device__ __forceinline__ void store_item(const float4 (&v)[16], int K, bf16* out, int kb, int gp, LAS float* scr, int lane) {
    const int k0 = 128 * kb;
#pragma unroll
    for (int i = 0; i < 16; ++i) { LAS float* d = scr + (8 * i + (lane >> 3)) * 33 + (lane & 7) * 4; d[0] = v[i].x; d[1] = v[i].y; d[2] = v[i].z; d[3] = v[i].w; }
    asm volatile("s_waitcnt lgkmcnt(0)" ::: "memory");
    const int c = lane & 15;
#pragma unroll
    for (int jj = 0; jj < 8; ++jj) { const int ip = (lane >> 4) + 4 * jj; const int il = 8 * ((ip >> 2) & 3) + 4 * (ip >> 4) + (ip & 3);
        const LAS float* s = scr + (8 * c) * 33 + il; u32x4 o;
        if constexpr (F8) { uint2 p; p.x = pg8::pk4_fp8(s[0 * 33] * WSCALE, s[1 * 33] * WSCALE, s[2 * 33] * WSCALE, s[3 * 33] * WSCALE); p.y = pg8::pk4_fp8(s[4 * 33] * WSCALE, s[5 * 33] * WSCALE, s[6 * 33] * WSCALE, s[7 * 33] * WSCALE);
            __builtin_nontemporal_store(*(const u32x2*)&p, (u32x2*)((unsigned char*)out + (size_t)(32 * gp + ip) * K + k0 + 8 * c)); }
        else { o.x = pg8::cvt_pk_bf16(s[0 * 33], s[1 * 33]); o.y = pg8::cvt_pk_bf16(s[2 * 33], s[3 * 33]); o.z = pg8::cvt_pk_bf16(s[4 * 33], s[5 * 33]); o.w = pg8::cvt_pk_bf16(s[6 * 33], s[7 * 33]);
            __builtin_nontemporal_store(o, (u32x4*)(out + (size_t)(32 * gp + ip) * K + k0 + 8 * c)); } }
    asm volatile("s_waitcnt lgkmcnt(0)" ::: "memory");
}
__device__ __forceinline__ void load_half(float4 (&v)[8], const float* W, int N, int mode, int kb, int gp, int half, int lane) {
    const float* src = W + (size_t)(128 * kb + 64 * half + (lane >> 3)) * N + logical_group_base(mode, gp) + (lane & 7) * 4;
#pragma unroll
    for (int i = 0; i < 8; ++i) { const f32x4 t = __builtin_nontemporal_load((const f32x4*)(src + (size_t)(8 * i) * N)); v[i] = make_float4(t[0], t[1], t[2], t[3]); }
}
__device__ __forceinline__ void write_half(const float4 (&v)[8], int half, LAS float* scr, int lane) {
#pragma unroll
    for (int i = 0; i < 8; ++i) { LAS float* d = scr + (64 * half + 8 * i + (lane >> 3)) * 33 + (lane & 7) * 4; d[0] = v[i].x; d[1] = v[i].y; d[2] = v[i].z; d[3] = v[i].w; }
}
template <bool F8> __device__ __forceinline__ void process_item(int K, bf16* out, int kb, int gp, LAS float* scr, int lane) {
    const int k0 = 128 * kb;
    asm volatile("s_waitcnt lgkmcnt(0)" ::: "memory");
    const int c = lane & 15;
#pragma unroll
    for (int jj = 0; jj < 8; ++jj) { const int ip = (lane >> 4) + 4 * jj; const int il = 8 * ((ip >> 2) & 3) + 4 * (ip >> 4) + (ip & 3);
        const LAS float* s = scr + (8 * c) * 33 + il; u32x4 o;
        if constexpr (F8) { uint2 p; p.x = pg8::pk4_fp8(s[0 * 33] * WSCALE, s[1 * 33] * WSCALE, s[2 * 33] * WSCALE, s[3 * 33] * WSCALE); p.y = pg8::pk4_fp8(s[4 * 33] * WSCALE, s[5 * 33] * WSCALE, s[6 * 33] * WSCALE, s[7 * 33] * WSCALE);
            __builtin_nontemporal_store(*(const u32x2*)&p, (u32x2*)((unsigned char*)out + (size_t)(32 * gp + ip) * K + k0 + 8 * c)); }
        else { o.x = pg8::cvt_pk_bf16(s[0 * 33], s[1 * 33]); o.y = pg8::cvt_pk_bf16(s[2 * 33], s[3 * 33]); o.z = pg8::cvt_pk_bf16(s[4 * 33], s[5 * 33]); o.w = pg8::cvt_pk_bf16(s[6 * 33], s[7 * 33]);
            __builtin_nontemporal_store(o, (u32x4*)(out + (size_t)(32 * gp + ip) * K + k0 + 8 * c)); } }
    asm volatile("s_waitcnt lgkmcnt(0)" ::: "memory");
}
template <int K, int N, int MODE, int NMAT, int BASE, bool F8 = false, int GP0 = 0, int GPN = N / 32>
__device__ __forceinline__ void convert_job(LAS unsigned char* lds, const float* W, bf16* out, int gw, int ngw) {
    const int tid = opaque_tid(), lane = tid & 63, wave = tid >> 6; LAS float* scr = (LAS float*)(lds + wave * 16896);
    constexpr int ng = GPN, per = (K / 128) * ng, tot = per * NMAT;
    int it = gw - (BASE % ngw); if (it < 0) it += ngw;
    if (it >= tot) return;
    float4 va[8], vb[8];
#define CVT_LOADH(dst, item, half) do { const int m2_ = (item) / per, r2_ = (item) % per; load_half(dst, W + (size_t)m2_ * K * N, N, MODE, r2_ / ng, GP0 + r2_ % ng, half, lane); } while (0)
#define CVT_PROC(item) do { const int m_ = (item) / per, r_ = (item) % per; process_item<F8>(K, F8 ? (bf16*)((unsigned char*)out + (size_t)m_ * K * N) : out + (size_t)m_ * K * N, r_ / ng, GP0 + r_ % ng, scr, lane); } while (0)
    CVT_LOADH(va, it, 0); CVT_LOADH(vb, it, 1);
    const int nmin = tot / ngw; int kk = 0;
#define CVT_SYNC() do { if (kk < nmin) __builtin_amdgcn_s_barrier(); ++kk; } while (0)
    for (;;) {
        if (it + ngw >= tot) { CVT_SYNC(); write_half(va, 0, scr, lane); write_half(vb, 1, scr, lane); CVT_PROC(it); break; }
        CVT_SYNC(); write_half(va, 0, scr, lane); asm volatile("" ::: "memory"); CVT_LOADH(va, it + ngw, 0); asm volatile("" ::: "memory");
        write_half(vb, 1, scr, lane); asm volatile("" ::: "memory"); CVT_LOADH(vb, it + ngw, 1); asm volatile("" ::: "memory");
        CVT_PROC(it); it += ngw;
    }
#undef CVT_SYNC
#undef CVT_LOADH
#undef CVT_PROC
}
constexpr int CVT_T0 = (1024 / 128) * (4096 / 32) * 2, CVT_T1 = (1536 / 128) * (1024 / 32) * 2, CVT_T2 = (1024 / 128) * (3072 / 32) * 2, CVT_T3 = (1024 / 128) * (1024 / 32) * 2, CVT_T4 = (1024 / 128) * (2048 / 32) * 128;
typedef short s16x4 __attribute__((ext_vector_type(4)));
using pg8::bf16x8;
__device__ __forceinline__ bf16x8 tr_frag(const LAS unsigned char* p0, const LAS unsigned char* p1) {
    const s16x4 a = __builtin_amdgcn_ds_read_tr16_b64_v4i16((LAS s16x4*)p0), b = __builtin_amdgcn_ds_read_tr16_b64_v4i16((LAS s16x4*)p1);
    return (bf16x8){a[0], a[1], a[2], a[3], b[0], b[1], b[2], b[3]};
}
__device__ __forceinline__ void phase_attn(LAS unsigned char* lds, const bf16* P, const float* relb, const float* qg, const float* kg, bf16* MIX, int c0, int G) {
    constexpr float LOG2E = 1.4426950408889634f; constexpr int KS = 144, HB = 18432, BUF = 2 * HB;
    LAS float* rt = (LAS float*)(lds + 2 * BUF); LAS float* red = rt + 1280;
    const int tid = opaque_tid(), lane = tid & 63, w = tid >> 6, fr = lane & 15, fq = lane >> 4;
    const int skey = tid >> 3, sseg = tid & 7, hw = w >> 2;
    float Mref;
    { float m1 = 0.f, m2 = 0.f, m3 = -1.0e30f;
      if (tid < 64) { m1 = fabsf(qg[tid]); m2 = fabsf(kg[tid]); }
      for (int i = tid; i < 16 * 320; i += 512) m3 = fmaxf(m3, relb[i]);
#define WMAX(v) do { v = fmaxf(v, xshfl<1>(v)); v = fmaxf(v, xshfl<2>(v)); v = fmaxf(v, xshfl<4>(v)); v = fmaxf(v, xshfl<8>(v)); v = fmaxf(v, xshfl<16>(v)); v = max_halves(v); } while (0)
      WMAX(m1); WMAX(m2); WMAX(m3);
#undef WMAX
      __syncthreads();
      if (lane == 0) { red[w] = m1; red[8 + w] = m2; red[16 + w] = m3; }
      __syncthreads();
      float g1 = 0.f, g2 = 0.f, g3 = -1.0e30f;
#pragma unroll
      for (int i = 0; i < 8; ++i) { g1 = fmaxf(g1, red[i]); g2 = fmaxf(g2, red[8 + i]); g3 = fmaxf(g3, red[16 + i]); }
      Mref = (8.0f * g1 * g2 * 1.01f + g3 + 0.1f) * LOG2E; }
    if ((G & 127) == 0) { const int hp0 = (c0 >> 4) & 7; float tv[3];
#pragma unroll
        for (int k = 0; k < 3; ++k) { const int i = tid + 512 * k, ic = i < 1280 ? i : 0, hj = ic >= 640 ? 1 : 0, j = 639 - (ic - 640 * hj); tv[k] = relb[(2 * hp0 + hj) * 320 + (j > 319 ? 319 : j)]; }
#pragma unroll
        for (int k = 0; k < 3; ++k) { const int i = tid + 512 * k; if (i < 1280) rt[i] = tv[k] * LOG2E - Mref; } }
    for (int u = c0; u < NB * 8 * 16; u += G) {
        const int b = u >> 7, hp = (u >> 4) & 7, cp = ((u & 15) + 4 * (u >> 8)) & 15, h = 2 * hp + hw, nq = 2 * cp + ((w >> 1) & 1);
        const int kc_lo = 2 * cp - 8 < 0 ? 0 : 2 * cp - 8, kc_hi = 2 * cp + 1;
        const bf16* srcb = P + ((size_t)b * SEQ + skey) * 3072 + 1024 + (2 * hp) * 64 + sseg * 8;
        u32x4 ka = *(const u32x4*)(srcb + (size_t)kc_lo * 64 * 3072), kb = *(const u32x4*)(srcb + (size_t)kc_lo * 64 * 3072 + 64), va = *(const u32x4*)(srcb + (size_t)kc_lo * 64 * 3072 + 1024), vb = *(const u32x4*)(srcb + (size_t)kc_lo * 64 * 3072 + 1024 + 64);
        __syncthreads();
        if ((G & 127) != 0) { for (int i = tid; i < 1280; i += 512) { const int hj = i >= 640 ? 1 : 0, j = 639 - (i - 640 * hj); rt[i] = relb[(2 * hp + hj) * 320 + (j > 319 ? 319 : j)] * LOG2E - Mref; } }
        { LAS unsigned char* d = lds + skey * KS + sseg * 16; *(LAS u32x4*)d = ka; *(LAS u32x4*)(d + 9216) = va; *(LAS u32x4*)(d + HB) = kb; *(LAS u32x4*)(d + HB + 9216) = vb; }
        bf16x8 qf[2][2];
#pragma unroll
        for (int qt = 0; qt < 2; ++qt)
#pragma unroll
            for (int s = 0; s < 2; ++s) qf[qt][s] = *(const bf16x8*)(P + ((size_t)b * SEQ + nq * 64 + 32 * (w & 1) + 16 * qt + fr) * 3072 + h * 64 + 32 * s + 8 * fq);
        f32x4 o[2][4]; float lrow[2];
#pragma unroll
        for (int qt = 0; qt < 2; ++qt) { lrow[qt] = 0.f;
#pragma unroll
            for (int dt = 0; dt < 4; ++dt) o[qt][dt] = (f32x4){0.f, 0.f, 0.f, 0.f}; }
        const LAS float* rtw = rt + 640 * hw;
        __builtin_amdgcn_s_waitcnt(0x0F70);
        __syncthreads();
        for (int kc = kc_lo; kc <= kc_hi; ++kc) {
            LAS unsigned char* Ks = lds + ((kc - kc_lo) & 1) * BUF + hw * HB; LAS unsigned char* Vs = Ks + 9216;
            if (kc < kc_hi) { const bf16* sp = srcb + (size_t)(kc + 1) * 64 * 3072; ka = *(const u32x4*)sp; kb = *(const u32x4*)(sp + 64); va = *(const u32x4*)(sp + 1024); vb = *(const u32x4*)(sp + 1024 + 64); }
            if (kc >= nq - 8 && kc <= nq) {
                const int delta = nq - kc;
                f32x4 st[2][4];
#pragma unroll
                for (int qt = 0; qt < 2; ++qt) {
                    if (delta >= 5) { const float cb = rtw[320];
#pragma unroll
                        for (int t = 0; t < 4; ++t) st[qt][t] = (f32x4){cb, cb, cb, cb}; }
                    else { const int qi = 32 * (w & 1) + 16 * qt + fr; const LAS float* bp = rtw + (639 - (qi - 4 * fq + 64 * delta + 63));
#pragma unroll
                        for (int t = 0; t < 4; ++t)
#pragma unroll
                            for (int r = 0; r < 4; ++r) st[qt][t][r] = bp[16 * t + r]; } }
#pragma unroll
                for (int t = 0; t < 4; ++t) {
                    const bf16x8 k0 = *(const LAS bf16x8*)(Ks + (16 * t + fr) * KS + (8 * fq) * 2), k1 = *(const LAS bf16x8*)(Ks + (16 * t + fr) * KS + (32 + 8 * fq) * 2);
#pragma unroll
                    for (int qt = 0; qt < 2; ++qt) { f32x4 a = st[qt][t];
                        a = __builtin_amdgcn_mfma_f32_16x16x32_bf16(k0, qf[qt][0], a, 0, 0, 0); a = __builtin_amdgcn_mfma_f32_16x16x32_bf16(k1, qf[qt][1], a, 0, 0, 0); st[qt][t] = a; }
                }
                bf16x8 pf[2][2];
#pragma unroll
                for (int qt = 0; qt < 2; ++qt) {
                    float ps = 0.f;
#pragma unroll
                    for (int t = 0; t < 4; ++t)
#pragma unroll
                        for (int r = 0; r < 4; ++r) { const float p = __builtin_amdgcn_exp2f(st[qt][t][r]); st[qt][t][r] = p; ps += p; }
                    lrow[qt] += ps;
                    pf[qt][0] = (bf16x8)pg8::pack8(st[qt][0], st[qt][1]); pf[qt][1] = (bf16x8)pg8::pack8(st[qt][2], st[qt][3]);
                }
#pragma unroll
                for (int s = 0; s < 2; ++s)
#pragma unroll
                    for (int dt = 0; dt < 4; ++dt) {
                        const LAS unsigned char* vp = Vs + (32 * s + 4 * fq + (fr >> 2)) * KS + (16 * dt + 4 * (fr & 3)) * 2;
                        const bf16x8 vf = tr_frag(vp, vp + 16 * KS);
#pragma unroll
                        for (int qt = 0; qt < 2; ++qt) o[qt][dt] = __builtin_amdgcn_mfma_f32_16x16x32_bf16(vf, pf[qt][s], o[qt][dt], 0, 0, 0);
                    }
            }
            if (kc < kc_hi) { LAS unsigned char* d = lds + (((kc - kc_lo) & 1) ^ 1) * BUF + skey * KS + sseg * 16; *(LAS u32x4*)d = ka; *(LAS u32x4*)(d + 9216) = va; *(LAS u32x4*)(d + HB) = kb; *(LAS u32x4*)(d + HB + 9216) = vb; }
            __syncthreads();
        }
#pragma unroll
        for (int qt = 0; qt < 2; ++qt) { float l = lrow[qt]; l += xshfl<16>(l); l = sum_halves(l); const float inv = __builtin_amdgcn_rcpf(l);
            unsigned char* dst = (unsigned char*)MIX + ((size_t)b * SEQ + nq * 64 + 32 * (w & 1) + 16 * qt + fr) * DM + h * 64 + 4 * fq;
#pragma unroll
            for (int dt = 0; dt < 4; ++dt) { const f32x4 v = o[qt][dt] * inv; *(unsigned*)(dst + 16 * dt) = pg8::pk4_fp8(v[0], v[1], v[2], v[3]); } }
    }
}
struct KvRegs { u32x4 k[2], v[4]; };
__device__ __forceinline__ void kv_load(KvRegs& R, const bf16* P, int u, int tid) {
    const int h = u & 3, n = (u >> 2) & 31, b = u >> 7; const size_t row0 = (size_t)b * SEQ + (size_t)n * 64;
#pragma unroll
    for (int i = 0; i < 2; ++i) { const int id = tid + 512 * i, j = id >> 4, seg = id & 15; R.k[i] = *(const u32x4*)(P + (row0 + j) * EVEN_IN + 512 + h * 128 + seg * 8); }
#pragma unroll
    for (int i = 0; i < 4; ++i) { const int id = tid + 512 * i, j = id >> 5, seg = id & 31; R.v[i] = *(const u32x4*)(P + (row0 + j) * EVEN_IN + 1024 + h * 256 + seg * 8); }
}
__device__ __forceinline__ void kv_unit(LAS unsigned char* lds, const bf16* P, bf16* KV, int u, KvRegs& R, int unext) {
    constexpr int KST = 272, VST = 528;
    LAS unsigned char* Ks = lds; LAS unsigned char* Vs = lds + 64 * KST;
    const int tid = opaque_tid(), lane = tid & 63, w = tid >> 6, fr = lane & 15, fq = lane >> 4;
    const int h = u & 3, n = (u >> 2) & 31, b = u >> 7;
    const float log2g = log2f(1.0f - exp2f(-5.0f - (float)h));
    const size_t row0 = (size_t)b * SEQ + (size_t)n * 64;
    __syncthreads();
#pragma unroll
    for (int i = 0; i < 2; ++i) { const int id = tid + 512 * i, j = id >> 4, seg = id & 15; const u32x4 v = R.k[i];
        const float kd = exp2f(log2g * (float)(63 - j)); u32x4 o;
#pragma unroll
        for (int q = 0; q < 4; ++q) { const float lo = __uint_as_float(v[q] << 16) * kd, hi = __uint_as_float(v[q] & 0xffff0000u) * kd; o[q] = pg8::cvt_pk_bf16(lo, hi); }
        *(LAS u32x4*)(Ks + j * KST + seg * 16) = o; }
#pragma unroll
    for (int i = 0; i < 4; ++i) { const int id = tid + 512 * i, j = id >> 5, seg = id & 31; *(LAS u32x4*)(Vs + j * VST + seg * 16) = R.v[i]; }
    __syncthreads();
    if (unext >= 0) kv_load(R, P, unext, tid);
    f32x4 acc[8][2];
#pragma unroll
    for (int dt = 0; dt < 8; ++dt) { acc[dt][0] = (f32x4){0.f, 0.f, 0.f, 0.f}; acc[dt][1] = (f32x4){0.f, 0.f, 0.f, 0.f}; }
#pragma unroll
    for (int s = 0; s < 2; ++s) {
        bf16x8 vf[2];
#pragma unroll
        for (int e2 = 0; e2 < 2; ++e2) { const LAS unsigned char* vp = Vs + (32 * s + 8 * fq + (fr >> 2)) * VST + (16 * (2 * w + e2) + 4 * (fr & 3)) * 2; vf[e2] = tr_frag(vp, vp + 4 * VST); }
#pragma unroll
        for (int dt = 0; dt < 8; ++dt) { const LAS unsigned char* kp = Ks + (32 * s + 8 * fq + (fr >> 2)) * KST + (16 * dt + 4 * (fr & 3)) * 2; const bf16x8 kf = tr_frag(kp, kp + 4 * KST);
#pragma unroll
            for (int e2 = 0; e2 < 2; ++e2) acc[dt][e2] = __builtin_amdgcn_mfma_f32_16x16x32_bf16(kf, vf[e2], acc[dt][e2], 0, 0, 0); }
    }
    bf16* dst = KV + (size_t)u * 32768;
#pragma unroll
    for (int e2 = 0; e2 < 2; ++e2)
#pragma unroll
        for (int dt = 0; dt < 8; ++dt) { const f32x4 v = acc[dt][e2]; uint2 pk; pk.x = pg8::cvt_pk_bf16(v[0], v[1]); pk.y = pg8::cvt_pk_bf16(v[2], v[3]);
            *(uint2*)(dst + (16 * (2 * w + e2) + fr) * 128 + 16 * dt + 4 * fq) = pk; }
}
struct GmRegs { float4 w4[8]; u32x4 z2[4]; f32x4 lg0, lg1, lb0, lb1; uint2 uv[8]; float bs[8]; };
__device__ __forceinline__ void gm_load(GmRegs& R, const bf16* P, const float* lng, const float* lnb, const float* sgw, const float* sgb, size_t t0, int g, int tid, int w, int fr, int fq) {
    const int c8 = (tid & 15) * 8;
#pragma unroll
    for (int i = 0; i < 8; ++i) { const int id = tid + 512 * i, r = id >> 5, c4 = (id & 31) * 4; R.w4[i] = *(const float4*)(sgw + ((size_t)g * 128 + r) * 128 + c4); }
#pragma unroll
    for (int i = 0; i < 4; ++i) { const int id = tid + 512 * i, j = id >> 4; R.z2[i] = *(const u32x4*)(P + (t0 + j) * EVEN_IN + 3584 + g * 128 + c8); }
    R.lg0 = *(const f32x4*)(lng + g * 128 + c8); R.lg1 = *(const f32x4*)(lng + g * 128 + c8 + 4); R.lb0 = *(const f32x4*)(lnb + g * 128 + c8); R.lb1 = *(const f32x4*)(lnb + g * 128 + c8 + 4);
}
__device__ __forceinline__ void gm_load_epi(GmRegs& R, const bf16* P, const float* sgb, size_t t0, int g, int w, int fr, int fq) {
#pragma unroll
    for (int it = 0; it < 8; ++it) { const int i = 16 * it + fr; R.bs[it] = sgb[g * 128 + i]; R.uv[it] = *(const uint2*)(P + (t0 + i) * EVEN_IN + 3072 + g * 128 + 16 * w + 4 * fq); }
}
__device__ __forceinline__ void gmlp_unit(LAS unsigned char* lds, const bf16* P, const float* lng, const float* lnb, const float* sgw, const float* sgb, bf16* MIX, int u) {
    constexpr int ST = 272;
    LAS unsigned char* Wl = lds; LAS unsigned char* Zt = lds + 128 * ST; LAS float* stat = (LAS float*)(lds + 256 * ST);
    const int tid = opaque_tid(), lane = tid & 63, w = tid >> 6, fr = lane & 15, fq = lane >> 4;
    const int gp2 = u & 1, p = (u >> 1) & 15, b = u >> 5; const size_t t0 = (size_t)b * SEQ + (size_t)p * 128;
    const int c8 = (tid & 15) * 8;
    u32x4 zv[16];
#pragma unroll
    for (int i = 0; i < 16; ++i) zv[i] = *(const u32x4*)(P + (t0 + 16 * w + i) * EVEN_IN + 3584 + lane * 8);
    GmRegs R; gm_load(R, P, lng, lnb, sgw, sgb, t0, 2 * gp2, tid, w, fr, fq); gm_load_epi(R, P, sgb, t0, 2 * gp2, w, fr, fq);
    __syncthreads();
    { float val[32];
#pragma unroll
      for (int i = 0; i < 16; ++i) { float s = 0.f, q = 0.f;
#pragma unroll
          for (int k = 0; k < 4; ++k) { const float lo = __uint_as_float(zv[i][k] << 16), hi = __uint_as_float(zv[i][k] & 0xffff0000u); s += lo + hi; q += lo * lo + hi * hi; }
          val[2 * i] = sum_halves(s); val[2 * i + 1] = sum_halves(q); }
#define RS_STEP(M, HALF) do { const bool up = (lane & (M)) != 0; _Pragma("unroll") for (int i = 0; i < (HALF); ++i) { const float snd = up ? val[i] : val[i + (HALF)], kp = up ? val[i + (HALF)] : val[i]; val[i] = kp + xshfl<(M)>(snd); } } while (0)
      RS_STEP(16, 16); RS_STEP(8, 8); RS_STEP(4, 4); RS_STEP(2, 2); RS_STEP(1, 1);
#undef RS_STEP
      const float mine = val[0], other = xshfl<1>(mine);
      if ((lane & 33) == 0) { const float mu = mine * (1.0f / 512.0f); const float var = fmaxf(other * (1.0f / 512.0f) - mu * mu, 0.f); const int row = 16 * w + ((lane & 31) >> 1); stat[2 * row] = mu; stat[2 * row + 1] = rsqrtf(var + EPS); } }
#pragma unroll 1
    for (int gi = 0; gi < 2; ++gi) { const int g = 2 * gp2 + gi;
        if (gi == 1) __syncthreads();
#pragma unroll
        for (int i = 0; i < 8; ++i) { const int id = tid + 512 * i, r = id >> 5, c4 = (id & 31) * 4; float4 v = R.w4[i];
            if (r < 64 && c4 >= 64) v = make_float4(0.f, 0.f, 0.f, 0.f);
            u32x2 pk; pk.x = pg8::cvt_pk_bf16(v.x, v.y); pk.y = pg8::cvt_pk_bf16(v.z, v.w); *(LAS u32x2*)(Wl + r * ST + c4 * 2) = pk; }
        __syncthreads();
#pragma unroll
        for (int i = 0; i < 4; ++i) { const int id = tid + 512 * i, j = id >> 4; const u32x4 zz = R.z2[i];
            const float mu = stat[2 * j], rs = stat[2 * j + 1];
#pragma unroll
            for (int k = 0; k < 4; ++k) { const float gl_ = k < 2 ? R.lg0[2 * k] : R.lg1[2 * k - 4], gh_ = k < 2 ? R.lg0[2 * k + 1] : R.lg1[2 * k - 3], bl_ = k < 2 ? R.lb0[2 * k] : R.lb1[2 * k - 4], bh_ = k < 2 ? R.lb0[2 * k + 1] : R.lb1[2 * k - 3];
                const float lo = (__uint_as_float(zz[k] << 16) - mu) * rs * gl_ + bl_, hi = (__uint_as_float(zz[k] & 0xffff0000u) - mu) * rs * gh_ + bh_;
                const unsigned pk = pg8::cvt_pk_bf16(lo, hi);
                *(LAS unsigned short*)(Zt + (c8 + 2 * k) * ST + j * 2) = (unsigned short)(pk & 0xffffu); *(LAS unsigned short*)(Zt + (c8 + 2 * k + 1) * ST + j * 2) = (unsigned short)(pk >> 16); } }
        __syncthreads();
        if (gi == 0) gm_load(R, P, lng, lnb, sgw, sgb, t0, g + 1, tid, w, fr, fq);
        f32x4 acc[8];
#pragma unroll
        for (int it = 0; it < 8; ++it) acc[it] = (f32x4){0.f, 0.f, 0.f, 0.f};
#pragma unroll
        for (int s = 0; s < 4; ++s) { const bf16x8 zf = *(const LAS bf16x8*)(Zt + (16 * w + fr) * ST + (32 * s + 8 * fq) * 2);
#pragma unroll
            for (int it = 0; it < 8; ++it) { if (s >= 2 && it < 4) continue; const bf16x8 wf = *(const LAS bf16x8*)(Wl + (16 * it + fr) * ST + (32 * s + 8 * fq) * 2);
                acc[it] = __builtin_amdgcn_mfma_f32_16x16x32_bf16(zf, wf, acc[it], 0, 0, 0); } }
#pragma unroll
        for (int it = 0; it < 8; ++it) { const int i = 16 * it + fr; const float bs = R.bs[it]; const uint2 uv = R.uv[it];
            const float u0 = __uint_as_float(uv.x << 16), u1 = __uint_as_float(uv.x & 0xffff0000u), u2 = __uint_as_float(uv.y << 16), u3 = __uint_as_float(uv.y & 0xffff0000u);
            *(unsigned*)((unsigned char*)MIX + (t0 + i) * EVEN_MIX + 1024 + g * 128 + 16 * w + 4 * fq) = pg8::pk4_fp8(u0 * (acc[it][0] + bs), u1 * (acc[it][1] + bs), u2 * (acc[it][2] + bs), u3 * (acc[it][3] + bs)); }
        if (gi == 0) gm_load_epi(R, P, sgb, t0, g + 1, w, fr, fq);
    }
}
__device__ __forceinline__ void phase_e1(LAS unsigned char* lds, const bf16* P, bf16* KV, const float* lng, const float* lnb, const float* sgw, const float* sgb, bf16* MIX, int c0, int G, int ulo, int uhi) {
    KvRegs R; bool have = false;
    for (int u = ulo + c0; u < uhi; u += G) {
        if (u < 1024) { if (((u >> 2) & 31) == 31) continue;
            if (!have) kv_load(R, P, u, opaque_tid());
            int un = u + G; while (un < uhi && un < 1024 && ((un >> 2) & 31) == 31) un += G;
            const int unext = (un < uhi && un < 1024) ? un : -1;
            kv_unit(lds, P, KV, u, R, unext); have = unext >= 0; }
        else gmlp_unit(lds, P, lng, lnb, sgw, sgb, MIX, u - 1024);
    }
}
__device__ __forceinline__ void phase_e2(const bf16* KV, bf16* STt, int gtid, int nthr) {
    for (int idx = gtid; idx < NB * 4 * 4096; idx += nthr) {
        const int bh = idx >> 12, rem = (idx & 4095) * 8, b = bh >> 2, h = bh & 3;
        const float g64 = exp2f(64.0f * log2f(1.0f - exp2f(-5.0f - (float)h)));
        float S[8];
#pragma unroll
        for (int k = 0; k < 8; ++k) S[k] = 0.f;
        u32x4 kvv[31];
#pragma unroll
        for (int n = 0; n < 31; ++n) kvv[n] = *(const u32x4*)(KV + ((size_t)((b * 32 + n) * 4 + h)) * 32768 + rem);
#pragma unroll
        for (int n = 0; n < 31; ++n) { const size_t off = ((size_t)((b * 32 + n) * 4 + h)) * 32768 + rem; const u32x4 v = kvv[n];
#pragma unroll
            for (int k = 0; k < 4; ++k) { S[2 * k] = S[2 * k] * g64 + __uint_as_float(v[k] << 16); S[2 * k + 1] = S[2 * k + 1] * g64 + __uint_as_float(v[k] & 0xffff0000u); }
            u32x4 o;
#pragma unroll
            for (int k = 0; k < 4; ++k) o[k] = pg8::cvt_pk_bf16(S[2 * k], S[2 * k + 1]);
            *(u32x4*)(STt + off + 4 * 32768) = o; }
    }
}
struct RetRegs { u32x4 k[2], v[4], s[8]; bf16x8 q[4]; uint2 g[8]; };
__device__ __forceinline__ void ret_load(RetRegs& R, const bf16* P, const bf16* STt, int u, int tid, int it, int fr, int fq) {
    const int h = u & 3, n = (u >> 2) & 31, b = u >> 7; const size_t row0 = (size_t)b * SEQ + (size_t)n * 64;
#pragma unroll
    for (int i = 0; i < 2; ++i) { const int id = tid + 512 * i, j = id >> 4, seg = id & 15; R.k[i] = *(const u32x4*)(P + (row0 + j) * EVEN_IN + 512 + h * 128 + seg * 8); }
#pragma unroll
    for (int i = 0; i < 4; ++i) { const int id = tid + 512 * i, j = id >> 5, seg = id & 31; R.v[i] = *(const u32x4*)(P + (row0 + j) * EVEN_IN + 1024 + h * 256 + seg * 8); }
    if (n > 0) {
#pragma unroll
        for (int i = 0; i < 8; ++i) { const int id = tid + 512 * i, e = id >> 4, seg = id & 15; R.s[i] = *(const u32x4*)(STt + (size_t)u * 32768 + e * 128 + seg * 8); } }
#pragma unroll
    for (int s = 0; s < 4; ++s) R.q[s] = *(const bf16x8*)(P + (row0 + 16 * it + fr) * EVEN_IN + h * 128 + 32 * s + 8 * fq);
    { const int eh = (tid >> 6) & 1; const bf16* gp = P + (row0 + 16 * it + fr) * EVEN_IN + 2048 + h * 256 + 128 * eh + 4 * fq;
#pragma unroll
      for (int k = 0; k < 8; ++k) R.g[k] = *(const uint2*)(gp + 16 * k); }
}
__device__ __forceinline__ void ret_unit(LAS unsigned char* lds, const bf16* P, const bf16* STt, bf16* MIX, int u, RetRegs& R, int unext) {
    constexpr int KST = 272, VST = 528, SST = 272;
    LAS unsigned char* Ks = lds; LAS unsigned char* Vs = lds + 64 * KST; LAS unsigned char* Ss = Vs + 64 * VST; LAS float* dec = (LAS float*)(Ss + 256 * SST); LAS float* red = dec + 128;
    const int tid = opaque_tid(), lane = tid & 63, w = tid >> 6, fr = lane & 15, fq = lane >> 4, it = w >> 1, eh = w & 1;
    const int h = u & 3, n = (u >> 2) & 31, b = u >> 7;
    const float log2g = log2f(1.0f - exp2f(-5.0f - (float)h));
    const size_t row0 = (size_t)b * SEQ + (size_t)n * 64;
    __syncthreads();
    if (tid < 65) dec[tid] = exp2f(log2g * (float)tid);
#pragma unroll
    for (int i = 0; i < 2; ++i) { const int id = tid + 512 * i, j = id >> 4, seg = id & 15; *(LAS u32x4*)(Ks + j * KST + seg * 16) = R.k[i]; }
#pragma unroll
    for (int i = 0; i < 4; ++i) { const int id = tid + 512 * i, j = id >> 5, seg = id & 31; *(LAS u32x4*)(Vs + j * VST + seg * 16) = R.v[i]; }
    if (n > 0) {
#pragma unroll
        for (int i = 0; i < 8; ++i) { const int id = tid + 512 * i, e = id >> 4, seg = id & 15; *(LAS u32x4*)(Ss + e * SST + seg * 16) = R.s[i]; } }
    bf16x8 qf[4];
#pragma unroll
    for (int s = 0; s < 4; ++s) qf[s] = R.q[s];
    uint2 gcur[8];
#pragma unroll
    for (int k = 0; k < 8; ++k) gcur[k] = R.g[k];
    __syncthreads();
    if (unext >= 0) ret_load(R, P, STt, unext, tid, it, fr, fq);
    const int i_loc = 16 * it + fr;
    bf16x8 pf[2];
    { f32x4 pt[4];
#pragma unroll
      for (int t = 0; t < 4; ++t) { f32x4 a = (f32x4){0.f, 0.f, 0.f, 0.f};
#pragma unroll
          for (int s = 0; s < 4; ++s) { const bf16x8 kf = *(const LAS bf16x8*)(Ks + (16 * t + fr) * KST + (32 * s + 8 * fq) * 2); a = __builtin_amdgcn_mfma_f32_16x16x32_bf16(kf, qf[s], a, 0, 0, 0); }
#pragma unroll
          for (int r = 0; r < 4; ++r) { const int dj = i_loc - (16 * t + 4 * fq + r); a[r] *= dec[dj < 0 ? -dj : dj]; }
          pt[t] = a; }
      pf[0] = (bf16x8)pg8::pack8(pt[0], pt[1]); pf[1] = (bf16x8)pg8::pack8(pt[2], pt[3]); }
    f32x4 o[8];
#pragma unroll
    for (int k = 0; k < 8; ++k) o[k] = (f32x4){0.f, 0.f, 0.f, 0.f};
    if (n > 0) {
#pragma unroll
        for (int k = 0; k < 8; ++k)
#pragma unroll
            for (int s = 0; s < 4; ++s) { const bf16x8 sf = *(const LAS bf16x8*)(Ss + (16 * (8 * eh + k) + fr) * SST + (32 * s + 8 * fq) * 2); o[k] = __builtin_amdgcn_mfma_f32_16x16x32_bf16(sf, qf[s], o[k], 0, 0, 0); }
        const float qd = dec[i_loc + 1];
#pragma unroll
        for (int k = 0; k < 8; ++k) o[k] = o[k] * qd;
    }
#pragma unroll
    for (int s = 0; s < 2; ++s)
#pragma unroll
        for (int k = 0; k < 8; ++k) { const LAS unsigned char* vp = Vs + (32 * s + 4 * fq + (fr >> 2)) * VST + (16 * (8 * eh + k) + 4 * (fr & 3)) * 2; const bf16x8 vf = tr_frag(vp, vp + 16 * VST);
            o[k] = __builtin_amdgcn_mfma_f32_16x16x32_bf16(vf, pf[s], o[k], 0, 0, 0); }
    float s1 = 0.f, s2 = 0.f;
#pragma unroll
    for (int k = 0; k < 8; ++k)
#pragma unroll
        for (int r = 0; r < 4; ++r) { s1 += o[k][r]; s2 += o[k][r] * o[k][r]; }
    s1 += xshfl<16>(s1); s1 = sum_halves(s1); s2 += xshfl<16>(s2); s2 = sum_halves(s2);
    if (fq == 0) { red[(w * 16 + fr) * 2] = s1; red[(w * 16 + fr) * 2 + 1] = s2; }
    __syncthreads();
    { const int wo = w ^ 1; s1 += red[(wo * 16 + fr) * 2]; s2 += red[(wo * 16 + fr) * 2 + 1]; }
    const float mu = s1 * (1.0f / 256.0f), var = fmaxf(s2 * (1.0f / 256.0f) - mu * mu, 0.f), rs = rsqrtf(var + EPS);
    const bf16* gp = P + (row0 + i_loc) * EVEN_IN + 2048 + h * 256 + 128 * eh + 4 * fq; unsigned char* dst = (unsigned char*)MIX + (row0 + i_loc) * EVEN_MIX + h * 256 + 128 * eh + 4 * fq;
#pragma unroll
    for (int k = 0; k < 8; ++k) { const uint2 gv = gcur[k];
        const float g0 = __uint_as_float(gv.x << 16), g1 = __uint_as_float(gv.x & 0xffff0000u), g2 = __uint_as_float(gv.y << 16), g3 = __uint_as_float(gv.y & 0xffff0000u);
        *(unsigned*)(dst + 16 * k) = pg8::pk4_fp8((o[k][0] - mu) * rs * g0, (o[k][1] - mu) * rs * g1, (o[k][2] - mu) * rs * g2, (o[k][3] - mu) * rs * g3); }
}
__device__ __forceinline__ void phase_e3(LAS unsigned char* lds, const bf16* P, const bf16* STt, bf16* MIX, int c0, int G) {
    RetRegs R; { const int tid = opaque_tid(), lane = tid & 63; if (c0 < 1024) ret_load(R, P, STt, c0, tid, tid >> 7, lane & 15, lane >> 4); }
    for (int u = c0; u < 1024; u += G) ret_unit(lds, P, STt, MIX, u, R, u + G < 1024 ? u + G : -1);
}
typedef float f32x4g __attribute__((ext_vector_type(4)));
__device__ __forceinline__ void phase_mod(LAS unsigned char* lds, const float* c, const float* ada_w, const float* ada_b, float* MOD, int c0, int G) {
    LAS float* ca = (LAS float*)lds; LAS float* red = (LAS float*)(lds + 32768);
    const int tid = opaque_tid(), lane = tid & 63, w = tid >> 6;
    __syncthreads();
    for (int i = tid; i < 8192; i += 512) { const float v = c[i]; ca[i] = v / (1.0f + __expf(-v)); }
    __syncthreads();
    for (int u = c0; u < DEPTH * 96; u += G) { const int l = u / 96, n0 = (u % 96) * 64;
        const float* wp = ada_w + ((size_t)l * 1024 + 128 * w) * 6144 + n0 + lane; float acc[8];
#pragma unroll
        for (int b = 0; b < 8; ++b) acc[b] = 0.f;
#pragma unroll 32
        for (int k = 0; k < 128; ++k) { const float wv = __builtin_nontemporal_load(wp + (size_t)k * 6144);
#pragma unroll
            for (int b = 0; b < 8; ++b) acc[b] += ca[b * 1024 + 128 * w + k] * wv; }
#pragma unroll
        for (int b = 0; b < 8; ++b) red[(w * 8 + b) * 64 + lane] = acc[b];
        __syncthreads();
        { const int b = tid >> 6; float s = 0.f;
#pragma unroll
          for (int ww = 0; ww < 8; ++ww) s += red[(ww * 8 + b) * 64 + lane];
          MOD[(size_t)(l * 8 + b) * 6144 + n0 + lane] = s + ada_b[l * 6144 + n0 + lane]; }
        __syncthreads(); }
}
__device__ __forceinline__ void phase_rope(float* COS, float* SIN, int gtid, int nthr) {
    for (int i = gtid; i < SEQ * 64; i += nthr) { const int pos = i >> 6, d = i & 63; const float inv = powf(10000.0f, -(float)d / 64.0f); const float ang = (float)pos * inv; COS[i] = cosf(ang); SIN[i] = sinf(ang); }
}
__device__ __forceinline__ f32x4g ld4bf(const bf16* p) { const uint2 y = *(const uint2*)p; return (f32x4g){__uint_as_float(y.x << 16), __uint_as_float(y.x & 0xffff0000u), __uint_as_float(y.y << 16), __uint_as_float(y.y & 0xffff0000u)}; }
__device__ __forceinline__ void st4bf(bf16* p, const f32x4g v) { uint2 pk; pk.x = pg8::cvt_pk_bf16(v[0], v[1]); pk.y = pg8::cvt_pk_bf16(v[2], v[3]); *(uint2*)p = pk; }
template <bool IN_F32, bool OUT_F32> __device__ __forceinline__ void phase_norm1_generic(const void* Xin_, void* Xout_, bool store_x, const bf16* YS, const float* MODprev, bool combine, const float* g, const float* MODl, bf16* H, bool do_norm, int gw, int ngw, bool h_fp8 = false, unsigned char* H8 = nullptr) {
    const int lane = opaque_tid() & 63;
    for (int row = gw; row < T_TOK; row += ngw) { const int b = row / SEQ; f32x4g v[4];
#pragma unroll
        for (int j = 0; j < 4; ++j) { if constexpr (IN_F32) v[j] = *(const f32x4g*)((const float*)Xin_ + (size_t)row * DM + 256 * j + 4 * lane); else v[j] = ld4bf((const bf16*)Xin_ + (size_t)row * DM + 256 * j + 4 * lane); }
        if (combine) { const float* g2 = MODprev + (size_t)b * 6144 + 5120;
#pragma unroll
            for (int j = 0; j < 4; ++j) { f32x4g s = (f32x4g){0.f, 0.f, 0.f, 0.f};
#pragma unroll
                for (int k = 0; k < 4; ++k) { const int y = *(const int*)((const unsigned char*)YS + ((size_t)row * 4 + k) * DM + 256 * j + 4 * lane);
                    const auto lo = __builtin_amdgcn_cvt_pk_f32_fp8(y, false), hi = __builtin_amdgcn_cvt_pk_f32_fp8(y, true); s[0] += lo[0]; s[1] += lo[1]; s[2] += hi[0]; s[3] += hi[1]; }
                v[j] = v[j] + *(const f32x4g*)(g2 + 256 * j + 4 * lane) * (s * YSCALE_INV); } }
        if (store_x) {
#pragma unroll
            for (int j = 0; j < 4; ++j) { if constexpr (OUT_F32) __builtin_nontemporal_store(v[j], (f32x4g*)((float*)Xout_ + (size_t)row * DM + 256 * j + 4 * lane));   else st4bf((bf16*)Xout_ + (size_t)row * DM + 256 * j + 4 * lane, v[j]); } }
        if (do_norm) { float ss = 0.f;
#pragma unroll
            for (int j = 0; j < 4; ++j) ss += (v[j][0] * v[j][0] + v[j][1] * v[j][1]) + (v[j][2] * v[j][2] + v[j][3] * v[j][3]);
            ss = wave_sum(ss); const float r = rsqrtf(ss * (1.0f / DM) + EPS); const float* mod = MODl + (size_t)b * 6144;
#pragma unroll
            for (int j = 0; j < 4; ++j) { const int k = 256 * j + 4 * lane; const f32x4g gv = *(const f32x4g*)(g + k), sc = *(const f32x4g*)(mod + 1024 + k), sh = *(const f32x4g*)(mod + k);
                const f32x4g hv = v[j] * r * gv * (sc + 1.0f) + sh;
                if (H8) *(unsigned*)(H8 + (size_t)row * DM + k) = pg8::pk4_fp8(hv[0], hv[1], hv[2], hv[3]);
                if (h_fp8) *(unsigned*)((unsigned char*)H + (size_t)row * DM + k) = pg8::pk4_fp8(hv[0], hv[1], hv[2], hv[3]);
                else { uint2 pk; pk.x = pg8::cvt_pk_bf16(hv[0], hv[1]); pk.y = pg8::cvt_pk_bf16(hv[2], hv[3]); *(uint2*)(H + (size_t)row * DM + k) = pk; } } }
    }
}
template <bool IN_F32, bool OUT_F32> __device__ __forceinline__ void phase_norm1(const void* Xin_, void* Xout_, bool store_x, const bf16* YS, const float* MODprev, bool combine, const float* g, const float* MODl, bf16* H, bool do_norm, int gw, int ngw, bool h_fp8 = false, unsigned char* H8 = nullptr) {
    const int rpw = T_TOK / ngw;
    if (rpw * ngw != T_TOK || (SEQ % rpw) != 0 || combine != !IN_F32 || do_norm != !OUT_F32 || !store_x) { phase_norm1_generic<IN_F32, OUT_F32>(Xin_, Xout_, store_x, YS, MODprev, combine, g, MODl, H, do_norm, gw, ngw, h_fp8, H8); return; }
    constexpr bool COMB = !IN_F32, NORM = !OUT_F32;
    const int lane = opaque_tid() & 63; const int row0 = gw * rpw, rend = row0 + rpw, b = row0 / SEQ;
    f32x4g g2v[4], gv[4], scv[4], shv[4];
#pragma unroll
    for (int j = 0; j < 4; ++j) { const int k = 256 * j + 4 * lane;
        if constexpr (COMB) g2v[j] = *(const f32x4g*)(MODprev + (size_t)b * 6144 + 5120 + k) * YSCALE_INV;
        if constexpr (NORM) { gv[j] = *(const f32x4g*)(g + k); scv[j] = *(const f32x4g*)(MODl + (size_t)b * 6144 + 1024 + k) + 1.0f; shv[j] = *(const f32x4g*)(MODl + (size_t)b * 6144 + k); gv[j] = gv[j] * scv[j]; } }
    f32x4g xfa[4], xfb[4]; uint2 xba[4], xbb[4]; int ya[16], yb[16];
#define N1_LOAD(XF, XB_, Y, r_) do { \
        _Pragma("unroll") for (int j = 0; j < 4; ++j) { if constexpr (IN_F32) XF[j] = *(const f32x4g*)((const float*)Xin_ + (size_t)(r_) * DM + 256 * j + 4 * lane); else XB_[j] = *(const uint2*)((const bf16*)Xin_ + (size_t)(r_) * DM + 256 * j + 4 * lane); } \
        if constexpr (COMB) { _Pragma("unroll") for (int j = 0; j < 4; ++j) { _Pragma("unroll") for (int k = 0; k < 4; ++k) Y[4 * j + k] = *(const int*)((const unsigned char*)YS + ((size_t)(r_) * 4 + k) * DM + 256 * j + 4 * lane); } } \
    } while (0)
#define N1_PROC(XF, XB_, Y, r_) do { f32x4g v[4]; \
        _Pragma("unroll") for (int j = 0; j < 4; ++j) { if constexpr (IN_F32) v[j] = XF[j]; else v[j] = (f32x4g){__uint_as_float(XB_[j].x << 16), __uint_as_float(XB_[j].x & 0xffff0000u), __uint_as_float(XB_[j].y << 16), __uint_as_float(XB_[j].y & 0xffff0000u)}; } \
        if constexpr (COMB) { _Pragma("unroll") for (int j = 0; j < 4; ++j) { f32x4g s = (f32x4g){0.f, 0.f, 0.f, 0.f}; \
            _Pragma("unroll") for (int k = 0; k < 4; ++k) { const auto lo = __builtin_amdgcn_cvt_pk_f32_fp8(Y[4 * j + k], false), hi = __builtin_amdgcn_cvt_pk_f32_fp8(Y[4 * j + k], true); s[0] += lo[0]; s[1] += lo[1]; s[2] += hi[0]; s[3] += hi[1]; } \
            v[j] = v[j] + g2v[j] * s; } } \
        _Pragma("unroll") for (int j = 0; j < 4; ++j) { if constexpr (OUT_F32) __builtin_nontemporal_store(v[j], (f32x4g*)((float*)Xout_ + (size_t)(r_) * DM + 256 * j + 4 * lane)); else st4bf((bf16*)Xout_ + (size_t)(r_) * DM + 256 * j + 4 * lane, v[j]); } \
        if constexpr (NORM) { float ss = 0.f; \
            _Pragma("unroll") for (int j = 0; j < 4; ++j) ss += (v[j][0] * v[j][0] + v[j][1] * v[j][1]) + (v[j][2] * v[j][2] + v[j][3] * v[j][3]); \
            ss = wave_sum(ss); const float rr = rsqrtf(ss * (1.0f / DM) + EPS); \
            _Pragma("unroll") for (int j = 0; j < 4; ++j) { const int k = 256 * j + 4 * lane; const f32x4g hv = v[j] * rr * gv[j] + shv[j]; \
                if (H8) *(unsigned*)(H8 + (size_t)(r_) * DM + k) = pg8::pk4_fp8(hv[0], hv[1], hv[2], hv[3]); \
                if (h_fp8) *(unsigned*)((unsigned char*)H + (size_t)(r_) * DM + k) = pg8::pk4_fp8(hv[0], hv[1], hv[2], hv[3]); \
                else { uint2 pk; pk.x = pg8::cvt_pk_bf16(hv[0], hv[1]); pk.y = pg8::cvt_pk_bf16(hv[2], hv[3]); *(uint2*)(H + (size_t)(r_) * DM + k) = pk; } } } \
    } while (0)
    int row = row0;
    N1_LOAD(xfa, xba, ya, row);
    for (;;) {
        if (row + 1 >= rend) { N1_PROC(xfa, xba, ya, row); break; }
        N1_LOAD(xfb, xbb, yb, row + 1); asm volatile("" ::: "memory"); N1_PROC(xfa, xba, ya, row); ++row;
        if (row + 1 >= rend) { N1_PROC(xfb, xbb, yb, row); break; }
        N1_LOAD(xfa, xba, ya, row + 1); asm volatile("" ::: "memory"); N1_PROC(xfb, xbb, yb, row); ++row;
    }
#undef N1_LOAD
#undef N1_PROC
}
__device__ __forceinline__ void phase_router(LAS unsigned char* lds, const bf16* X, const float* gffn, const float* MODl, const float* rw, const float* rb, bf16* H,
                                             int* RSLOT, float* RGATE, int* COUNTS, int c0, int G) {
    LAS float* wf = (LAS float*)lds; LAS float* GV = (LAS float*)(lds + 131072); LAS float* SH = GV + 1024;
    LAS float* rs = (LAS float*)(lds + LDS_CTL_OFF + 1536); LAS int* hist = (LAS int*)(rs + 64); LAS int* base = hist + 32; LAS int* rank = base + 32; LAS int* eid = rank + 256; LAS float* gl = (LAS float*)(eid + 256);
    const int tid = opaque_tid(), lane = tid & 63, w = tid >> 6, fr = lane & 15, kq = lane >> 4;
    for (int unit = c0; unit < T_TOK / 64; unit += G) { const int t0 = unit * 64, b = t0 / SEQ; const float* mod = MODl + (size_t)b * 6144;
        __syncthreads();
        f32x4g rwv[16];
#pragma unroll
        for (int i = 0; i < 16; ++i) rwv[i] = *(const f32x4g*)(rw + 4 * (tid + 512 * i));
        for (int k = tid; k < DM; k += 512) { GV[k] = gffn[k] * (1.0f + mod[4096 + k]); SH[k] = mod[3072 + k]; }
        if (tid < 32) hist[tid] = 0;
        __syncthreads();
#pragma unroll
        for (int i = 0; i < 8; ++i) { const int row = t0 + 8 * w + i; f32x4g v[4]; float ss = 0.f;
#pragma unroll
            for (int j = 0; j < 4; ++j) { v[j] = ld4bf(X + (size_t)row * DM + 256 * j + 4 * lane); ss += (v[j][0] * v[j][0] + v[j][1] * v[j][1]) + (v[j][2] * v[j][2] + v[j][3] * v[j][3]); }
            ss = wave_sum(ss); const float r = rsqrtf(ss * (1.0f / DM) + EPS); if (lane == 0) rs[8 * w + i] = r;
#pragma unroll
            for (int j = 0; j < 4; ++j) { const int k = 256 * j + 4 * lane; const f32x4g gv = *(const LAS f32x4g*)(GV + k), sh = *(const LAS f32x4g*)(SH + k);
                const f32x4g hv = v[j] * r * gv + sh; *(unsigned*)((unsigned char*)H + (size_t)row * DM + k) = pg8::pk4_fp8(hv[0], hv[1], hv[2], hv[3]); } }
#pragma unroll
        for (int i = 0; i < 16; ++i) { const int q = tid + 512 * i, k = q >> 3, e = (q & 7) * 4; const int l = (k >> 8) * 16 + (e & 15), et = e >> 4, s = k & 255; LAS float* d = wf + ((s >> 2) * 2 + et) * 256 + 4 * l + (s & 3);
            d[0] = rwv[i][0]; d[4] = rwv[i][1]; d[8] = rwv[i][2]; d[12] = rwv[i][3]; }
        __syncthreads();
        const int tg = w & 3, kh = w >> 2, tok = t0 + 16 * tg + fr; const float r = rs[16 * tg + fr];
        f32x4 acc0 = (f32x4){0.f, 0.f, 0.f, 0.f}, acc1 = (f32x4){0.f, 0.f, 0.f, 0.f};
        { const bf16* xp = X + (size_t)tok * DM + 256 * kq + 128 * kh; const LAS float* gp = GV + 256 * kq + 128 * kh; const LAS float* shp = SH + 256 * kq + 128 * kh; const LAS float* wp = wf + (size_t)(64 * kh) * 256 + 4 * lane;
          uint2 xr[32];
#pragma unroll
          for (int u = 0; u < 32; ++u) xr[u] = *(const uint2*)(xp + 4 * u);
#pragma unroll
          for (int u = 0; u < 32; ++u) { const f32x4g xv = (f32x4g){__uint_as_float(xr[u].x << 16), __uint_as_float(xr[u].x & 0xffff0000u), __uint_as_float(xr[u].y << 16), __uint_as_float(xr[u].y & 0xffff0000u)}, gv = *(const LAS f32x4g*)(gp + 4 * u), sh = *(const LAS f32x4g*)(shp + 4 * u);
              const f32x4g hv = xv * r * gv + sh; const f32x4g w0 = *(const LAS f32x4g*)(wp + (u * 2) * 256), w1 = *(const LAS f32x4g*)(wp + (u * 2 + 1) * 256);
#pragma unroll
              for (int q = 0; q < 4; ++q) { acc0 = __builtin_amdgcn_mfma_f32_16x16x4f32(w0[q], hv[q], acc0, 0, 0, 0); acc1 = __builtin_amdgcn_mfma_f32_16x16x4f32(w1[q], hv[q], acc1, 0, 0, 0); } } }
        __syncthreads();
        if (kh == 1) { *(LAS f32x4*)(wf + (tg * 64 + lane) * 8) = acc0; *(LAS f32x4*)(wf + (tg * 64 + lane) * 8 + 4) = acc1; }
        __syncthreads();
        if (kh == 0) {
            acc0 = acc0 + *(const LAS f32x4*)(wf + (tg * 64 + lane) * 8); acc1 = acc1 + *(const LAS f32x4*)(wf + (tg * 64 + lane) * 8 + 4);
            float vals[8];
#pragma unroll
            for (int q = 0; q < 4; ++q) { vals[q] = acc0[q] + rb[4 * kq + q]; vals[4 + q] = acc1[q] + rb[16 + 4 * kq + q]; }
            unsigned taken = 0u; float tv[4]; int ti[4];
#pragma unroll
            for (int rr = 0; rr < 4; ++rr) { float bv = -3.0e38f; int bi = 64;
#pragma unroll
                for (int cc = 0; cc < 8; ++cc) { const int e = 16 * (cc >> 2) + 4 * kq + (cc & 3); const float v = ((taken >> cc) & 1u) ? -3.0e38f : vals[cc]; if (v > bv || (v == bv && e < bi)) { bv = v; bi = e; } }
                { const float ov = xshfl<16>(bv); const int oi = xshfl_i<16>(bi); if (ov > bv || (ov == bv && oi < bi)) { bv = ov; bi = oi; } }
                { const auto rv = __builtin_amdgcn_permlane32_swap(__float_as_uint(bv), __float_as_uint(bv), false, false); const auto ri = __builtin_amdgcn_permlane32_swap((unsigned)bi, (unsigned)bi, false, false);
                  const float v0 = __uint_as_float(rv[0]), v1 = __uint_as_float(rv[1]); const int i0 = (int)ri[0], i1 = (int)ri[1]; const bool take1 = v1 > v0 || (v1 == v0 && i1 < i0); bv = take1 ? v1 : v0; bi = take1 ? i1 : i0; }
                tv[rr] = bv; ti[rr] = bi; if (((bi >> 2) & 3) == kq) taken |= 1u << (((bi >> 4) << 2) | (bi & 3)); }
            const float e1 = __expf(tv[1] - tv[0]), e2 = __expf(tv[2] - tv[0]), e3 = __expf(tv[3] - tv[0]), inv = 1.0f / (1.0f + e1 + e2 + e3);
            if (kq == 0) { const float gt[4] = {inv, e1 * inv, e2 * inv, e3 * inv};
#pragma unroll
                for (int rr = 0; rr < 4; ++rr) { const int a = (16 * tg + fr) * 4 + rr; eid[a] = ti[rr]; gl[a] = gt[rr]; rank[a] = atomicAdd((int*)(hist + ti[rr]), 1); } }
        }
        __syncthreads();
        if (tid < 32) base[tid] = atomicAdd(&COUNTS[tid], hist[tid]);
        __syncthreads();
        if (tid < 256) { const int e = eid[tid], dest = e * EREG + base[e] + rank[tid]; RSLOT[dest] = t0 * 4 + tid; RGATE[dest] = gl[tid]; }
    }
}
__device__ __forceinline__ void moe_prefix(LAS int* ps, const int* COUNTS) {
    if (opaque_tid() == 0) { int a = 0; for (int e = 0; e < NEXP; ++e) { const int cnt = COUNTS[e]; ps[e] = a; ps[64 + e] = cnt; a += ((cnt + 255) >> 8) << 8; } ps[NEXP] = a; }
    __syncthreads();
}
__device__ __forceinline__ void phase_gather(LAS unsigned char* lds, const bf16* H, const int* TOPI, const float* TOPG, const int* POS, const int* COUNTS, bf16* XS, int* ROWSLOT, float* ROWGATE, int c0, int G) {
    LAS int* ps = (LAS int*)lds; const int tid = opaque_tid(), lane = tid & 63, w = tid >> 6;
    __syncthreads(); moe_prefix(ps, COUNTS);
    for (int a = c0 * 8 + w; a < T_TOK * 4; a += G * 8) { const int t = a >> 2, e = TOPI[a], dest = ps[e] + POS[a];
        const u32x4* src = (const u32x4*)((const unsigned char*)H + (size_t)t * DM); u32x4* dst = (u32x4*)((unsigned char*)XS + (size_t)dest * DM); dst[lane] = src[lane];
        if (lane == 0) { ROWSLOT[dest] = a; ROWGATE[dest] = TOPG[a]; } }
    for (int e = c0; e < NEXP; e += G) for (int r = ps[e] + ps[64 + e] + tid; r < ps[e + 1]; r += 512) ROWSLOT[r] = -1;
}
#define XB_TMO      128
#define XB_XCNT(j)  (256  + 64 * (j))
#define XB_XSUB(j)  (1280 + 64 * (j))
#define XB_XGEN(j)  (2304 + 64 * (j))
#define XB_TOP      3328
#define XB_TOPGEN   3392
#define XCD_BAR_WORDS 3456
#define XB_SPIN_CAP (1u << 18)
#define LAS __attribute__((address_space(3)))

__device__ __forceinline__ unsigned xb_ld(unsigned* p)              { return __hip_atomic_load(p, __ATOMIC_RELAXED, __HIP_MEMORY_SCOPE_AGENT); }
__device__ __forceinline__ unsigned xb_add(unsigned* p, unsigned v) { return __hip_atomic_fetch_add(p, v, __ATOMIC_RELAXED, __HIP_MEMORY_SCOPE_AGENT); }
__device__ __forceinline__ unsigned xb_xcc_id() { return (unsigned)__builtin_amdgcn_s_getreg((3 << 11) | 20) & 0xFu; }
#define XB_SPIN(cond, bar) do { unsigned _sp = 0; while (cond) { __builtin_amdgcn_s_sleep(1); \
    if ((++_sp & 255u) == 0u) { if (xb_ld(&(bar)[XB_TMO])) break; if (_sp > XB_SPIN_CAP) { atomicAdd(&(bar)[XB_TMO], 1u); break; } } } } while (0)

struct XcdBarrier {
    unsigned* bar; unsigned x;
    volatile LAS unsigned* st;
};

__device__ __forceinline__ XcdBarrier xcd_barrier_post(unsigned* bar, volatile LAS unsigned* st) {
    XcdBarrier b; b.bar = bar; b.x = xb_xcc_id(); b.st = st;
    if (opaque_tid() == 0) (void)xb_add(&bar[XB_XCNT(b.x)], 1u);
    return b;
}
__device__ __forceinline__ void xcd_barrier_complete(unsigned* bar, unsigned x, unsigned& nloc, unsigned& nx) {
    const unsigned G = gridDim.x * gridDim.y * gridDim.z;
    unsigned sum, cnt, mine, sp = 0u;
    for (;;) {
        sum = 0u; cnt = 0u; mine = 0u;
#pragma unroll
        for (unsigned j = 0; j < 16; ++j) { const unsigned c = xb_ld(&bar[XB_XCNT(j)]); sum += c; cnt += (c > 0u) ? 1u : 0u; mine = (j == x) ? c : mine; }
        if (sum == G) break;
        __builtin_amdgcn_s_sleep(1);
        if ((++sp & 255u) == 0u) { if (xb_ld(&bar[XB_TMO])) break; if (sp > XB_SPIN_CAP) { atomicAdd(&bar[XB_TMO], 1u); break; } }
    }
    nloc = mine > 0u ? mine : 1u; nx = cnt > 0u ? cnt : 1u;
}

__device__ __forceinline__ void xcd_barrier(const XcdBarrier& b) {
    asm volatile("s_waitcnt vmcnt(0)" ::: "memory");
    __syncthreads();
    if (opaque_tid() == 0) {
        unsigned* bar = b.bar;
        __builtin_amdgcn_s_waitcnt(0);
        unsigned nloc = b.st[0], nx = b.st[1];
        if (nloc == 0u) { xcd_barrier_complete(bar, b.x, nloc, nx); b.st[0] = nloc; b.st[1] = nx; }
        const unsigned old = xb_add(&bar[XB_XSUB(b.x)], 1u);
        const unsigned gen = old / nloc;
        if (old + 1u == (gen + 1u) * nloc) {
            __builtin_amdgcn_fence(__ATOMIC_RELEASE, "agent");
            asm volatile("s_waitcnt vmcnt(0)" ::: "memory");
            const unsigned og = xb_add(&bar[XB_TOP], 1u);
            const unsigned tg = og / nx;
            if (og + 1u == (tg + 1u) * nx) xb_add(&bar[XB_TOPGEN], 1u);
            else XB_SPIN(xb_ld(&bar[XB_TOPGEN]) == tg, bar);
            __builtin_amdgcn_fence(__ATOMIC_ACQUIRE, "agent");
            xb_add(&bar[XB_XGEN(b.x)], 1u);
            asm volatile("s_waitcnt vmcnt(0)" ::: "memory");
        } else {
            XB_SPIN(xb_ld(&bar[XB_XGEN(b.x)]) == gen, bar);
            __builtin_amdgcn_fence(__ATOMIC_ACQUIRE, "agent");
            asm volatile("s_waitcnt vmcnt(0)" ::: "memory");
        }
    }
    __syncthreads();
}
#ifndef PROBE_DUP
#define PROBE_DUP 0
#endif
#define DUP(bit, ...) do { __VA_ARGS__; if (PROBE_DUP & (bit)) { __VA_ARGS__; } } while (0)
#ifndef MK_PER_PHASE
#define MK_PER_PHASE 0
#endif
constexpr int N_PHASES = 2 + 12 * DEPTH;
struct Args { const float* in[23]; float* out; unsigned char* ws; int ph_lo, ph_hi; };
__device__ __forceinline__ void moe_table(LAS int* tab, const int* COUNTS, int NT, int G, int c, const int* RSLOT, LAS unsigned short* gath) {
    __syncthreads();
    const int tid = opaque_tid();
    if (tid < NEXP) tab[160 + tid] = COUNTS[tid];
    __syncthreads();
    if (tid == 0) { int a = 0, row = 0; for (int e = 0; e < NEXP; ++e) { const int mt = (tab[160 + e] + 255) >> 8; tab[e] = a; tab[64 + e] = row; tab[128 + e] = mt; a += mt * NT; row += mt; } tab[32] = a; }
    __syncthreads();
    if (tid < 14) { const int nwg = tab[32]; const long L = (long)tid * G + c;
        if (L < nwg) { int w = (int)L; { const int q = nwg / 8, r = nwg % 8, xcd = w % 8, off = w / 8; w = (xcd < r ? xcd * (q + 1) : r * (q + 1) + (xcd - r) * q) + off; }
            int e = 0; for (int k = 1; k < 32; ++k) e += (w >= tab[k]) ? 1 : 0;
            const int local = w - tab[e], mt = tab[128 + e]; tab[194 + 2 * tid] = tab[64 + e] + local % mt; tab[195 + 2 * tid] = e * NT + local / mt; }
        if (tid == 0) { const int mine = nwg > c ? (nwg - c + G - 1) / G : 0; tab[192] = mine < 14 ? mine : 14; } }
    __syncthreads();
    if (gath) {
        const int mine = tab[192];
        int sl[7]; const int lim = mine * 256;
        if (mine > 0) {
#pragma unroll
        for (int ps = 0; ps < 7; ++ps) { const int idx = tid + 512 * ps, ic = idx < lim ? idx : 0, i = ic >> 8, r = ic & 255, pm = tab[194 + 2 * i], e = tab[195 + 2 * i] / NT, rl = (pm - tab[64 + e]) * 256 + r, cnt = tab[160 + e];
            const int rlc = rl < cnt ? rl : 0; const int v = RSLOT[e * EREG + rlc]; sl[ps] = rl < cnt ? (v >> 2) : 0; }
#pragma unroll
        for (int ps = 0; ps < 7; ++ps) { const int idx = tid + 512 * ps; if (idx < lim) gath[idx] = (unsigned short)sl[ps]; } }
        __syncthreads(); }
}
typedef __attribute__((address_space(1))) unsigned char* gptr_t;
__device__ __forceinline__ unsigned char* opq(unsigned char* p) { gptr_t g = (gptr_t)p; asm volatile("" : "+s"(g)); return (unsigned char*)g; }
__global__ void __launch_bounds__(512, 2) mega(Args a) {
    extern __shared__ __attribute__((aligned(16))) unsigned char lds_raw[];
    LAS unsigned char* L = (LAS unsigned char*)lds_raw;
    const int G = (int)gridDim.x, c0 = (int)blockIdx.x;
    const int lo = a.ph_lo, hi = a.ph_hi;
#define WSP(type, off) ((type*)(opq(a.ws) + (off)))
#define GW (c0 * 8 + __builtin_amdgcn_readfirstlane(opaque_tid() >> 6))
#define NGW (G * 8)
    { const int tid = opaque_tid(); if (tid < 4) ((LAS unsigned*)(L + LDS_CTL_OFF + 1024))[tid] = 0u; }
    __syncthreads();
    XcdBarrier bar = xcd_barrier_post(WSP(unsigned, WS_CTL) + CW_BAR, (volatile LAS unsigned*)(L + LDS_CTL_OFF + 1024));
#define IN(k) (lo <= (k) && (k) < hi)
#define SEAM(k) do { if ((k) + 1 < hi) { XcdBarrier b2_ = bar; b2_.bar = (unsigned*)opq((unsigned char*)bar.bar); xcd_barrier(b2_); if (PROBE_DUP & 8192) { XcdBarrier b3_ = bar; b3_.bar = (unsigned*)opq((unsigned char*)bar.bar); xcd_barrier(b3_); } } } while (0)
    if (IN(0)) {
        DUP(1, {
        phase_rope(WSP(float, WS_COS), WSP(float, WS_SIN), c0 * 512 + opaque_tid(), G * 512);
        phase_mod(L, a.in[1], a.in[2], a.in[3], WSP(float, WS_MOD), c0, G);
        __syncthreads();
        convert_job<1024, 4096, 1, 2, 0, false, 0, 32>(L, a.in[6], WSP(bf16, WS_WEVIN), GW, NGW);
        convert_job<1024, 4096, 1, 2, 0, true, 32, 96>(L, a.in[6], WSP(bf16, WS_WEVIN8), GW, NGW);
        convert_job<1536, 1024, 0, 2, CVT_T0, true>(L, a.in[7], WSP(bf16, WS_WEVOUT), GW, NGW);
        convert_job<1024, 3072, 2, 2, CVT_T0 + CVT_T1, true>(L, a.in[12], WSP(bf16, WS_WODIN), GW, NGW);
        convert_job<1024, 1024, 0, 2, CVT_T0 + CVT_T1 + CVT_T2, true>(L, a.in[13], WSP(bf16, WS_WODOUT), GW, NGW);
        convert_job<1024, 2048, 3, 128, CVT_T0 + CVT_T1 + CVT_T2 + CVT_T3, true>(L, a.in[19], WSP(bf16, WS_W1), GW, NGW);
        convert_job<1024, 1024, 0, 128, CVT_T0 + CVT_T1 + CVT_T2 + CVT_T3 + CVT_T4, true>(L, a.in[21], WSP(bf16, WS_W2), GW, NGW);
        });
        SEAM(0);
    }
    {
        constexpr int l = 0;
        const int pb = 1 + 12 * l, i = l >> 1; const bool odd = (l & 1) != 0;
#define MODL (WSP(float, WS_MOD) + (size_t)l * 8 * 6144)
#define COUNTSL (WSP(int, WS_CTL) + CW_COUNTS + 64 * l)
        if (IN(pb + 0)) { if (l == 0) phase_norm1<true, false>(a.in[0], WSP(bf16, WS_XB), true, WSP(bf16, WS_YS), MODL, false, a.in[4] + l * DM, MODL, WSP(bf16, WS_H), true, GW, NGW, odd, odd ? nullptr : WSP(unsigned char, WS_H8)); else phase_norm1<false, false>(WSP(bf16, WS_XB), WSP(bf16, WS_XB), true, WSP(bf16, WS_YS), MODL - 8 * 6144, true, a.in[4] + l * DM, MODL, WSP(bf16, WS_H), true, GW, NGW, odd, odd ? nullptr : WSP(unsigned char, WS_H8)); SEAM(pb + 0); }
        if (IN(pb + 1)) {
            if (!odd) {
                { pg8::Gemm g{WSP(bf16, WS_H), WSP(bf16, WS_WEVIN) + (size_t)i * EVEN_IN * DM, T_TOK, 1024, DM, 0}; pg8::StaticOrder S; S.init(T_TOK, 1024, G, c0);
                  DUP(2, pg8::gemm_phase<EpiEvenIn, pg8::StaticOrder, true, true>(L, g, S, EpiEvenIn{WSP(bf16, WS_PROJ), WSP(float, WS_COS), WSP(float, WS_SIN), 0, 1.0f})); }
                { pg8::Gemm g{WSP(bf16, WS_H8), WSP(bf16, WS_WEVIN8) + ((size_t)i * EVEN_IN + 1024) * (DM / 2), T_TOK, 3072, DM / 2, 0}; pg8::StaticOrder S; S.init(T_TOK, 3072, G, c0);
                  DUP(2, pg8::gemm_phase<EpiEvenIn, pg8::StaticOrder, true, true, true>(L, g, S, EpiEvenIn{WSP(bf16, WS_PROJ), WSP(float, WS_COS), WSP(float, WS_SIN), 4, WSCALE_INV})); } }
            else { pg8::Gemm g{WSP(bf16, WS_H), WSP(bf16, WS_WODIN) + (size_t)i * 3072 * (DM / 2), T_TOK, 3072, DM / 2, 0}; pg8::StaticOrder S; S.init(T_TOK, 3072, G, c0);
                DUP(2, pg8::gemm_phase<EpiOddIn, pg8::StaticOrder, true, true, true>(L, g, S, EpiOddIn{WSP(bf16, WS_PROJ), a.in[14] + i * 64, a.in[15] + i * 64})); }
            SEAM(pb + 1); }
        if (!odd) {
            if (IN(pb + 2)) { DUP(4, phase_e1(L, WSP(bf16, WS_PROJ), WSP(bf16, WS_KV), a.in[8] + i * 512, a.in[9] + i * 512, a.in[10] + (size_t)i * 4 * 128 * 128, a.in[11] + i * 512, WSP(bf16, WS_MIX), c0, G, 0, 1280)); SEAM(pb + 2); }
            if (IN(pb + 3)) { DUP(256, phase_e2(WSP(bf16, WS_KV), WSP(bf16, WS_ST), c0 * 512 + opaque_tid(), G * 512)); SEAM(pb + 3); }
            if (IN(pb + 4)) { DUP(512, phase_e3(L, WSP(bf16, WS_PROJ), WSP(bf16, WS_ST), WSP(bf16, WS_MIX), c0, G)); SEAM(pb + 4); }
        } else {
            if (IN(pb + 2)) { DUP(128, phase_attn(L, WSP(bf16, WS_PROJ), a.in[16] + (size_t)i * 16 * 320, a.in[14] + i * 64, a.in[15] + i * 64, WSP(bf16, WS_MIX), c0, G)); SEAM(pb + 2); }
        }
        if (IN(pb + 5)) { pg8::StaticOrder S; S.init(T_TOK, DM, G, c0);
            if (odd) { pg8::Gemm g{WSP(bf16, WS_MIX), WSP(bf16, WS_WODOUT) + (size_t)i * DM * (DM / 2), T_TOK, DM, DM / 2, 0}; pg8::gemm_phase<EpiResid, pg8::StaticOrder, true, true, true>(L, g, S, EpiResid{WSP(bf16, WS_XB), MODL, 2048, WSCALE_INV}); }
            else { pg8::Gemm g{WSP(bf16, WS_MIX), WSP(bf16, WS_WEVOUT) + (size_t)i * DM * (EVEN_MIX / 2), T_TOK, DM, EVEN_MIX / 2, 0};
            pg8::gemm_phase<EpiResid, pg8::StaticOrder, true, true, true>(L, g, S, EpiResid{WSP(bf16, WS_XB), MODL, 2048, WSCALE_INV}); } SEAM(pb + 5); }
        if (IN(pb + 6)) { phase_router(L, WSP(bf16, WS_XB), a.in[5] + l * DM, MODL, a.in[17] + (size_t)l * DM * NEXP, a.in[18] + l * NEXP, WSP(bf16, WS_H), WSP(int, WS_RSLOT), WSP(float, WS_RGATE), COUNTSL, c0, G); if (PROBE_DUP & 2048) phase_router(L, WSP(bf16, WS_XB), a.in[5] + l * DM, MODL, a.in[17] + (size_t)l * DM * NEXP, a.in[18] + l * NEXP, WSP(bf16, 920 * MiB), WSP(int, 940 * MiB), WSP(float, 944 * MiB), WSP(int, 948 * MiB), c0, G); SEAM(pb + 6); }
        if (IN(pb + 8)) { LAS int* tab = (LAS int*)(L + LDS_CTL_OFF); LAS unsigned short* gath = (LAS unsigned short*)(L + 131072); moe_table(tab, COUNTSL, 8, G, c0, WSP(int, WS_RSLOT), gath);
            pg8::Gemm g{WSP(bf16, WS_H), WSP(bf16, WS_W1) + (size_t)l * NEXP * 2048 * (DM / 2), CAP, 2048, DM / 2, 0, gath};
            pg8::MoeOrder S; S.tab = tab;
            DUP(16, pg8::gemm_phase<EpiMoe1, pg8::MoeOrder, true, true, true, true>(L, g, S, EpiMoe1{WSP(bf16, WS_ACT), a.in[20] + (size_t)l * NEXP * 2048})); SEAM(pb + 8); }
        if (IN(pb + 9)) { LAS int* tab = (LAS int*)(L + LDS_CTL_OFF); moe_table(tab, COUNTSL, 4, G, c0, nullptr, nullptr); pg8::Gemm g{WSP(bf16, WS_ACT), WSP(bf16, WS_W2) + (size_t)l * NEXP * DM * (DFF / 2), CAP, DM, DFF / 2, 0};
            pg8::MoeOrder S; S.tab = tab;
            DUP(32, pg8::gemm_phase<EpiMoe2, pg8::MoeOrder, true, true, true>(L, g, S, EpiMoe2{WSP(bf16, WS_YS), a.in[22] + (size_t)l * NEXP * DM, WSP(int, WS_RSLOT), WSP(float, WS_RGATE), tab})); SEAM(pb + 9); }
        }
    {
        constexpr int l = 1;
        const int pb = 1 + 12 * l, i = l >> 1; const bool odd = (l & 1) != 0;
#define MODL (WSP(float, WS_MOD) + (size_t)l * 8 * 6144)
#define COUNTSL (WSP(int, WS_CTL) + CW_COUNTS + 64 * l)
        if (IN(pb + 0)) { if (l == 0) phase_norm1<true, false>(a.in[0], WSP(bf16, WS_XB), true, WSP(bf16, WS_YS), MODL, false, a.in[4] + l * DM, MODL, WSP(bf16, WS_H), true, GW, NGW, odd, odd ? nullptr : WSP(unsigned char, WS_H8)); else phase_norm1<false, false>(WSP(bf16, WS_XB), WSP(bf16, WS_XB), true, WSP(bf16, WS_YS), MODL - 8 * 6144, true, a.in[4] + l * DM, MODL, WSP(bf16, WS_H), true, GW, NGW, odd, odd ? nullptr : WSP(unsigned char, WS_H8)); SEAM(pb + 0); }
        if (IN(pb + 1)) {
            if (!odd) {
                { pg8::Gemm g{WSP(bf16, WS_H), WSP(bf16, WS_WEVIN) + (size_t)i * EVEN_IN * DM, T_TOK, 1024, DM, 0}; pg8::StaticOrder S; S.init(T_TOK, 1024, G, c0);
                  DUP(2, pg8::gemm_phase<EpiEvenIn, pg8::StaticOrder, true, true>(L, g, S, EpiEvenIn{WSP(bf16, WS_PROJ), WSP(float, WS_COS), WSP(float, WS_SIN), 0, 1.0f})); }
                { pg8::Gemm g{WSP(bf16, WS_H8), WSP(bf16, WS_WEVIN8) + ((size_t)i * EVEN_IN + 1024) * (DM / 2), T_TOK, 3072, DM / 2, 0}; pg8::StaticOrder S; S.init(T_TOK, 3072, G, c0);
                  DUP(2, pg8::gemm_phase<EpiEvenIn, pg8::StaticOrder, true, true, true>(L, g, S, EpiEvenIn{WSP(bf16, WS_PROJ), WSP(float, WS_COS), WSP(float, WS_SIN), 4, WSCALE_INV})); } }
            else { pg8::Gemm g{WSP(bf16, WS_H), WSP(bf16, WS_WODIN) + (size_t)i * 3072 * (DM / 2), T_TOK, 3072, DM / 2, 0}; pg8::StaticOrder S; S.init(T_TOK, 3072, G, c0);
                DUP(2, pg8::gemm_phase<EpiOddIn, pg8::StaticOrder, true, true, true>(L, g, S, EpiOddIn{WSP(bf16, WS_PROJ), a.in[14] + i * 64, a.in[15] + i * 64})); }
            SEAM(pb + 1); }
        if (!odd) {
            if (IN(pb + 2)) { DUP(4, phase_e1(L, WSP(bf16, WS_PROJ), WSP(bf16, WS_KV), a.in[8] + i * 512, a.in[9] + i * 512, a.in[10] + (size_t)i * 4 * 128 * 128, a.in[11] + i * 512, WSP(bf16, WS_MIX), c0, G, 0, 1280)); SEAM(pb + 2); }
            if (IN(pb + 3)) { DUP(256, phase_e2(WSP(bf16, WS_KV), WSP(bf16, WS_ST), c0 * 512 + opaque_tid(), G * 512)); SEAM(pb + 3); }
            if (IN(pb + 4)) { DUP(512, phase_e3(L, WSP(bf16, WS_PROJ), WSP(bf16, WS_ST), WSP(bf16, WS_MIX), c0, G)); SEAM(pb + 4); }
        } else {
            if (IN(pb + 2)) { DUP(128, phase_attn(L, WSP(bf16, WS_PROJ), a.in[16] + (size_t)i * 16 * 320, a.in[14] + i * 64, a.in[15] + i * 64, WSP(bf16, WS_MIX), c0, G)); SEAM(pb + 2); }
        }
        if (IN(pb + 5)) { pg8::StaticOrder S; S.init(T_TOK, DM, G, c0);
            if (odd) { pg8::Gemm g{WSP(bf16, WS_MIX), WSP(bf16, WS_WODOUT) + (size_t)i * DM * (DM / 2), T_TOK, DM, DM / 2, 0}; pg8::gemm_phase<EpiResid, pg8::StaticOrder, true, true, true>(L, g, S, EpiResid{WSP(bf16, WS_XB), MODL, 2048, WSCALE_INV}); }
            else { pg8::Gemm g{WSP(bf16, WS_MIX), WSP(bf16, WS_WEVOUT) + (size_t)i * DM * (EVEN_MIX / 2), T_TOK, DM, EVEN_MIX / 2, 0};
            pg8::gemm_phase<EpiResid, pg8::StaticOrder, true, true, true>(L, g, S, EpiResid{WSP(bf16, WS_XB), MODL, 2048, WSCALE_INV}); } SEAM(pb + 5); }
        if (IN(pb + 6)) { phase_router(L, WSP(bf16, WS_XB), a.in[5] + l * DM, MODL, a.in[17] + (size_t)l * DM * NEXP, a.in[18] + l * NEXP, WSP(bf16, WS_H), WSP(int, WS_RSLOT), WSP(float, WS_RGATE), COUNTSL, c0, G); if (PROBE_DUP & 2048) phase_router(L, WSP(bf16, WS_XB), a.in[5] + l * DM, MODL, a.in[17] + (size_t)l * DM * NEXP, a.in[18] + l * NEXP, WSP(bf16, 920 * MiB), WSP(int, 940 * MiB), WSP(float, 944 * MiB), WSP(int, 948 * MiB), c0, G); SEAM(pb + 6); }
        if (IN(pb + 8)) { LAS int* tab = (LAS int*)(L + LDS_CTL_OFF); LAS unsigned short* gath = (LAS unsigned short*)(L + 131072); moe_table(tab, COUNTSL, 8, G, c0, WSP(int, WS_RSLOT), gath);
            pg8::Gemm g{WSP(bf16, WS_H), WSP(bf16, WS_W1) + (size_t)l * NEXP * 2048 * (DM / 2), CAP, 2048, DM / 2, 0, gath};
            pg8::MoeOrder S; S.tab = tab;
            DUP(16, pg8::gemm_phase<EpiMoe1, pg8::MoeOrder, true, true, true, true>(L, g, S, EpiMoe1{WSP(bf16, WS_ACT), a.in[20] + (size_t)l * NEXP * 2048})); SEAM(pb + 8); }
        if (IN(pb + 9)) { LAS int* tab = (LAS int*)(L + LDS_CTL_OFF); moe_table(tab, COUNTSL, 4, G, c0, nullptr, nullptr); pg8::Gemm g{WSP(bf16, WS_ACT), WSP(bf16, WS_W2) + (size_t)l * NEXP * DM * (DFF / 2), CAP, DM, DFF / 2, 0};
            pg8::MoeOrder S; S.tab = tab;
            DUP(32, pg8::gemm_phase<EpiMoe2, pg8::MoeOrder, true, true, true>(L, g, S, EpiMoe2{WSP(bf16, WS_YS), a.in[22] + (size_t)l * NEXP * DM, WSP(int, WS_RSLOT), WSP(float, WS_RGATE), tab})); SEAM(pb + 9); }
        }
    {
        constexpr int l = 2;
        const int pb = 1 + 12 * l, i = l >> 1; const bool odd = (l & 1) != 0;
#define MODL (WSP(float, WS_MOD) + (size_t)l * 8 * 6144)
#define COUNTSL (WSP(int, WS_CTL) + CW_COUNTS + 64 * l)
        if (IN(pb + 0)) { if (l == 0) phase_norm1<true, false>(a.in[0], WSP(bf16, WS_XB), true, WSP(bf16, WS_YS), MODL, false, a.in[4] + l * DM, MODL, WSP(bf16, WS_H), true, GW, NGW, odd, odd ? nullptr : WSP(unsigned char, WS_H8)); else phase_norm1<false, false>(WSP(bf16, WS_XB), WSP(bf16, WS_XB), true, WSP(bf16, WS_YS), MODL - 8 * 6144, true, a.in[4] + l * DM, MODL, WSP(bf16, WS_H), true, GW, NGW, odd, odd ? nullptr : WSP(unsigned char, WS_H8)); SEAM(pb + 0); }
        if (IN(pb + 1)) {
            if (!odd) {
                { pg8::Gemm g{WSP(bf16, WS_H), WSP(bf16, WS_WEVIN) + (size_t)i * EVEN_IN * DM, T_TOK, 1024, DM, 0}; pg8::StaticOrder S; S.init(T_TOK, 1024, G, c0);
                  DUP(2, pg8::gemm_phase<EpiEvenIn, pg8::StaticOrder, true, true>(L, g, S, EpiEvenIn{WSP(bf16, WS_PROJ), WSP(float, WS_COS), WSP(float, WS_SIN), 0, 1.0f})); }
                { pg8::Gemm g{WSP(bf16, WS_H8), WSP(bf16, WS_WEVIN8) + ((size_t)i * EVEN_IN + 1024) * (DM / 2), T_TOK, 3072, DM / 2, 0}; pg8::StaticOrder S; S.init(T_TOK, 3072, G, c0);
                  DUP(2, pg8::gemm_phase<EpiEvenIn, pg8::StaticOrder, true, true, true>(L, g, S, EpiEvenIn{WSP(bf16, WS_PROJ), WSP(float, WS_COS), WSP(float, WS_SIN), 4, WSCALE_INV})); } }
            else { pg8::Gemm g{WSP(bf16, WS_H), WSP(bf16, WS_WODIN) + (size_t)i * 3072 * (DM / 2), T_TOK, 3072, DM / 2, 0}; pg8::StaticOrder S; S.init(T_TOK, 3072, G, c0);
                DUP(2, pg8::gemm_phase<EpiOddIn, pg8::StaticOrder, true, true, true>(L, g, S, EpiOddIn{WSP(bf16, WS_PROJ), a.in[14] + i * 64, a.in[15] + i * 64})); }
            SEAM(pb + 1); }
        if (!odd) {
            if (IN(pb + 2)) { DUP(4, phase_e1(L, WSP(bf16, WS_PROJ), WSP(bf16, WS_KV), a.in[8] + i * 512, a.in[9] + i * 512, a.in[10] + (size_t)i * 4 * 128 * 128, a.in[11] + i * 512, WSP(bf16, WS_MIX), c0, G, 0, 1280)); SEAM(pb + 2); }
            if (IN(pb + 3)) { DUP(256, phase_e2(WSP(bf16, WS_KV), WSP(bf16, WS_ST), c0 * 512 + opaque_tid(), G * 512)); SEAM(pb + 3); }
            if (IN(pb + 4)) { DUP(512, phase_e3(L, WSP(bf16, WS_PROJ), WSP(bf16, WS_ST), WSP(bf16, WS_MIX), c0, G)); SEAM(pb + 4); }
        } else {
            if (IN(pb + 2)) { DUP(128, phase_attn(L, WSP(bf16, WS_PROJ), a.in[16] + (size_t)i * 16 * 320, a.in[14] + i * 64, a.in[15] + i * 64, WSP(bf16, WS_MIX), c0, G)); SEAM(pb + 2); }
        }
        if (IN(pb + 5)) { pg8::StaticOrder S; S.init(T_TOK, DM, G, c0);
            if (odd) { pg8::Gemm g{WSP(bf16, WS_MIX), WSP(bf16, WS_WODOUT) + (size_t)i * DM * (DM / 2), T_TOK, DM, DM / 2, 0}; pg8::gemm_phase<EpiResid, pg8::StaticOrder, true, true, true>(L, g, S, EpiResid{WSP(bf16, WS_XB), MODL, 2048, WSCALE_INV}); }
            else { pg8::Gemm g{WSP(bf16, WS_MIX), WSP(bf16, WS_WEVOUT) + (size_t)i * DM * (EVEN_MIX / 2), T_TOK, DM, EVEN_MIX / 2, 0};
            pg8::gemm_phase<EpiResid, pg8::StaticOrder, true, true, true>(L, g, S, EpiResid{WSP(bf16, WS_XB), MODL, 2048, WSCALE_INV}); } SEAM(pb + 5); }
        if (IN(pb + 6)) { phase_router(L, WSP(bf16, WS_XB), a.in[5] + l * DM, MODL, a.in[17] + (size_t)l * DM * NEXP, a.in[18] + l * NEXP, WSP(bf16, WS_H), WSP(int, WS_RSLOT), WSP(float, WS_RGATE), COUNTSL, c0, G); if (PROBE_DUP & 2048) phase_router(L, WSP(bf16, WS_XB), a.in[5] + l * DM, MODL, a.in[17] + (size_t)l * DM * NEXP, a.in[18] + l * NEXP, WSP(bf16, 920 * MiB), WSP(int, 940 * MiB), WSP(float, 944 * MiB), WSP(int, 948 * MiB), c0, G); SEAM(pb + 6); }
        if (IN(pb + 8)) { LAS int* tab = (LAS int*)(L + LDS_CTL_OFF); LAS unsigned short* gath = (LAS unsigned short*)(L + 131072); moe_table(tab, COUNTSL, 8, G, c0, WSP(int, WS_RSLOT), gath);
            pg8::Gemm g{WSP(bf16, WS_H), WSP(bf16, WS_W1) + (size_t)l * NEXP * 2048 * (DM / 2), CAP, 2048, DM / 2, 0, gath};
            pg8::MoeOrder S; S.tab = tab;
            DUP(16, pg8::gemm_phase<EpiMoe1, pg8::MoeOrder, true, true, true, true>(L, g, S, EpiMoe1{WSP(bf16, WS_ACT), a.in[20] + (size_t)l * NEXP * 2048})); SEAM(pb + 8); }
        if (IN(pb + 9)) { LAS int* tab = (LAS int*)(L + LDS_CTL_OFF); moe_table(tab, COUNTSL, 4, G, c0, nullptr, nullptr); pg8::Gemm g{WSP(bf16, WS_ACT), WSP(bf16, WS_W2) + (size_t)l * NEXP * DM * (DFF / 2), CAP, DM, DFF / 2, 0};
            pg8::MoeOrder S; S.tab = tab;
            DUP(32, pg8::gemm_phase<EpiMoe2, pg8::MoeOrder, true, true, true>(L, g, S, EpiMoe2{WSP(bf16, WS_YS), a.in[22] + (size_t)l * NEXP * DM, WSP(int, WS_RSLOT), WSP(float, WS_RGATE), tab})); SEAM(pb + 9); }
        }
    {
        constexpr int l = 3;
        const int pb = 1 + 12 * l, i = l >> 1; const bool odd = (l & 1) != 0;
#define MODL (WSP(float, WS_MOD) + (size_t)l * 8 * 6144)
#define COUNTSL (WSP(int, WS_CTL) + CW_COUNTS + 64 * l)
        if (IN(pb + 0)) { if (l == 0) phase_norm1<true, false>(a.in[0], WSP(bf16, WS_XB), true, WSP(bf16, WS_YS), MODL, false, a.in[4] + l * DM, MODL, WSP(bf16, WS_H), true, GW, NGW, odd, odd ? nullptr : WSP(unsigned char, WS_H8)); else phase_norm1<false, false>(WSP(bf16, WS_XB), WSP(bf16, WS_XB), true, WSP(bf16, WS_YS), MODL - 8 * 6144, true, a.in[4] + l * DM, MODL, WSP(bf16, WS_H), true, GW, NGW, odd, odd ? nullptr : WSP(unsigned char, WS_H8)); SEAM(pb + 0); }
        if (IN(pb + 1)) {
            if (!odd) {
                { pg8::Gemm g{WSP(bf16, WS_H), WSP(bf16, WS_WEVIN) + (size_t)i * EVEN_IN * DM, T_TOK, 1024, DM, 0}; pg8::StaticOrder S; S.init(T_TOK, 1024, G, c0);
                  DUP(2, pg8::gemm_phase<EpiEvenIn, pg8::StaticOrder, true, true>(L, g, S, EpiEvenIn{WSP(bf16, WS_PROJ), WSP(float, WS_COS), WSP(float, WS_SIN), 0, 1.0f})); }
                { pg8::Gemm g{WSP(bf16, WS_H8), WSP(bf16, WS_WEVIN8) + ((size_t)i * EVEN_IN + 1024) * (DM / 2), T_TOK, 3072, DM / 2, 0}; pg8::StaticOrder S; S.init(T_TOK, 3072, G, c0);
                  DUP(2, pg8::gemm_phase<EpiEvenIn, pg8::StaticOrder, true, true, true>(L, g, S, EpiEvenIn{WSP(bf16, WS_PROJ), WSP(float, WS_COS), WSP(float, WS_SIN), 4, WSCALE_INV})); } }
            else { pg8::Gemm g{WSP(bf16, WS_H), WSP(bf16, WS_WODIN) + (size_t)i * 3072 * (DM / 2), T_TOK, 3072, DM / 2, 0}; pg8::StaticOrder S; S.init(T_TOK, 3072, G, c0);
                DUP(2, pg8::gemm_phase<EpiOddIn, pg8::StaticOrder, true, true, true>(L, g, S, EpiOddIn{WSP(bf16, WS_PROJ), a.in[14] + i * 64, a.in[15] + i * 64})); }
            SEAM(pb + 1); }
        if (!odd) {
            if (IN(pb + 2)) { DUP(4, phase_e1(L, WSP(bf16, WS_PROJ), WSP(bf16, WS_KV), a.in[8] + i * 512, a.in[9] + i * 512, a.in[10] + (size_t)i * 4 * 128 * 128, a.in[11] + i * 512, WSP(bf16, WS_MIX), c0, G, 0, 1280)); SEAM(pb + 2); }
            if (IN(pb + 3)) { DUP(256, phase_e2(WSP(bf16, WS_KV), WSP(bf16, WS_ST), c0 * 512 + opaque_tid(), G * 512)); SEAM(pb + 3); }
            if (IN(pb + 4)) { DUP(512, phase_e3(L, WSP(bf16, WS_PROJ), WSP(bf16, WS_ST), WSP(bf16, WS_MIX), c0, G)); SEAM(pb + 4); }
        } else {
            if (IN(pb + 2)) { DUP(128, phase_attn(L, WSP(bf16, WS_PROJ), a.in[16] + (size_t)i * 16 * 320, a.in[14] + i * 64, a.in[15] + i * 64, WSP(bf16, WS_MIX), c0, G)); SEAM(pb + 2); }
        }
        if (IN(pb + 5)) { pg8::StaticOrder S; S.init(T_TOK, DM, G, c0);
            if (odd) { pg8::Gemm g{WSP(bf16, WS_MIX), WSP(bf16, WS_WODOUT) + (size_t)i * DM * (DM / 2), T_TOK, DM, DM / 2, 0}; pg8::gemm_phase<EpiResid, pg8::StaticOrder, true, true, true>(L, g, S, EpiResid{WSP(bf16, WS_XB), MODL, 2048, WSCALE_INV}); }
            else { pg8::Gemm g{WSP(bf16, WS_MIX), WSP(bf16, WS_WEVOUT) + (size_t)i * DM * (EVEN_MIX / 2), T_TOK, DM, EVEN_MIX / 2, 0};
            pg8::gemm_phase<EpiResid, pg8::StaticOrder, true, true, true>(L, g, S, EpiResid{WSP(bf16, WS_XB), MODL, 2048, WSCALE_INV}); } SEAM(pb + 5); }
        if (IN(pb + 6)) { phase_router(L, WSP(bf16, WS_XB), a.in[5] + l * DM, MODL, a.in[17] + (size_t)l * DM * NEXP, a.in[18] + l * NEXP, WSP(bf16, WS_H), WSP(int, WS_RSLOT), WSP(float, WS_RGATE), COUNTSL, c0, G); if (PROBE_DUP & 2048) phase_router(L, WSP(bf16, WS_XB), a.in[5] + l * DM, MODL, a.in[17] + (size_t)l * DM * NEXP, a.in[18] + l * NEXP, WSP(bf16, 920 * MiB), WSP(int, 940 * MiB), WSP(float, 944 * MiB), WSP(int, 948 * MiB), c0, G); SEAM(pb + 6); }
        if (IN(pb + 8)) { LAS int* tab = (LAS int*)(L + LDS_CTL_OFF); LAS unsigned short* gath = (LAS unsigned short*)(L + 131072); moe_table(tab, COUNTSL, 8, G, c0, WSP(int, WS_RSLOT), gath);
            pg8::Gemm g{WSP(bf16, WS_H), WSP(bf16, WS_W1) + (size_t)l * NEXP * 2048 * (DM / 2), CAP, 2048, DM / 2, 0, gath};
            pg8::MoeOrder S; S.tab = tab;
            DUP(16, pg8::gemm_phase<EpiMoe1, pg8::MoeOrder, true, true, true, true>(L, g, S, EpiMoe1{WSP(bf16, WS_ACT), a.in[20] + (size_t)l * NEXP * 2048})); SEAM(pb + 8); }
        if (IN(pb + 9)) { LAS int* tab = (LAS int*)(L + LDS_CTL_OFF); moe_table(tab, COUNTSL, 4, G, c0, nullptr, nullptr); pg8::Gemm g{WSP(bf16, WS_ACT), WSP(bf16, WS_W2) + (size_t)l * NEXP * DM * (DFF / 2), CAP, DM, DFF / 2, 0};
            pg8::MoeOrder S; S.tab = tab;
            DUP(32, pg8::gemm_phase<EpiMoe2, pg8::MoeOrder, true, true, true>(L, g, S, EpiMoe2{WSP(bf16, WS_YS), a.in[22] + (size_t)l * NEXP * DM, WSP(int, WS_RSLOT), WSP(float, WS_RGATE), tab})); SEAM(pb + 9); }
        }
    if (IN(N_PHASES - 1)) phase_norm1<false, true>(WSP(bf16, WS_XB), a.out, true, WSP(bf16, WS_YS), WSP(float, WS_MOD) + (size_t)(DEPTH - 1) * 8 * 6144, true, nullptr, nullptr, nullptr, false, GW, NGW);
#undef IN
#undef SEAM
}
extern "C" void kernel_launch(void* const* d_in, const int* in_sizes, int n_in, void* d_out, int out_size, void* d_ws, size_t ws_size, hipStream_t stream) {
    (void)in_sizes; (void)out_size; (void)ws_size;
    static int grid = 0;
    if (!grid) {
        (void)hipFuncSetAttribute((const void*)mega, hipFuncAttributeMaxDynamicSharedMemorySize, LDS_BYTES);
        int dev = 0, cus = 0, per_cu = 0; (void)hipGetDevice(&dev); (void)hipDeviceGetAttribute(&cus, hipDeviceAttributeMultiprocessorCount, dev);
        (void)hipOccupancyMaxActiveBlocksPerMultiprocessor(&per_cu, (const void*)mega, 512, LDS_BYTES); (void)hipGetLastError();
        grid = cus > 0 ? cus : 256;
    }
    (void)hipMemsetAsync((unsigned char*)d_ws + WS_CTL, 0, CTL_ZERO_BYTES, stream);
    Args a{};
    for (int i = 0; i < 23 && i < n_in; ++i) a.in[i] = (const float*)d_in[i];
    a.out = (float*)d_out; a.ws = (unsigned char*)d_ws;
#if MK_PER_PHASE
    for (int p = 0; p < N_PHASES; ++p) {
        if (p >= 1 && p < N_PHASES - 1) { const int l = (p - 1) / 12, j = (p - 1) % 12; if (j >= 10) continue; if ((l & 1) && (j == 3 || j == 4)) continue; }
        a.ph_lo = p; a.ph_hi = p + 1; hipLaunchKernelGGL(mega, dim3(grid), dim3(512), LDS_BYTES, stream, a);
    }
#else
    a.ph_lo = 0; a.ph_hi = N_PHASES; hipLaunchKernelGGL(mega, dim3(grid), dim3(512), LDS_BYTES, stream, a);
#endif
}
```

```cpp
#include <hip/hip_runtime.h>
#include <stdint.h>
#include <stdio.h>

typedef unsigned short bf16;

constexpr int NB = 8, SEQ = 2048, DM = 1024, T_TOK = NB * SEQ, DEPTH = 4;
constexpr int CHUNK = 64, NCH = SEQ / CHUNK;
constexpr int EVEN_IN = 4096, EVEN_MIX = 1536;
constexpr int NEXP = 32, TOPK = 4, DFF = 1024;
constexpr int CAP = T_TOK * TOPK + NEXP * 256;
constexpr float EPS = 1e-6f;

constexpr size_t MiB = 1u << 20;
constexpr size_t WS_CTL = 0;
constexpr size_t WS_MOD = 1 * MiB;
constexpr size_t WS_COS = 2 * MiB;
constexpr size_t WS_SIN = 3 * MiB;
constexpr size_t WS_H = 4 * MiB;
constexpr size_t WS_PROJ = 36 * MiB;
constexpr size_t WS_MIX = 164 * MiB;
constexpr size_t WS_TOPI = 212 * MiB;
constexpr size_t WS_TOPG = 213 * MiB;
constexpr size_t WS_POS = 214 * MiB;
constexpr size_t WS_ROWSLOT = 215 * MiB;
constexpr size_t WS_ROWGATE = 216 * MiB;
constexpr size_t WS_H8 = 220 * MiB;
constexpr size_t WS_WEVIN8 = 240 * MiB;
constexpr size_t WS_XS = 260 * MiB;
constexpr size_t WS_ACT = 364 * MiB;
constexpr size_t WS_YS = 508 * MiB;
constexpr size_t WS_KV = 636 * MiB;
constexpr size_t WS_ST = 772 * MiB;
constexpr size_t WS_XB = 960 * MiB;
constexpr size_t WS_RSLOT = 900 * MiB, WS_RGATE = 904 * MiB;
constexpr int EREG = 16384;
constexpr size_t WS_WEVIN = 2500 * MiB, WS_WEVOUT = 2516 * MiB, WS_WODIN = 2524 * MiB, WS_WODOUT = 2540 * MiB, WS_W1 = 2560 * MiB, WS_W2 = 3072 * MiB;
constexpr int CW_COUNTS = 64;
constexpr int CW_BAR = 4096;
constexpr size_t CTL_ZERO_BYTES = 64 * 1024;

__device__ __forceinline__ int opaque_tid() { int t = threadIdx.x; asm volatile("" : "+v"(t)); return t; }
__device__ __forceinline__ float bf2f(bf16 v) { return __uint_as_float(((unsigned)v) << 16); }
template <int M> __device__ __forceinline__ float xshfl(float v) { return __int_as_float(__builtin_amdgcn_ds_swizzle(__float_as_int(v), (M << 10) | 0x1f)); }
template <int M> __device__ __forceinline__ int xshfl_i(int v) { return __builtin_amdgcn_ds_swizzle(v, (M << 10) | 0x1f); }
__device__ __forceinline__ float sum_halves(float v) { const auto r = __builtin_amdgcn_permlane32_swap(__float_as_uint(v), __float_as_uint(v), false, false); return __uint_as_float(r[0]) + __uint_as_float(r[1]); }
__device__ __forceinline__ float max_halves(float v) { const auto r = __builtin_amdgcn_permlane32_swap(__float_as_uint(v), __float_as_uint(v), false, false); return fmaxf(__uint_as_float(r[0]), __uint_as_float(r[1])); }
__device__ __forceinline__ float wave_sum(float v) { v += xshfl<1>(v); v += xshfl<2>(v); v += xshfl<4>(v); v += xshfl<8>(v); v += xshfl<16>(v); return sum_halves(v); }
#define LAS __attribute__((address_space(3)))
namespace pg8 {
#define PG8_LAS __attribute__((address_space(3)))
typedef unsigned short bf16_t;
typedef short bf16x8 __attribute__((ext_vector_type(8)));
typedef float f32x4 __attribute__((ext_vector_type(4)));
typedef unsigned u32x4 __attribute__((ext_vector_type(4)));
constexpr int BM = 256, BK = 64, HALF = 128, HTB = HALF * BK * 2  , STAGE_BYTES = 8 * HTB, NXCD = 8, WGM = 8;
__host__ __device__ __forceinline__ int lds_byte(int r, int c) { const int st = (r >> 4) * 2 + (c >> 5), rr = r & 15, cc = c & 31, ob = rr * 64 + cc * 2; return st * 1024 + (ob ^ (((ob >> 9) & 1) << 5)); }
__host__ __device__ __forceinline__ void stage_rc(int b, int& R, int& C) { const int st = b / 1024, sb = b % 1024, swz = sb ^ (((sb >> 9) & 1) << 5); R = (st >> 1) * 16 + swz / 64; C = (st & 1) * 32 + (swz % 64) / 2; }
__host__ __device__ __forceinline__ int perm32(int rho) { const int n = rho >> 4, i = rho & 15; return 8 * (i >> 2) + 4 * n + (i & 3); }
__device__ __forceinline__ unsigned stage_voff(int i, int K) { const int t = opaque_tid(); int R, C; stage_rc(t * 16 + i * 8192, R, C); return (unsigned)(R * K + C) * 2u; }
__device__ __forceinline__ unsigned rc2vo(unsigned rc, int K) { return (rc >> 16) * (unsigned)(K * 2) + (rc & 0xffffu); }
struct Unit { int pm, pn; };
struct Gemm { const bf16_t* A; const bf16_t* Bt; int M, N, K, pad; const PG8_LAS unsigned short* gath; };
struct StaticOrder {
    int nM, nN, nwg, G, c;
    __host__ __device__ void init(int M, int N, int G_, int c_) { nM = M / BM; nN = N / BM; nwg = nM * nN; G = G_; c = c_; }
    __host__ __device__ bool next(int i, Unit& u) const {
        const long L = (long)i * G + c; if (L >= nwg) return false;
        int wgid = (int)L; { const int q = nwg / NXCD, r = nwg % NXCD, xcd = wgid % NXCD, off = wgid / NXCD; wgid = (xcd < r ? xcd * (q + 1) : r * (q + 1) + (xcd - r) * q) + off; }
        const int nig = WGM * nN, gid = wgid / nig, fm = gid * WGM, gsz = (nM - fm) < WGM ? (nM - fm) : WGM;
        u.pm = fm + ((wgid % nig) % gsz); u.pn = (wgid % nig) / gsz; return true;
    }
    __device__ __forceinline__ void a_ready(const Unit&) const {}
    __device__ __forceinline__ void done(const Unit&) const {}
};
struct MoeOrder {
    const PG8_LAS int* tab;
    __device__ __forceinline__ bool next(int i, Unit& u) const {
        if (i >= __builtin_amdgcn_readfirstlane(tab[192])) return false;
        u.pm = __builtin_amdgcn_readfirstlane(tab[194 + 2 * i]); u.pn = __builtin_amdgcn_readfirstlane(tab[195 + 2 * i]); return true;
    }
    __device__ __forceinline__ void a_ready(const Unit&) const {}
    __device__ __forceinline__ void done(const Unit&) const {}
};
typedef __bf16 bf16x2_t __attribute__((ext_vector_type(2)));
typedef float f32x2_t __attribute__((ext_vector_type(2)));
__device__ __forceinline__ unsigned cvt_pk_bf16(float lo, float hi) { const f32x2_t v = {lo, hi}; const bf16x2_t b = __builtin_convertvector(v, bf16x2_t); return __builtin_bit_cast(unsigned, b); }
typedef int i32x4_t __attribute__((ext_vector_type(4)));
typedef int i32x8_t __attribute__((ext_vector_type(8)));
__device__ __forceinline__ i32x8_t cat8(const bf16x8 a, const bf16x8 b) { return __builtin_shufflevector((i32x4_t)a, (i32x4_t)b, 0, 1, 2, 3, 4, 5, 6, 7); }
__device__ __forceinline__ unsigned pk4_fp8(float a, float b, float c, float d) { int w = 0; w = __builtin_amdgcn_cvt_pk_fp8_f32(a, b, w, false); w = __builtin_amdgcn_cvt_pk_fp8_f32(c, d, w, true); return (unsigned)w; }
__device__ __forceinline__ u32x4 pack8(const f32x4 a, const f32x4 b) { u32x4 w; w.x = cvt_pk_bf16(a[0], a[1]); w.y = cvt_pk_bf16(a[2], a[3]); w.z = cvt_pk_bf16(b[0], b[1]); w.w = cvt_pk_bf16(b[2], b[3]); return w; }
template <class Epi, class Sched, bool ALIGN_EPI = false, bool SP2 = false, bool FP8 = false, bool GATHER = false>
__device__ __forceinline__ void gemm_phase(PG8_LAS unsigned char* lds, const Gemm g, const Sched& S, const Epi& E) {
    const int tid = opaque_tid(), wid = __builtin_amdgcn_readfirstlane(tid >> 6), lane = tid & 63, wr = wid >> 2, wc = wid & 3, fr = lane & 15, fq = lane >> 4;
    const int K = g.K, nt = K / BK;
    unsigned voffA[2], voffB[2];
#pragma unroll
    for (int i = 0; i < 2; ++i) { int R, C; stage_rc(tid * 16 + i * 8192, R, C); const int Rb = Epi::PERM ? ((R & ~31) + perm32(R & 31)) : R;
        voffA[i] = (unsigned)(R * K + C) * 2u; voffB[i] = (unsigned)(Rb * K + C) * 2u; }
    const size_t kstep = (size_t)(BK * 2);
    const size_t hstep = (size_t)HALF * K * 2;
    const size_t tstep = 2 * hstep;
    const unsigned ldsw = (unsigned)wid * 1024u;
    const int aoff = lds_byte(wr * 64 + fr, fq * 8), boff = lds_byte(wc * 32 + fr, fq * 8);
#define PG8_SA(b, h) (((b) * 2 + (h)) * HTB)
#define PG8_SB(b, h) ((4 + (b) * 2 + (h)) * HTB)
    const __amdgpu_buffer_rsrc_t rsA = __builtin_amdgcn_make_buffer_rsrc((void*)g.A, 0, -1, 0x00020000);
    const unsigned relB = (unsigned)(size_t)((const char*)g.Bt - (const char*)g.A);
#define rsB rsA
    PG8_LAS unsigned* voT = (PG8_LAS unsigned*)(lds + 141312);
    if constexpr (FP8) {
#pragma unroll
        for (int i = 0; i < 2; ++i) { int R, C; stage_rc(tid * 16 + i * 8192, R, C); voT[i * 512 + tid] = ((unsigned)R << 16) | (unsigned)(C * 2); } }
#define PG8_DMA(rs, bufoff, ptr, vo, i) __builtin_amdgcn_raw_ptr_buffer_load_lds(rs, (PG8_LAS void*)(lds + (bufoff) + ldsw + (i) * 8192), 16, (vo), (unsigned)(size_t)(ptr), 0, 0)
#define PG8_VO(arr, i) (FP8 ? rc2vo(voT[(i) * 512 + opaque_tid()], K) : (arr)[i])
#define PG8_STAGE_B(bufoff, ptr) do { _Pragma("unroll") for (int _i = 0; _i < 2; ++_i) PG8_DMA(rsA, bufoff, (ptr) + relB, PG8_VO(voffB, _i), _i); } while (0)
#define PG8_STAGE_A0(bufoff, ptr) do { _Pragma("unroll") for (int _i = 0; _i < 2; ++_i) PG8_DMA(rsA, bufoff, ptr, PG8_VO(voffA, _i), _i); } while (0)
#define PG8_STAGE_A(bufoff, ptr, half, slot) do { if constexpr (GATHER) { _Pragma("unroll") for (int _i = 0; _i < 2; ++_i) { \
        const unsigned rc_ = voT[_i * 512 + opaque_tid()]; const unsigned vo_ = (unsigned)g.gath[(slot) * 256 + (half) * 128 + (rc_ >> 16)] * (unsigned)(K * 2) + (rc_ & 0xffffu); PG8_DMA(rsA, bufoff, ptr, vo_, _i); } } \
        else { PG8_STAGE_A0(bufoff, (ptr) + (half) * hstep); } } while (0)
#define PG8_LDA(dst, b, h) do { _Pragma("unroll") for (int m = 0; m < 4; ++m) _Pragma("unroll") for (int k = 0; k < 2; ++k) dst[m][k] = *(const PG8_LAS bf16x8*)(lds + PG8_SA(b, h) + aoff + m * 2048 + k * 1024); } while (0)
#define PG8_LDB(dst, b, h) do { _Pragma("unroll") for (int n = 0; n < 2; ++n) _Pragma("unroll") for (int k = 0; k < 2; ++k) dst[n][k] = *(const PG8_LAS bf16x8*)(lds + PG8_SB(b, h) + boff + n * 2048 + k * 1024); } while (0)
#define PG8_MMA(ai, bj, At, Bt) do { __builtin_amdgcn_s_setprio(1); _Pragma("unroll") for (int m = 0; m < 4; ++m) _Pragma("unroll") for (int n = 0; n < 2; ++n) { \
        if constexpr (FP8) { acc[ai][bj][m][n] = __builtin_amdgcn_mfma_scale_f32_16x16x128_f8f6f4(cat8(Bt[n][0], Bt[n][1]), cat8(At[m][0], At[m][1]), acc[ai][bj][m][n], 0, 0, 0, 0, 0, 0); } \
        else { _Pragma("unroll") for (int k = 0; k < 2; ++k) acc[ai][bj][m][n] = __builtin_amdgcn_mfma_f32_16x16x32_bf16(Bt[n][k], At[m][k], acc[ai][bj][m][n], 0, 0, 0); } } \
        __builtin_amdgcn_s_setprio(0); } while (0)
#define PG8_WAIT_V(n) asm volatile("s_waitcnt vmcnt(" #n ")" ::: "memory")
#define PG8_WAIT_L(n) asm volatile("s_waitcnt lgkmcnt(" #n ")" ::: "memory")
#define PG8_BAR __builtin_amdgcn_s_barrier()
#define PG8_SCHED __builtin_amdgcn_sched_barrier(0)

#define PG8_PIN_ACC() do { \
        asm volatile("" : "+v"(acc[0][0][0][0]), "+v"(acc[0][0][0][1]), "+v"(acc[0][0][1][0]), "+v"(acc[0][0][1][1]), "+v"(acc[0][0][2][0]), "+v"(acc[0][0][2][1]), "+v"(acc[0][0][3][0]), "+v"(acc[0][0][3][1]), \
                          "+v"(acc[0][1][0][0]), "+v"(acc[0][1][0][1]), "+v"(acc[0][1][1][0]), "+v"(acc[0][1][1][1]), "+v"(acc[0][1][2][0]), "+v"(acc[0][1][2][1]), "+v"(acc[0][1][3][0]), "+v"(acc[0][1][3][1])); \
        asm volatile("" : "+v"(acc[1][0][0][0]), "+v"(acc[1][0][0][1]), "+v"(acc[1][0][1][0]), "+v"(acc[1][0][1][1]), "+v"(acc[1][0][2][0]), "+v"(acc[1][0][2][1]), "+v"(acc[1][0][3][0]), "+v"(acc[1][0][3][1]), \
                          "+v"(acc[1][1][0][0]), "+v"(acc[1][1][0][1]), "+v"(acc[1][1][1][0]), "+v"(acc[1][1][1][1]), "+v"(acc[1][1][2][0]), "+v"(acc[1][1][2][1]), "+v"(acc[1][1][3][0]), "+v"(acc[1][1][3][1])); } while (0)
    Unit cur, nxt; int ui = 0;
    if (!S.next(0, cur)) return;
    f32x4 acc[2][2][4][2];
#pragma unroll
    for (int a = 0; a < 2; ++a)
#pragma unroll
        for (int b = 0; b < 2; ++b)
#pragma unroll
            for (int m = 0; m < 4; ++m)
#pragma unroll
                for (int n = 0; n < 2; ++n) acc[a][b][m][n] = (f32x4){0.f, 0.f, 0.f, 0.f};
    int pf_b = 131072, pf_s = 133120; if constexpr (Epi::PREF) pf_b = Epi::L_BIAS;
    if constexpr (Epi::PREF) { if (wr == 0) E.pref(lds, cur, pf_b, pf_s, wid, lane); PG8_WAIT_V(0); PG8_BAR; E.init_lds(acc, lds, pf_b, wc, fq); }
    else if constexpr (Epi::INIT) E.init(acc, cur, wc, fq);
    else if constexpr (FP8) PG8_PIN_ACC();
    bf16x8 At[4][2], B0[2][2], B1[2][2];
    static_assert(!GATHER || SP2, "GATHER is written for the SP2 loop");
    const char* cA = (const char*)0 + (GATHER ? (size_t)0 : (size_t)cur.pm * tstep); const char* cB = (const char*)0 + (size_t)cur.pn * tstep;
    S.a_ready(cur);
    if constexpr (SP2) {
        PG8_STAGE_B(PG8_SB(0, 0), cB); PG8_STAGE_B(PG8_SB(0, 1), cB + hstep); PG8_STAGE_A(PG8_SA(0, 0), cA, 0, 0); PG8_STAGE_A(PG8_SA(0, 1), cA, 1, 0);
        if (wr == 1) PG8_BAR;
        PG8_WAIT_V(2); PG8_BAR;
        PG8_STAGE_B(PG8_SB(1, 0), cB + kstep); PG8_STAGE_A(PG8_SA(1, 0), cA + kstep, 0, 0); PG8_STAGE_B(PG8_SB(1, 1), cB + hstep + kstep);
        PG8_WAIT_V(6); PG8_BAR;
    } else {
        PG8_STAGE_B(PG8_SB(0, 0), cB); PG8_STAGE_A0(PG8_SA(0, 0), cA); PG8_STAGE_B(PG8_SB(0, 1), cB + hstep); PG8_STAGE_A0(PG8_SA(0, 1), cA + hstep);
        if (wr == 1) PG8_BAR;
        PG8_WAIT_V(4); PG8_BAR;
        PG8_STAGE_B(PG8_SB(1, 0), cB + kstep); PG8_STAGE_A0(PG8_SA(1, 0), cA + kstep); PG8_STAGE_B(PG8_SB(1, 1), cB + hstep + kstep);
        PG8_WAIT_V(6); PG8_BAR;
    }
    for (;;) {
        const bool has_next = S.next(ui + 1, nxt);
        const char* nA = has_next ? (const char*)0 + (GATHER ? (size_t)0 : (size_t)nxt.pm * tstep) : cA; const char* nB = has_next ? (const char*)0 + (size_t)nxt.pn * tstep : cB;
        const int nslot = has_next ? ui + 1 : ui;
        const int pf_nb = pf_b ^ 1024, pf_ns = (pf_s == 133120 + 4096) ? 133120 : pf_s + 2048;
        if constexpr (Epi::PREF) { if (wr == 0 && has_next) E.pref(lds, nxt, pf_nb, pf_ns, wid, lane); }
        for (int t = 0; t < nt; t += 2) {
            const bool last = (t == nt - 2);
            const char* a1 = cA + (size_t)(t + 1) * kstep;
            const char* a2 = last ? nA : cA + (size_t)(t + 2) * kstep; const char* b2 = last ? nB : cB + (size_t)(t + 2) * kstep;
            const char* a3 = a2 + kstep; const char* b3 = b2 + kstep;
            if (last && has_next) S.a_ready(nxt);
            if constexpr (SP2) {
            PG8_LDB(B0, 0, 0); PG8_LDB(B1, 0, 1); PG8_SCHED; PG8_LDA(At, 0, 0); PG8_STAGE_A(PG8_SA(1, 1), a1, 1, ui);
            PG8_WAIT_V(8); PG8_WAIT_L(0); PG8_BAR;
            PG8_MMA(0, 0, At, B0); PG8_MMA(0, 1, At, B1); PG8_BAR; PG8_SCHED;
            PG8_LDA(At, 0, 1); PG8_STAGE_B(PG8_SB(0, 0), b2); PG8_STAGE_B(PG8_SB(0, 1), b2 + hstep); PG8_STAGE_A(PG8_SA(0, 0), a2, 0, (last ? nslot : ui));
            PG8_WAIT_V(8); PG8_WAIT_L(0); PG8_BAR; PG8_MMA(1, 0, At, B0); PG8_MMA(1, 1, At, B1); PG8_BAR; PG8_SCHED;
            PG8_LDB(B0, 1, 0); PG8_LDB(B1, 1, 1); PG8_SCHED; PG8_LDA(At, 1, 0); PG8_STAGE_A(PG8_SA(0, 1), a2, 1, (last ? nslot : ui));
            PG8_WAIT_V(8); PG8_WAIT_L(0); PG8_BAR; PG8_MMA(0, 0, At, B0); PG8_MMA(0, 1, At, B1); PG8_BAR; PG8_SCHED;
            PG8_LDA(At, 1, 1); PG8_STAGE_B(PG8_SB(1, 0), b3); PG8_STAGE_B(PG8_SB(1, 1), b3 + hstep); PG8_STAGE_A(PG8_SA(1, 0), a3, 0, (last ? nslot : ui));
            PG8_WAIT_V(8); PG8_WAIT_L(0); PG8_BAR; PG8_MMA(1, 0, At, B0); PG8_MMA(1, 1, At, B1); PG8_BAR; PG8_SCHED;
            } else {
            PG8_LDB(B0, 0, 0); PG8_SCHED; PG8_LDA(At, 0, 0); PG8_STAGE_A0(PG8_SA(1, 1), a1 + hstep);
            PG8_WAIT_L(8); PG8_BAR; PG8_WAIT_L(0); PG8_MMA(0, 0, At, B0); PG8_BAR; PG8_SCHED;
            PG8_LDB(B1, 0, 1); PG8_STAGE_B(PG8_SB(0, 0), b2);
            PG8_BAR; PG8_WAIT_L(0); PG8_MMA(0, 1, At, B1); PG8_BAR;
            PG8_LDA(At, 0, 1); PG8_STAGE_A0(PG8_SA(0, 0), a2);
            PG8_BAR; PG8_WAIT_L(0); PG8_MMA(1, 0, At, B0); PG8_BAR; PG8_SCHED;
            PG8_STAGE_B(PG8_SB(0, 1), b2 + hstep);
            PG8_WAIT_V(6); PG8_BAR; PG8_MMA(1, 1, At, B1); PG8_BAR;
            PG8_LDB(B0, 1, 0); PG8_SCHED; PG8_LDA(At, 1, 0); PG8_STAGE_A0(PG8_SA(0, 1), a2 + hstep);
            PG8_WAIT_L(8); PG8_BAR; PG8_WAIT_L(0); PG8_MMA(0, 0, At, B0); PG8_BAR; PG8_SCHED;
            PG8_LDB(B1, 1, 1); PG8_STAGE_B(PG8_SB(1, 0), b3);
            PG8_BAR; PG8_WAIT_L(0); PG8_MMA(0, 1, At, B1); PG8_BAR;
            PG8_LDA(At, 1, 1); PG8_STAGE_A0(PG8_SA(1, 0), a3);
            PG8_BAR; PG8_WAIT_L(0); PG8_MMA(1, 0, At, B0); PG8_BAR; PG8_SCHED;
            PG8_STAGE_B(PG8_SB(1, 1), b3 + hstep);
            PG8_WAIT_V(6); PG8_BAR; PG8_MMA(1, 1, At, B1); PG8_BAR;
            }
        }
        if constexpr (ALIGN_EPI) { if (wr == 0) PG8_BAR; }
        if constexpr (Epi::PREF) { E.epi_lds(acc, cur, lds, pf_s, wr, wc, fr, fq); pf_s = pf_ns; S.done(cur); }
        else if constexpr (!Epi::AFTER_DRAIN) { E(acc, cur, wr, wc, fr, fq); S.done(cur); }
        if (!has_next) break;
#pragma unroll
        for (int a = 0; a < 2; ++a)
#pragma unroll
            for (int b = 0; b < 2; ++b)
#pragma unroll
                for (int m = 0; m < 4; ++m)
#pragma unroll
                    for (int n = 0; n < 2; ++n) acc[a][b][m][n] = (f32x4){0.f, 0.f, 0.f, 0.f};
        if constexpr (Epi::PREF) { E.init_lds(acc, lds, pf_nb, wc, fq); pf_b = pf_nb; } else if constexpr (Epi::INIT) E.init(acc, nxt, wc, fq);
        else if constexpr (FP8) PG8_PIN_ACC();
        cur = nxt; cA = nA; cB = nB; ++ui;
        if constexpr (ALIGN_EPI) { if (wr == 1) PG8_BAR; }
    }
    PG8_WAIT_V(0);
    if constexpr (!ALIGN_EPI) { if (wr == 0) PG8_BAR; }
    PG8_BAR;
    if constexpr (Epi::AFTER_DRAIN) { E.fused(acc, cur, wr, wc, fr, fq, lds, wid, lane); S.done(cur); }
#undef PG8_SA
#undef PG8_SB
#undef PG8_DMA
#undef PG8_VO
#undef rsB
#undef PG8_STAGE_B
#undef PG8_STAGE_A0
#undef PG8_STAGE_A
#undef PG8_LDA
#undef PG8_LDB
#undef PG8_MMA
#undef PG8_WAIT_V
#undef PG8_WAIT_L
#undef PG8_BAR
#undef PG8_SCHED
#undef PG8_PIN_ACC
}
}

using pg8::f32x4; using pg8::u32x4; using pg8::Unit;
typedef unsigned u32x2 __attribute__((ext_vector_type(2)));
__device__ __forceinline__ float fsigmoid(float x) { return __builtin_amdgcn_rcpf(1.0f + __builtin_amdgcn_exp2f(-1.4426950408889634f * x)); }
__device__ __forceinline__ float fgelu(float x) { const float u = -2.302208198f * (x + 0.044715f * x * x * x); return x * __builtin_amdgcn_rcpf(1.0f + __builtin_amdgcn_exp2f(u)); }
constexpr float WSCALE = 32.0f, WSCALE_INV = 1.0f / 32.0f;
struct EpiResid {
    static constexpr bool PERM = false, AFTER_DRAIN = false, INIT = false, PREF = false;
    bf16* X; const float* MODl; int g_off; float scale;
    __device__ __forceinline__ void operator()(const f32x4 (&acc)[2][2][4][2], const Unit& u, int wr, int wc, int fr, int fq) const {
        const int row0 = u.pm * 256 + wr * 64 + fr, b = (u.pm * 256) / SEQ, col0 = u.pn * 256 + wc * 32 + 8 * fq;
        const float* gp = MODl + (size_t)b * 6144 + g_off + col0; f32x4 gv[2][2];
#pragma unroll
        for (int bj = 0; bj < 2; ++bj)
#pragma unroll
            for (int n = 0; n < 2; ++n) gv[bj][n] = *(const f32x4*)(gp + bj * 128 + 4 * n) * scale;
#pragma unroll
        for (int ai = 0; ai < 2; ++ai)
#pragma unroll
            for (int m = 0; m < 4; ++m) { bf16* rowp = X + (size_t)(row0 + ai * 128 + m * 16) * DM + col0;
#pragma unroll
                for (int bj = 0; bj < 2; ++bj) { const u32x4 xv = *(const u32x4*)(rowp + bj * 128);
                    const f32x4 x0 = (f32x4){__uint_as_float(xv[0] << 16), __uint_as_float(xv[0] & 0xffff0000u), __uint_as_float(xv[1] << 16), __uint_as_float(xv[1] & 0xffff0000u)};
                    const f32x4 x1 = (f32x4){__uint_as_float(xv[2] << 16), __uint_as_float(xv[2] & 0xffff0000u), __uint_as_float(xv[3] << 16), __uint_as_float(xv[3] & 0xffff0000u)};
                    *(u32x4*)(rowp + bj * 128) = pg8::pack8(x0 + gv[bj][0] * acc[ai][bj][m][0], x1 + gv[bj][1] * acc[ai][bj][m][1]); } }
    }
};
struct EpiEvenIn {
    static constexpr bool PERM = false, AFTER_DRAIN = false, INIT = false, PREF = false;
    bf16* P; const float* COS; const float* SIN; int pn0; float scale;
    __device__ __forceinline__ void operator()(const f32x4 (&acc)[2][2][4][2], const Unit& u, int wr, int wc, int fr, int fq) const {
        const int row0 = u.pm * 256 + wr * 64 + fr, pn = u.pn + pn0;
        if (pn < 4) {
            const float sc = pn >= 2 ? 0.08838834764831845f : 1.0f; const int dlow = 32 * (wc & 1) + 8 * fq, col1 = pn * 256 + 128 * (wc >> 1) + dlow;
#pragma unroll
            for (int ai = 0; ai < 2; ++ai)
#pragma unroll
                for (int m = 0; m < 4; ++m) { const int row = row0 + ai * 128 + m * 16, pos = row & (SEQ - 1);
                    const f32x4 c0 = *(const f32x4*)(COS + pos * 64 + dlow), c1 = *(const f32x4*)(COS + pos * 64 + dlow + 4), s0 = *(const f32x4*)(SIN + pos * 64 + dlow), s1 = *(const f32x4*)(SIN + pos * 64 + dlow + 4);
                    const f32x4 x1a = acc[ai][0][m][0], x1b = acc[ai][0][m][1], x2a = acc[ai][1][m][0], x2b = acc[ai][1][m][1];
                    const f32x4 o1a = (x1a * c0 - x2a * s0) * sc, o1b = (x1b * c1 - x2b * s1) * sc, o2a = (x1a * s0 + x2a * c0) * sc, o2b = (x1b * s1 + x2b * c1) * sc;
                    bf16* rp = P + (size_t)row * EVEN_IN + col1; *(u32x4*)rp = pg8::pack8(o1a, o1b); *(u32x4*)(rp + 64) = pg8::pack8(o2a, o2b); }
        } else {
            const int mode = pn < 8 ? 0 : (pn < 12 ? 1 : 2); const int col0 = pn * 256 + wc * 32 + 8 * fq;
#pragma unroll
            for (int ai = 0; ai < 2; ++ai)
#pragma unroll
                for (int m = 0; m < 4; ++m) { bf16* rp = P + (size_t)(row0 + ai * 128 + m * 16) * EVEN_IN + col0;
#pragma unroll
                    for (int bj = 0; bj < 2; ++bj) { f32x4 v0 = acc[ai][bj][m][0] * scale, v1 = acc[ai][bj][m][1] * scale;
                        if (mode == 1) {
#pragma unroll
                            for (int j = 0; j < 4; ++j) { v0[j] = v0[j] * fsigmoid(v0[j]); v1[j] = v1[j] * fsigmoid(v1[j]); } }
                        else if (mode == 2) {
#pragma unroll
                            for (int j = 0; j < 4; ++j) { v0[j] = fgelu(v0[j]); v1[j] = fgelu(v1[j]); } }
                        *(u32x4*)(rp + bj * 128) = pg8::pack8(v0, v1); } }
        }
    }
};
struct EpiOddIn {
    static constexpr bool PERM = false, AFTER_DRAIN = false, INIT = false, PREF = false;
    bf16* P; const float* qg; const float* kg;
    __device__ __forceinline__ void operator()(const f32x4 (&acc)[2][2][4][2], const Unit& u, int wr, int wc, int fr, int fq) const {
        const int row0 = u.pm * 256 + wr * 64 + fr, pn = u.pn;
        if (pn < 8) {
            const float* g = pn < 4 ? qg : kg; const float sc = pn < 4 ? 0.125f * 1.4426950408889634f : 1.0f; f32x4 gv[2][2];
#pragma unroll
            for (int bj = 0; bj < 2; ++bj)
#pragma unroll
                for (int n = 0; n < 2; ++n) gv[bj][n] = *(const f32x4*)(g + 32 * bj + 8 * fq + 4 * n) * sc;
            const int col0 = pn * 256 + 64 * wc + 8 * fq;
#pragma unroll
            for (int ai = 0; ai < 2; ++ai)
#pragma unroll
                for (int m = 0; m < 4; ++m) { float ss = 0.f;
#pragma unroll
                    for (int bj = 0; bj < 2; ++bj)
#pragma unroll
                        for (int n = 0; n < 2; ++n) { const f32x4 v = acc[ai][bj][m][n]; ss += (v[0] * v[0] + v[1] * v[1]) + (v[2] * v[2] + v[3] * v[3]); }
                    ss += xshfl<16>(ss); ss = sum_halves(ss); ss *= WSCALE_INV * WSCALE_INV;
                    const float r = rsqrtf(ss * (1.0f / 64.0f) + EPS) * WSCALE_INV; bf16* rp = P + (size_t)(row0 + ai * 128 + m * 16) * 3072 + col0;
#pragma unroll
                    for (int bj = 0; bj < 2; ++bj) *(u32x4*)(rp + 32 * bj) = pg8::pack8(acc[ai][bj][m][0] * gv[bj][0] * r, acc[ai][bj][m][1] * gv[bj][1] * r); }
        } else {
            const int col0 = pn * 256 + wc * 32 + 8 * fq;
#pragma unroll
            for (int ai = 0; ai < 2; ++ai)
#pragma unroll
                for (int m = 0; m < 4; ++m) { bf16* rp = P + (size_t)(row0 + ai * 128 + m * 16) * 3072 + col0;
#pragma unroll
                    for (int bj = 0; bj < 2; ++bj) *(u32x4*)(rp + bj * 128) = pg8::pack8(acc[ai][bj][m][0] * WSCALE_INV, acc[ai][bj][m][1] * WSCALE_INV); }
        }
    }
};
struct EpiMoe1 {
    static constexpr bool PERM = false, AFTER_DRAIN = false, INIT = true, PREF = true; static constexpr int L_BIAS = 145408;
    bf16* ACT; const float* b1l;
    __device__ __forceinline__ void init(f32x4 (&acc)[2][2][4][2], const Unit& u, int wc, int fq) const {
        const int e = u.pn >> 3, pnl = u.pn & 7, c0 = 128 * pnl + 32 * wc + 8 * fq; const float* bp = b1l + (size_t)e * 2048 + c0;
#pragma unroll
        for (int n = 0; n < 2; ++n) { const f32x4 bg = *(const f32x4*)(bp + 4 * n) * WSCALE, bl = *(const f32x4*)(bp + 1024 + 4 * n) * WSCALE;
#pragma unroll
            for (int ai = 0; ai < 2; ++ai)
#pragma unroll
                for (int m = 0; m < 4; ++m) { acc[ai][0][m][n] = bg; acc[ai][1][m][n] = bl; } }
    }
    __device__ __forceinline__ void operator()(const f32x4 (&acc)[2][2][4][2], const Unit& u, int wr, int wc, int fr, int fq) const {
        const int pnl = u.pn & 7, c0 = 128 * pnl + 32 * wc + 8 * fq, row0 = u.pm * 256 + wr * 64 + fr;
#pragma unroll
        for (int ai = 0; ai < 2; ++ai)
#pragma unroll
            for (int m = 0; m < 4; ++m) { f32x4 a[2];
#pragma unroll
                for (int n = 0; n < 2; ++n) { const f32x4 hg = acc[ai][0][m][n], hl = acc[ai][1][m][n];
                    f32x4 xg, xl;
#pragma unroll
                    for (int j = 0; j < 4; ++j) { xg[j] = __builtin_amdgcn_fmed3f(hg[j], -1.0e30f, 7.0f * WSCALE); xl[j] = __builtin_amdgcn_fmed3f(hl[j], -7.0f * WSCALE, 7.0f * WSCALE); }
                    const f32x4 ea = xg * (-1.702f * 1.4426950408889634f * WSCALE_INV); f32x4 t;
#pragma unroll
                    for (int j = 0; j < 4; ++j) t[j] = __builtin_amdgcn_exp2f(ea[j]);
                    const f32x4 d = t * (WSCALE * WSCALE) + (WSCALE * WSCALE); f32x4 r;
#pragma unroll
                    for (int j = 0; j < 4; ++j) r[j] = __builtin_amdgcn_rcpf(d[j]);
                    a[n] = (xg * (xl + WSCALE)) * r; }
                uint2 pk; pk.x = pg8::pk4_fp8(a[0][0], a[0][1], a[0][2], a[0][3]); pk.y = pg8::pk4_fp8(a[1][0], a[1][1], a[1][2], a[1][3]);
                *(uint2*)((unsigned char*)ACT + (size_t)(row0 + ai * 128 + m * 16) * DFF + c0) = pk; }
    }
    __device__ __forceinline__ void pref(LAS unsigned char* lds, const Unit& u, int boff, int, int wid, int lane) const {
        const int e = u.pn >> 3, pnl = u.pn & 7, L = wid * 64 + lane;
        const __amdgpu_buffer_rsrc_t rb = __builtin_amdgcn_make_buffer_rsrc((void*)(b1l + (size_t)e * 2048 + 128 * pnl), 0, -1, 0x00020000);
        __builtin_amdgcn_raw_ptr_buffer_load_lds(rb, (LAS void*)(lds + boff + wid * 256), 4, (unsigned)((L & 127) + (L >> 7) * 1024) * 4u, 0u, 0, 0);
    }
    __device__ __forceinline__ void init_lds(f32x4 (&acc)[2][2][4][2], LAS unsigned char* lds, int boff, int wc, int fq) const {
        const LAS float* bp = (const LAS float*)(lds + boff) + 32 * wc + 8 * fq;
#pragma unroll
        for (int n = 0; n < 2; ++n) { const f32x4 bg = *(const LAS f32x4*)(bp + 4 * n) * WSCALE, bl = *(const LAS f32x4*)(bp + 128 + 4 * n) * WSCALE;
#pragma unroll
            for (int ai = 0; ai < 2; ++ai)
#pragma unroll
                for (int m = 0; m < 4; ++m) { acc[ai][0][m][n] = bg; acc[ai][1][m][n] = bl; } }
    }
    __device__ __forceinline__ void epi_lds(const f32x4 (&acc)[2][2][4][2], const Unit& u, LAS unsigned char*, int, int wr, int wc, int fr, int fq) const { (*this)(acc, u, wr, wc, fr, fq); }
};
constexpr float YSCALE = 16.0f, YSCALE_INV = 1.0f / 16.0f;
struct EpiMoe2 {
    static constexpr bool PERM = false, AFTER_DRAIN = false, INIT = true, PREF = true; static constexpr int L_BIAS = 131072;
    bf16* YS; const float* b2l; const int* RSLOT; const float* RGATE; const LAS int* tab;
    __device__ __forceinline__ void init(f32x4 (&acc)[2][2][4][2], const Unit& u, int wc, int fq) const {
        const int e = u.pn >> 2, pnl = u.pn & 3, col0 = 256 * pnl + 32 * wc + 8 * fq; const float* bp = b2l + (size_t)e * 1024 + col0;
#pragma unroll
        for (int bj = 0; bj < 2; ++bj)
#pragma unroll
            for (int n = 0; n < 2; ++n) { const f32x4 bv = *(const f32x4*)(bp + bj * 128 + 4 * n) * WSCALE;
#pragma unroll
                for (int ai = 0; ai < 2; ++ai)
#pragma unroll
                    for (int m = 0; m < 4; ++m) acc[ai][bj][m][n] = bv; }
    }
    __device__ __forceinline__ void operator()(const f32x4 (&acc)[2][2][4][2], const Unit& u, int wr, int wc, int fr, int fq) const {
        const int e = u.pn >> 2, pnl = u.pn & 3, col0 = 256 * pnl + 32 * wc + 8 * fq, rl0 = (u.pm - tab[64 + e]) * 256 + wr * 64 + fr, cnt = tab[160 + e];
        int slot[2][4]; float gt[2][4];
#pragma unroll
        for (int ai = 0; ai < 2; ++ai)
#pragma unroll
            for (int m = 0; m < 4; ++m) { const int rl = rl0 + ai * 128 + m * 16; const bool ok = rl < cnt; slot[ai][m] = ok ? RSLOT[e * EREG + rl] : -1; gt[ai][m] = ok ? RGATE[e * EREG + rl] * WSCALE_INV : 0.f; }
#pragma unroll
        for (int ai = 0; ai < 2; ++ai)
#pragma unroll
            for (int m = 0; m < 4; ++m) { unsigned char* rp = (slot[ai][m] >= 0 ? (unsigned char*)YS + (size_t)slot[ai][m] * DM : (unsigned char*)YS + (size_t)T_TOK * 4 * DM + (size_t)(32u << 20)) + col0; const float g = gt[ai][m] * YSCALE;
#pragma unroll
                for (int bj = 0; bj < 2; ++bj) { const f32x4 y0 = acc[ai][bj][m][0] * g, y1 = acc[ai][bj][m][1] * g; uint2 pk; pk.x = pg8::pk4_fp8(y0[0], y0[1], y0[2], y0[3]); pk.y = pg8::pk4_fp8(y1[0], y1[1], y1[2], y1[3]); *(uint2*)(rp + bj * 128) = pk; } }
    }
    __device__ __forceinline__ void pref(LAS unsigned char* lds, const Unit& u, int boff, int soff, int wid, int lane) const {
        const int e = u.pn >> 2, pnl = u.pn & 3, rl = (u.pm - tab[64 + e]) * 256 + wid * 64 + lane;
        const __amdgpu_buffer_rsrc_t rs = __builtin_amdgcn_make_buffer_rsrc((void*)RSLOT, 0, -1, 0x00020000);
        const unsigned relg = (unsigned)(size_t)((const char*)RGATE - (const char*)RSLOT);
        __builtin_amdgcn_raw_ptr_buffer_load_lds(rs, (LAS void*)(lds + soff + wid * 256), 4, (unsigned)rl * 4u, (unsigned)(e * EREG) * 4u, 0, 0);
        __builtin_amdgcn_raw_ptr_buffer_load_lds(rs, (LAS void*)(lds + soff + 1024 + wid * 256), 4, (unsigned)rl * 4u, (unsigned)(e * EREG) * 4u + relg, 0, 0);
        const __amdgpu_buffer_rsrc_t rb = __builtin_amdgcn_make_buffer_rsrc((void*)(b2l + (size_t)e * 1024 + 256 * pnl), 0, -1, 0x00020000);
        __builtin_amdgcn_raw_ptr_buffer_load_lds(rb, (LAS void*)(lds + boff + wid * 256), 4, (unsigned)(wid * 64 + lane) * 4u, 0u, 0, 0);
    }
    __device__ __forceinline__ void init_lds(f32x4 (&acc)[2][2][4][2], LAS unsigned char* lds, int boff, int wc, int fq) const {
        const LAS float* bp = (const LAS float*)(lds + boff) + 32 * wc + 8 * fq;
#pragma unroll
        for (int bj = 0; bj < 2; ++bj)
#pragma unroll
            for (int n = 0; n < 2; ++n) { const f32x4 bv = *(const LAS f32x4*)(bp + bj * 128 + 4 * n) * WSCALE;
#pragma unroll
                for (int ai = 0; ai < 2; ++ai)
#pragma unroll
                    for (int m = 0; m < 4; ++m) acc[ai][bj][m][n] = bv; }
    }
    __device__ __forceinline__ void epi_lds(const f32x4 (&acc)[2][2][4][2], const Unit& u, LAS unsigned char* lds, int soff, int wr, int wc, int fr, int fq) const {
        const int e = u.pn >> 2, pnl = u.pn & 3, col0 = 256 * pnl + 32 * wc + 8 * fq, r0 = wr * 64 + fr, rl0 = (u.pm - tab[64 + e]) * 256 + r0, cnt = tab[160 + e];
        const LAS int* sl = (const LAS int*)(lds + soff); const LAS float* gl = (const LAS float*)(sl + 256);
        int slot[2][4]; float gt[2][4];
#pragma unroll
        for (int ai = 0; ai < 2; ++ai)
#pragma unroll
            for (int m = 0; m < 4; ++m) { const int r = ai * 128 + m * 16; const bool ok = rl0 + r < cnt; slot[ai][m] = ok ? sl[r0 + r] : -1; gt[ai][m] = ok ? gl[r0 + r] * WSCALE_INV : 0.f; }
#pragma unroll
        for (int ai = 0; ai < 2; ++ai)
#pragma unroll
            for (int m = 0; m < 4; ++m) { unsigned char* rp = (slot[ai][m] >= 0 ? (unsigned char*)YS + (size_t)slot[ai][m] * DM : (unsigned char*)YS + (size_t)T_TOK * 4 * DM + (size_t)(32u << 20)) + col0; const float g = gt[ai][m] * YSCALE;
#pragma unroll
                for (int bj = 0; bj < 2; ++bj) { const f32x4 y0 = acc[ai][bj][m][0] * g, y1 = acc[ai][bj][m][1] * g; uint2 pk; pk.x = pg8::pk4_fp8(y0[0], y0[1], y0[2], y0[3]); pk.y = pg8::pk4_fp8(y1[0], y1[1], y1[2], y1[3]); *(uint2*)(rp + bj * 128) = pk; } }
    }
};

struct EpiNull { static constexpr bool PERM = false, AFTER_DRAIN = false, INIT = false, PREF = false; float* sink;
    __device__ __forceinline__ void operator()(const f32x4 (&acc)[2][2][4][2], const Unit& u, int wr, int wc, int fr, int fq) const { f32x4 s = acc[0][0][0][0];
#pragma unroll
        for (int ai = 0; ai < 2; ++ai)
#pragma unroll
            for (int bj = 0; bj < 2; ++bj)
#pragma unroll
                for (int m = 0; m < 4; ++m)
#pragma unroll
                    for (int n = 0; n < 2; ++n) s = s + acc[ai][bj][m][n];
        if (s[0] + s[1] + s[2] + s[3] == 12345.678f) sink[0] = s[0]; } };
constexpr int LDS_STAGE = 131072, LDS_CTL_OFF = 139264, LDS_BYTES = 147456;
__device__ __forceinline__ int logical_group_base(int mode, int gp) {
    const int pn = gp >> 3, bj = (gp >> 2) & 1, wc = gp & 3;
    if (mode == 1) return pn < 4 ? 256 * pn + 128 * (wc >> 1) + 64 * bj + 32 * (wc & 1) : 32 * gp;
    if (mode == 2) return pn < 8 ? 256 * pn + 64 * wc + 32 * bj : 32 * gp;
    if (mode == 3) return 1024 * bj + 128 * pn + 32 * wc;
    return 32 * gp;
}
__device__ __forceinline__ void load_item(float4 (&v)[16], const float* W, int N, int mode, int kb, int gp, int lane) {
    const float* src = W + (size_t)(128 * kb + (lane >> 3)) * N + logical_group_base(mode, gp) + (lane & 7) * 4;
#pragma unroll
    for (int i = 0; i < 16; ++i) { const f32x4 t = __builtin_nontemporal_load((const f32x4*)(src + (size_t)(8 * i) * N)); v[i] = make_float4(t[0], t[1], t[2], t[3]); }
}
template <bool F8> __device__ __forceinline__ void store_item(const float4 (&v)[16], int K, bf16* out, int kb, int gp, LAS float* scr, int lane) {
    const int k0 = 128 * kb;
#pragma unroll
    for (int i = 0; i < 16; ++i) { LAS float* d = scr + (8 * i + (lane >> 3)) * 33 + (lane & 7) * 4; d[0] = v[i].x; d[1] = v[i].y; d[2] = v[i].z; d[3] = v[i].w; }
    asm volatile("s_waitcnt lgkmcnt(0)" ::: "memory");
    const int c = lane & 15;
#pragma unroll
    for (int jj = 0; jj < 8; ++jj) { const int ip = (lane >> 4) + 4 * jj; const int il = 8 * ((ip >> 2) & 3) + 4 * (ip >> 4) + (ip & 3);
        const LAS float* s = scr + (8 * c) * 33 + il; u32x4 o;
        if constexpr (F8) { uint2 p; p.x = pg8::pk4_fp8(s[0 * 33] * WSCALE, s[1 * 33] * WSCALE, s[2 * 33] * WSCALE, s[3 * 33] * WSCALE); p.y = pg8::pk4_fp8(s[4 * 33] * WSCALE, s[5 * 33] * WSCALE, s[6 * 33] * WSCALE, s[7 * 33] * WSCALE);
            __builtin_nontemporal_store(*(const u32x2*)&p, (u32x2*)((unsigned char*)out + (size_t)(32 * gp + ip) * K + k0 + 8 * c)); }
        else { o.x = pg8::cvt_pk_bf16(s[0 * 33], s[1 * 33]); o.y = pg8::cvt_pk_bf16(s[2 * 33], s[3 * 33]); o.z = pg8::cvt_pk_bf16(s[4 * 33], s[5 * 33]); o.w = pg8::cvt_pk_bf16(s[6 * 33], s[7 * 33]);
            __builtin_nontemporal_store(o, (u32x4*)(out + (size_t)(32 * gp + ip) * K + k0 + 8 * c)); } }
    asm volatile("s_waitcnt lgkmcnt(0)" ::: "memory");
}
__device__ __forceinline__ void load_half(float4 (&v)[8], const float* W, int N, int mode, int kb, int gp, int half, int lane) {
    const float* src = W + (size_t)(128 * kb + 64 * half + (lane >> 3)) * N + logical_group_base(mode, gp) + (lane & 7) * 4;
#pragma unroll
    for (int i = 0; i < 8; ++i) { const f32x4 t = __builtin_nontemporal_load((const f32x4*)(src + (size_t)(8 * i) * N)); v[i] = make_float4(t[0], t[1], t[2], t[3]); }
}
__device__ __forceinline__ void write_half(const float4 (&v)[8], int half, LAS float* scr, int lane) {
#pragma unroll
    for (int i = 0; i < 8; ++i) { LAS float* d = scr + (64 * half + 8 * i + (lane >> 3)) * 33 + (lane & 7) * 4; d[0] = v[i].x; d[1] = v[i].y; d[2] = v[i].z; d[3] = v[i].w; }
}
template <bool F8> __device__ __forceinline__ void process_item(int K, bf16* out, int kb, int gp, LAS float* scr, int lane) {
    const int k0 = 128 * kb;
    asm volatile("s_waitcnt lgkmcnt(0)" ::: "memory");
    const int c = lane & 15;
#pragma unroll
    for (int jj = 0; jj < 8; ++jj) { const int ip = (lane >> 4) + 4 * jj; const int il = 8 * ((ip >> 2) & 3) + 4 * (ip >> 4) + (ip & 3);
        const LAS float* s = scr + (8 * c) * 33 + il; u32x4 o;
        if constexpr (F8) { uint2 p; p.x = pg8::pk4_fp8(s[0 * 33] * WSCALE, s[1 * 33] * WSCALE, s[2 * 33] * WSCALE, s[3 * 33] * WSCALE); p.y = pg8::pk4_fp8(s[4 * 33] * WSCALE, s[5 * 33] * WSCALE, s[6 * 33] * WSCALE, s[7 * 33] * WSCALE);
            __builtin_nontemporal_store(*(const u32x2*)&p, (u32x2*)((unsigned char*)out + (size_t)(32 * gp + ip) * K + k0 + 8 * c)); }
        else { o.x = pg8::cvt_pk_bf16(s[0 * 33], s[1 * 33]); o.y = pg8::cvt_pk_bf16(s[2 * 33], s[3 * 33]); o.z = pg8::cvt_pk_bf16(s[4 * 33], s[5 * 33]); o.w = pg8::cvt_pk_bf16(s[6 * 33], s[7 * 33]);
            __builtin_nontemporal_store(o, (u32x4*)(out + (size_t)(32 * gp + ip) * K + k0 + 8 * c)); } }
    asm volatile("s_waitcnt lgkmcnt(0)" ::: "memory");
}
template <int K, int N, int MODE, int NMAT, int BASE, bool F8 = false, int GP0 = 0, int GPN = N / 32>
__device__ __forceinline__ void convert_job(LAS unsigned char* lds, const float* W, bf16* out, int gw, int ngw) {
    const int tid = opaque_tid(), lane = tid & 63, wave = tid >> 6; LAS float* scr = (LAS float*)(lds + wave * 16896);
    constexpr int ng = GPN, per = (K / 128) * ng, tot = per * NMAT;
    int it = gw - (BASE % ngw); if (it < 0) it += ngw;
    if (it >= tot) return;
    float4 va[8], vb[8];
#define CVT_LOADH(dst, item, half) do { const int m2_ = (item) / per, r2_ = (item) % per; load_half(dst, W + (size_t)m2_ * K * N, N, MODE, r2_ / ng, GP0 + r2_ % ng, half, lane); } while (0)
#define CVT_PROC(item) do { const int m_ = (item) / per, r_ = (item) % per; process_item<F8>(K, F8 ? (bf16*)((unsigned char*)out + (size_t)m_ * K * N) : out + (size_t)m_ * K * N, r_ / ng, GP0 + r_ % ng, scr, lane); } while (0)
    CVT_LOADH(va, it, 0); CVT_LOADH(vb, it, 1);
    const int nmin = tot / ngw; int kk = 0;
#define CVT_SYNC() do { if (kk < nmin) __builtin_amdgcn_s_barrier(); ++kk; } while (0)
    for (;;) {
        if (it + ngw >= tot) { CVT_SYNC(); write_half(va, 0, scr, lane); write_half(vb, 1, scr, lane); CVT_PROC(it); break; }
        CVT_SYNC(); write_half(va, 0, scr, lane); asm volatile("" ::: "memory"); CVT_LOADH(va, it + ngw, 0); asm volatile("" ::: "memory");
        write_half(vb, 1, scr, lane); asm volatile("" ::: "memory"); CVT_LOADH(vb, it + ngw, 1); asm volatile("" ::: "memory");
        CVT_PROC(it); it += ngw;
    }
#undef CVT_SYNC
#undef CVT_LOADH
#undef CVT_PROC
}
constexpr int CVT_T0 = (1024 / 128) * (4096 / 32) * 2, CVT_T1 = (1536 / 128) * (1024 / 32) * 2, CVT_T2 = (1024 / 128) * (3072 / 32) * 2, CVT_T3 = (1024 / 128) * (1024 / 32) * 2, CVT_T4 = (1024 / 128) * (2048 / 32) * 128;
typedef short s16x4 __attribute__((ext_vector_type(4)));
using pg8::bf16x8;
__device__ __forceinline__ bf16x8 tr_frag(const LAS unsigned char* p0, const LAS unsigned char* p1) {
    const s16x4 a = __builtin_amdgcn_ds_read_tr16_b64_v4i16((LAS s16x4*)p0), b = __builtin_amdgcn_ds_read_tr16_b64_v4i16((LAS s16x4*)p1);
    return (bf16x8){a[0], a[1], a[2], a[3], b[0], b[1], b[2], b[3]};
}
__device__ __forceinline__ void phase_attn(LAS unsigned char* lds, const bf16* P, const float* relb, const float* qg, const float* kg, bf16* MIX, int c0, int G) {
    constexpr float LOG2E = 1.4426950408889634f; constexpr int KS = 144, HB = 18432, BUF = 2 * HB;
    LAS float* rt = (LAS float*)(lds + 2 * BUF); LAS float* red = rt + 1280;
    const int tid = opaque_tid(), lane = tid & 63, w = tid >> 6, fr = lane & 15, fq = lane >> 4;
    const int skey = tid >> 3, sseg = tid & 7, hw = w >> 2;
    float Mref;
    { float m1 = 0.f, m2 = 0.f, m3 = -1.0e30f;
      if (tid < 64) { m1 = fabsf(qg[tid]); m2 = fabsf(kg[tid]); }
      for (int i = tid; i < 16 * 320; i += 512) m3 = fmaxf(m3, relb[i]);
#define WMAX(v) do { v = fmaxf(v, xshfl<1>(v)); v = fmaxf(v, xshfl<2>(v)); v = fmaxf(v, xshfl<4>(v)); v = fmaxf(v, xshfl<8>(v)); v = fmaxf(v, xshfl<16>(v)); v = max_halves(v); } while (0)
      WMAX(m1); WMAX(m2); WMAX(m3);
#undef WMAX
      __syncthreads();
      if (lane == 0) { red[w] = m1; red[8 + w] = m2; red[16 + w] = m3; }
      __syncthreads();
      float g1 = 0.f, g2 = 0.f, g3 = -1.0e30f;
#pragma unroll
      for (int i = 0; i < 8; ++i) { g1 = fmaxf(g1, red[i]); g2 = fmaxf(g2, red[8 + i]); g3 = fmaxf(g3, red[16 + i]); }
      Mref = (8.0f * g1 * g2 * 1.01f + g3 + 0.1f) * LOG2E; }
    if ((G & 127) == 0) { const int hp0 = (c0 >> 4) & 7; float tv[3];
#pragma unroll
        for (int k = 0; k < 3; ++k) { const int i = tid + 512 * k, ic = i < 1280 ? i : 0, hj = ic >= 640 ? 1 : 0, j = 639 - (ic - 640 * hj); tv[k] = relb[(2 * hp0 + hj) * 320 + (j > 319 ? 319 : j)]; }
#pragma unroll
        for (int k = 0; k < 3; ++k) { const int i = tid + 512 * k; if (i < 1280) rt[i] = tv[k] * LOG2E - Mref; } }
    for (int u = c0; u < NB * 8 * 16; u += G) {
        const int b = u >> 7, hp = (u >> 4) & 7, cp = ((u & 15) + 4 * (u >> 8)) & 15, h = 2 * hp + hw, nq = 2 * cp + ((w >> 1) & 1);
        const int kc_lo = 2 * cp - 8 < 0 ? 0 : 2 * cp - 8, kc_hi = 2 * cp + 1;
        const bf16* srcb = P + ((size_t)b * SEQ + skey) * 3072 + 1024 + (2 * hp) * 64 + sseg * 8;
        u32x4 ka = *(const u32x4*)(srcb + (size_t)kc_lo * 64 * 3072), kb = *(const u32x4*)(srcb + (size_t)kc_lo * 64 * 3072 + 64), va = *(const u32x4*)(srcb + (size_t)kc_lo * 64 * 3072 + 1024), vb = *(const u32x4*)(srcb + (size_t)kc_lo * 64 * 3072 + 1024 + 64);
        __syncthreads();
        if ((G & 127) != 0) { for (int i = tid; i < 1280; i += 512) { const int hj = i >= 640 ? 1 : 0, j = 639 - (i - 640 * hj); rt[i] = relb[(2 * hp + hj) * 320 + (j > 319 ? 319 : j)] * LOG2E - Mref; } }
        { LAS unsigned char* d = lds + skey * KS + sseg * 16; *(LAS u32x4*)d = ka; *(LAS u32x4*)(d + 9216) = va; *(LAS u32x4*)(d + HB) = kb; *(LAS u32x4*)(d + HB + 9216) = vb; }
        bf16x8 qf[2][2];
#pragma unroll
        for (int qt = 0; qt < 2; ++qt)
#pragma unroll
            for (int s = 0; s < 2; ++s) qf[qt][s] = *(const bf16x8*)(P + ((size_t)b * SEQ + nq * 64 + 32 * (w & 1) + 16 * qt + fr) * 3072 + h * 64 + 32 * s + 8 * fq);
        f32x4 o[2][4]; float lrow[2];
#pragma unroll
        for (int qt = 0; qt < 2; ++qt) { lrow[qt] = 0.f;
#pragma unroll
            for (int dt = 0; dt < 4; ++dt) o[qt][dt] = (f32x4){0.f, 0.f, 0.f, 0.f}; }
        const LAS float* rtw = rt + 640 * hw;
        __builtin_amdgcn_s_waitcnt(0x0F70);
        __syncthreads();
        for (int kc = kc_lo; kc <= kc_hi; ++kc) {
            LAS unsigned char* Ks = lds + ((kc - kc_lo) & 1) * BUF + hw * HB; LAS unsigned char* Vs = Ks + 9216;
            if (kc < kc_hi) { const bf16* sp = srcb + (size_t)(kc + 1) * 64 * 3072; ka = *(const u32x4*)sp; kb = *(const u32x4*)(sp + 64); va = *(const u32x4*)(sp + 1024); vb = *(const u32x4*)(sp + 1024 + 64); }
            if (kc >= nq - 8 && kc <= nq) {
                const int delta = nq - kc;
                f32x4 st[2][4];
#pragma unroll
                for (int qt = 0; qt < 2; ++qt) {
                    if (delta >= 5) { const float cb = rtw[320];
#pragma unroll
                        for (int t = 0; t < 4; ++t) st[qt][t] = (f32x4){cb, cb, cb, cb}; }
                    else { const int qi = 32 * (w & 1) + 16 * qt + fr; const LAS float* bp = rtw + (639 - (qi - 4 * fq + 64 * delta + 63));
#pragma unroll
                        for (int t = 0; t < 4; ++t)
#pragma unroll
                            for (int r = 0; r < 4; ++r) st[qt][t][r] = bp[16 * t + r]; } }
#pragma unroll
                for (int t = 0; t < 4; ++t) {
                    const bf16x8 k0 = *(const LAS bf16x8*)(Ks + (16 * t + fr) * KS + (8 * fq) * 2), k1 = *(const LAS bf16x8*)(Ks + (16 * t + fr) * KS + (32 + 8 * fq) * 2);
#pragma unroll
                    for (int qt = 0; qt < 2; ++qt) { f32x4 a = st[qt][t];
                        a = __builtin_amdgcn_mfma_f32_16x16x32_bf16(k0, qf[qt][0], a, 0, 0, 0); a = __builtin_amdgcn_mfma_f32_16x16x32_bf16(k1, qf[qt][1], a, 0, 0, 0); st[qt][t] = a; }
                }
                bf16x8 pf[2][2];
#pragma unroll
                for (int qt = 0; qt < 2; ++qt) {
                    float ps = 0.f;
#pragma unroll
                    for (int t = 0; t < 4; ++t)
#pragma unroll
                        for (int r = 0; r < 4; ++r) { const float p = __builtin_amdgcn_exp2f(st[qt][t][r]); st[qt][t][r] = p; ps += p; }
                    lrow[qt] += ps;
                    pf[qt][0] = (bf16x8)pg8::pack8(st[qt][0], st[qt][1]); pf[qt][1] = (bf16x8)pg8::pack8(st[qt][2], st[qt][3]);
                }
#pragma unroll
                for (int s = 0; s < 2; ++s)
#pragma unroll
                    for (int dt = 0; dt < 4; ++dt) {
                        const LAS unsigned char* vp = Vs + (32 * s + 4 * fq + (fr >> 2)) * KS + (16 * dt + 4 * (fr & 3)) * 2;
                        const bf16x8 vf = tr_frag(vp, vp + 16 * KS);
#pragma unroll
                        for (int qt = 0; qt < 2; ++qt) o[qt][dt] = __builtin_amdgcn_mfma_f32_16x16x32_bf16(vf, pf[qt][s], o[qt][dt], 0, 0, 0);
                    }
            }
            if (kc < kc_hi) { LAS unsigned char* d = lds + (((kc - kc_lo) & 1) ^ 1) * BUF + skey * KS + sseg * 16; *(LAS u32x4*)d = ka; *(LAS u32x4*)(d + 9216) = va; *(LAS u32x4*)(d + HB) = kb; *(LAS u32x4*)(d + HB + 9216) = vb; }
            __syncthreads();
        }
#pragma unroll
        for (int qt = 0; qt < 2; ++qt) { float l = lrow[qt]; l += xshfl<16>(l); l = sum_halves(l); const float inv = __builtin_amdgcn_rcpf(l);
            unsigned char* dst = (unsigned char*)MIX + ((size_t)b * SEQ + nq * 64 + 32 * (w & 1) + 16 * qt + fr) * DM + h * 64 + 4 * fq;
#pragma unroll
            for (int dt = 0; dt < 4; ++dt) { const f32x4 v = o[qt][dt] * inv; *(unsigned*)(dst + 16 * dt) = pg8::pk4_fp8(v[0], v[1], v[2], v[3]); } }
    }
}
struct KvRegs { u32x4 k[2], v[4]; };
__device__ __forceinline__ void kv_load(KvRegs& R, const bf16* P, int u, int tid) {
    const int h = u & 3, n = (u >> 2) & 31, b = u >> 7; const size_t row0 = (size_t)b * SEQ + (size_t)n * 64;
#pragma unroll
    for (int i = 0; i < 2; ++i) { const int id = tid + 512 * i, j = id >> 4, seg = id & 15; R.k[i] = *(const u32x4*)(P + (row0 + j) * EVEN_IN + 512 + h * 128 + seg * 8); }
#pragma unroll
    for (int i = 0; i < 4; ++i) { const int id = tid + 512 * i, j = id >> 5, seg = id & 31; R.v[i] = *(const u32x4*)(P + (row0 + j) * EVEN_IN + 1024 + h * 256 + seg * 8); }
}
__device__ __forceinline__ void kv_unit(LAS unsigned char* lds, const bf16* P, bf16* KV, int u, KvRegs& R, int unext) {
    constexpr int KST = 272, VST = 528;
    LAS unsigned char* Ks = lds; LAS unsigned char* Vs = lds + 64 * KST;
    const int tid = opaque_tid(), lane = tid & 63, w = tid >> 6, fr = lane & 15, fq = lane >> 4;
    const int h = u & 3, n = (u >> 2) & 31, b = u >> 7;
    const float log2g = log2f(1.0f - exp2f(-5.0f - (float)h));
    const size_t row0 = (size_t)b * SEQ + (size_t)n * 64;
    __syncthreads();
#pragma unroll
    for (int i = 0; i < 2; ++i) { const int id = tid + 512 * i, j = id >> 4, seg = id & 15; const u32x4 v = R.k[i];
        const float kd = exp2f(log2g * (float)(63 - j)); u32x4 o;
#pragma unroll
        for (int q = 0; q < 4; ++q) { const float lo = __uint_as_float(v[q] << 16) * kd, hi = __uint_as_float(v[q] & 0xffff0000u) * kd; o[q] = pg8::cvt_pk_bf16(lo, hi); }
        *(LAS u32x4*)(Ks + j * KST + seg * 16) = o; }
#pragma unroll
    for (int i = 0; i < 4; ++i) { const int id = tid + 512 * i, j = id >> 5, seg = id & 31; *(LAS u32x4*)(Vs + j * VST + seg * 16) = R.v[i]; }
    __syncthreads();
    if (unext >= 0) kv_load(R, P, unext, tid);
    f32x4 acc[8][2];
#pragma unroll
    for (int dt = 0; dt < 8; ++dt) { acc[dt][0] = (f32x4){0.f, 0.f, 0.f, 0.f}; acc[dt][1] = (f32x4){0.f, 0.f, 0.f, 0.f}; }
#pragma unroll
    for (int s = 0; s < 2; ++s) {
        bf16x8 vf[2];
#pragma unroll
        for (int e2 = 0; e2 < 2; ++e2) { const LAS unsigned char* vp = Vs + (32 * s + 8 * fq + (fr >> 2)) * VST + (16 * (2 * w + e2) + 4 * (fr & 3)) * 2; vf[e2] = tr_frag(vp, vp + 4 * VST); }
#pragma unroll
        for (int dt = 0; dt < 8; ++dt) { const LAS unsigned char* kp = Ks + (32 * s + 8 * fq + (fr >> 2)) * KST + (16 * dt + 4 * (fr & 3)) * 2; const bf16x8 kf = tr_frag(kp, kp + 4 * KST);
#pragma unroll
            for (int e2 = 0; e2 < 2; ++e2) acc[dt][e2] = __builtin_amdgcn_mfma_f32_16x16x32_bf16(kf, vf[e2], acc[dt][e2], 0, 0, 0); }
    }
    bf16* dst = KV + (size_t)u * 32768;
#pragma unroll
    for (int e2 = 0; e2 < 2; ++e2)
#pragma unroll
        for (int dt = 0; dt < 8; ++dt) { const f32x4 v = acc[dt][e2]; uint2 pk; pk.x = pg8::cvt_pk_bf16(v[0], v[1]); pk.y = pg8::cvt_pk_bf16(v[2], v[3]);
            *(uint2*)(dst + (16 * (2 * w + e2) + fr) * 128 + 16 * dt + 4 * fq) = pk; }
}
struct GmRegs { float4 w4[8]; u32x4 z2[4]; f32x4 lg0, lg1, lb0, lb1; uint2 uv[8]; float bs[8]; };
__device__ __forceinline__ void gm_load(GmRegs& R, const bf16* P, const float* lng, const float* lnb, const float* sgw, const float* sgb, size_t t0, int g, int tid, int w, int fr, int fq) {
    const int c8 = (tid & 15) * 8;
#pragma unroll
    for (int i = 0; i < 8; ++i) { const int id = tid + 512 * i, r = id >> 5, c4 = (id & 31) * 4; R.w4[i] = *(const float4*)(sgw + ((size_t)g * 128 + r) * 128 + c4); }
#pragma unroll
    for (int i = 0; i < 4; ++i) { const int id = tid + 512 * i, j = id >> 4; R.z2[i] = *(const u32x4*)(P + (t0 + j) * EVEN_IN + 3584 + g * 128 + c8); }
    R.lg0 = *(const f32x4*)(lng + g * 128 + c8); R.lg1 = *(const f32x4*)(lng + g * 128 + c8 + 4); R.lb0 = *(const f32x4*)(lnb + g * 128 + c8); R.lb1 = *(const f32x4*)(lnb + g * 128 + c8 + 4);
}
__device__ __forceinline__ void gm_load_epi(GmRegs& R, const bf16* P, const float* sgb, size_t t0, int g, int w, int fr, int fq) {
#pragma unroll
    for (int it = 0; it < 8; ++it) { const int i = 16 * it + fr; R.bs[it] = sgb[g * 128 + i]; R.uv[it] = *(const uint2*)(P + (t0 + i) * EVEN_IN + 3072 + g * 128 + 16 * w + 4 * fq); }
}
__device__ __forceinline__ void gmlp_unit(LAS unsigned char* lds, const bf16* P, const float* lng, const float* lnb, const float* sgw, const float* sgb, bf16* MIX, int u) {
    constexpr int ST = 272;
    LAS unsigned char* Wl = lds; LAS unsigned char* Zt = lds + 128 * ST; LAS float* stat = (LAS float*)(lds + 256 * ST);
    const int tid = opaque_tid(), lane = tid & 63, w = tid >> 6, fr = lane & 15, fq = lane >> 4;
    const int gp2 = u & 1, p = (u >> 1) & 15, b = u >> 5; const size_t t0 = (size_t)b * SEQ + (size_t)p * 128;
    const int c8 = (tid & 15) * 8;
    u32x4 zv[16];
#pragma unroll
    for (int i = 0; i < 16; ++i) zv[i] = *(const u32x4*)(P + (t0 + 16 * w + i) * EVEN_IN + 3584 + lane * 8);
    GmRegs R; gm_load(R, P, lng, lnb, sgw, sgb, t0, 2 * gp2, tid, w, fr, fq); gm_load_epi(R, P, sgb, t0, 2 * gp2, w, fr, fq);
    __syncthreads();
    { float val[32];
#pragma unroll
      for (int i = 0; i < 16; ++i) { float s = 0.f, q = 0.f;
#pragma unroll
          for (int k = 0; k < 4; ++k) { const float lo = __uint_as_float(zv[i][k] << 16), hi = __uint_as_float(zv[i][k] & 0xffff0000u); s += lo + hi; q += lo * lo + hi * hi; }
          val[2 * i] = sum_halves(s); val[2 * i + 1] = sum_halves(q); }
#define RS_STEP(M, HALF) do { const bool up = (lane & (M)) != 0; _Pragma("unroll") for (int i = 0; i < (HALF); ++i) { const float snd = up ? val[i] : val[i + (HALF)], kp = up ? val[i + (HALF)] : val[i]; val[i] = kp + xshfl<(M)>(snd); } } while (0)
      RS_STEP(16, 16); RS_STEP(8, 8); RS_STEP(4, 4); RS_STEP(2, 2); RS_STEP(1, 1);
#undef RS_STEP
      const float mine = val[0], other = xshfl<1>(mine);
      if ((lane & 33) == 0) { const float mu = mine * (1.0f / 512.0f); const float var = fmaxf(other * (1.0f / 512.0f) - mu * mu, 0.f); const int row = 16 * w + ((lane & 31) >> 1); stat[2 * row] = mu; stat[2 * row + 1] = rsqrtf(var + EPS); } }
#pragma unroll 1
    for (int gi = 0; gi < 2; ++gi) { const int g = 2 * gp2 + gi;
        if (gi == 1) __syncthreads();
#pragma unroll
        for (int i = 0; i < 8; ++i) { const int id = tid + 512 * i, r = id >> 5, c4 = (id & 31) * 4; float4 v = R.w4[i];
            if (r < 64 && c4 >= 64) v = make_float4(0.f, 0.f, 0.f, 0.f);
            u32x2 pk; pk.x = pg8::cvt_pk_bf16(v.x, v.y); pk.y = pg8::cvt_pk_bf16(v.z, v.w); *(LAS u32x2*)(Wl + r * ST + c4 * 2) = pk; }
        __syncthreads();
#pragma unroll
        for (int i = 0; i < 4; ++i) { const int id = tid + 512 * i, j = id >> 4; const u32x4 zz = R.z2[i];
            const float mu = stat[2 * j], rs = stat[2 * j + 1];
#pragma unroll
            for (int k = 0; k < 4; ++k) { const float gl_ = k < 2 ? R.lg0[2 * k] : R.lg1[2 * k - 4], gh_ = k < 2 ? R.lg0[2 * k + 1] : R.lg1[2 * k - 3], bl_ = k < 2 ? R.lb0[2 * k] : R.lb1[2 * k - 4], bh_ = k < 2 ? R.lb0[2 * k + 1] : R.lb1[2 * k - 3];
                const float lo = (__uint_as_float(zz[k] << 16) - mu) * rs * gl_ + bl_, hi = (__uint_as_float(zz[k] & 0xffff0000u) - mu) * rs * gh_ + bh_;
                const unsigned pk = pg8::cvt_pk_bf16(lo, hi);
                *(LAS unsigned short*)(Zt + (c8 + 2 * k) * ST + j * 2) = (unsigned short)(pk & 0xffffu); *(LAS unsigned short*)(Zt + (c8 + 2 * k + 1) * ST + j * 2) = (unsigned short)(pk >> 16); } }
        __syncthreads();
        if (gi == 0) gm_load(R, P, lng, lnb, sgw, sgb, t0, g + 1, tid, w, fr, fq);
        f32x4 acc[8];
#pragma unroll
        for (int it = 0; it < 8; ++it) acc[it] = (f32x4){0.f, 0.f, 0.f, 0.f};
#pragma unroll
        for (int s = 0; s < 4; ++s) { const bf16x8 zf = *(const LAS bf16x8*)(Zt + (16 * w + fr) * ST + (32 * s + 8 * fq) * 2);
#pragma unroll
            for (int it = 0; it < 8; ++it) { if (s >= 2 && it < 4) continue; const bf16x8 wf = *(const LAS bf16x8*)(Wl + (16 * it + fr) * ST + (32 * s + 8 * fq) * 2);
                acc[it] = __builtin_amdgcn_mfma_f32_16x16x32_bf16(zf, wf, acc[it], 0, 0, 0); } }
#pragma unroll
        for (int it = 0; it < 8; ++it) { const int i = 16 * it + fr; const float bs = R.bs[it]; const uint2 uv = R.uv[it];
            const float u0 = __uint_as_float(uv.x << 16), u1 = __uint_as_float(uv.x & 0xffff0000u), u2 = __uint_as_float(uv.y << 16), u3 = __uint_as_float(uv.y & 0xffff0000u);
            *(unsigned*)((unsigned char*)MIX + (t0 + i) * EVEN_MIX + 1024 + g * 128 + 16 * w + 4 * fq) = pg8::pk4_fp8(u0 * (acc[it][0] + bs), u1 * (acc[it][1] + bs), u2 * (acc[it][2] + bs), u3 * (acc[it][3] + bs)); }
        if (gi == 0) gm_load_epi(R, P, sgb, t0, g + 1, w, fr, fq);
    }
}
__device__ __forceinline__ void phase_e1(LAS unsigned char* lds, const bf16* P, bf16* KV, const float* lng, const float* lnb, const float* sgw, const float* sgb, bf16* MIX, int c0, int G, int ulo, int uhi) {
    KvRegs R; bool have = false;
    for (int u = ulo + c0; u < uhi; u += G) {
        if (u < 1024) { if (((u >> 2) & 31) == 31) continue;
            if (!have) kv_load(R, P, u, opaque_tid());
            int un = u + G; while (un < uhi && un < 1024 && ((un >> 2) & 31) == 31) un += G;
            const int unext = (un < uhi && un < 1024) ? un : -1;
            kv_unit(lds, P, KV, u, R, unext); have = unext >= 0; }
        else gmlp_unit(lds, P, lng, lnb, sgw, sgb, MIX, u - 1024);
    }
}
__device__ __forceinline__ void phase_e2(const bf16* KV, bf16* STt, int gtid, int nthr) {
    for (int idx = gtid; idx < NB * 4 * 4096; idx += nthr) {
        const int bh = idx >> 12, rem = (idx & 4095) * 8, b = bh >> 2, h = bh & 3;
        const float g64 = exp2f(64.0f * log2f(1.0f - exp2f(-5.0f - (float)h)));
        float S[8];
#pragma unroll
        for (int k = 0; k < 8; ++k) S[k] = 0.f;
        u32x4 kvv[31];
#pragma unroll
        for (int n = 0; n < 31; ++n) kvv[n] = *(const u32x4*)(KV + ((size_t)((b * 32 + n) * 4 + h)) * 32768 + rem);
#pragma unroll
        for (int n = 0; n < 31; ++n) { const size_t off = ((size_t)((b * 32 + n) * 4 + h)) * 32768 + rem; const u32x4 v = kvv[n];
#pragma unroll
            for (int k = 0; k < 4; ++k) { S[2 * k] = S[2 * k] * g64 + __uint_as_float(v[k] << 16); S[2 * k + 1] = S[2 * k + 1] * g64 + __uint_as_float(v[k] & 0xffff0000u); }
            u32x4 o;
#pragma unroll
            for (int k = 0; k < 4; ++k) o[k] = pg8::cvt_pk_bf16(S[2 * k], S[2 * k + 1]);
            *(u32x4*)(STt + off + 4 * 32768) = o; }
    }
}
struct RetRegs { u32x4 k[2], v[4], s[8]; bf16x8 q[4]; uint2 g[8]; };
__device__ __forceinline__ void ret_load(RetRegs& R, const bf16* P, const bf16* STt, int u, int tid, int it, int fr, int fq) {
    const int h = u & 3, n = (u >> 2) & 31, b = u >> 7; const size_t row0 = (size_t)b * SEQ + (size_t)n * 64;
#pragma unroll
    for (int i = 0; i < 2; ++i) { const int id = tid + 512 * i, j = id >> 4, seg = id & 15; R.k[i] = *(const u32x4*)(P + (row0 + j) * EVEN_IN + 512 + h * 128 + seg * 8); }
#pragma unroll
    for (int i = 0; i < 4; ++i) { const int id = tid + 512 * i, j = id >> 5, seg = id & 31; R.v[i] = *(const u32x4*)(P + (row0 + j) * EVEN_IN + 1024 + h * 256 + seg * 8); }
    if (n > 0) {
#pragma unroll
        for (int i = 0; i < 8; ++i) { const int id = tid + 512 * i, e = id >> 4, seg = id & 15; R.s[i] = *(const u32x4*)(STt + (size_t)u * 32768 + e * 128 + seg * 8); } }
#pragma unroll
    for (int s = 0; s < 4; ++s) R.q[s] = *(const bf16x8*)(P + (row0 + 16 * it + fr) * EVEN_IN + h * 128 + 32 * s + 8 * fq);
    { const int eh = (tid >> 6) & 1; const bf16* gp = P + (row0 + 16 * it + fr) * EVEN_IN + 2048 + h * 256 + 128 * eh + 4 * fq;
#pragma unroll
      for (int k = 0; k < 8; ++k) R.g[k] = *(const uint2*)(gp + 16 * k); }
}
__device__ __forceinline__ void ret_unit(LAS unsigned char* lds, const bf16* P, const bf16* STt, bf16* MIX, int u, RetRegs& R, int unext) {
    constexpr int KST = 272, VST = 528, SST = 272;
    LAS unsigned char* Ks = lds; LAS unsigned char* Vs = lds + 64 * KST; LAS unsigned char* Ss = Vs + 64 * VST; LAS float* dec = (LAS float*)(Ss + 256 * SST); LAS float* red = dec + 128;
    const int tid = opaque_tid(), lane = tid & 63, w = tid >> 6, fr = lane & 15, fq = lane >> 4, it = w >> 1, eh = w & 1;
    const int h = u & 3, n = (u >> 2) & 31, b = u >> 7;
    const float log2g = log2f(1.0f - exp2f(-5.0f - (float)h));
    const size_t row0 = (size_t)b * SEQ + (size_t)n * 64;
    __syncthreads();
    if (tid < 65) dec[tid] = exp2f(log2g * (float)tid);
#pragma unroll
    for (int i = 0; i < 2; ++i) { const int id = tid + 512 * i, j = id >> 4, seg = id & 15; *(LAS u32x4*)(Ks + j * KST + seg * 16) = R.k[i]; }
#pragma unroll
    for (int i = 0; i < 4; ++i) { const int id = tid + 512 * i, j = id >> 5, seg = id & 31; *(LAS u32x4*)(Vs + j * VST + seg * 16) = R.v[i]; }
    if (n > 0) {
#pragma unroll
        for (int i = 0; i < 8; ++i) { const int id = tid + 512 * i, e = id >> 4, seg = id & 15; *(LAS u32x4*)(Ss + e * SST + seg * 16) = R.s[i]; } }
    bf16x8 qf[4];
#pragma unroll
    for (int s = 0; s < 4; ++s) qf[s] = R.q[s];
    uint2 gcur[8];
#pragma unroll
    for (int k = 0; k < 8; ++k) gcur[k] = R.g[k];
    __syncthreads();
    if (unext >= 0) ret_load(R, P, STt, unext, tid, it, fr, fq);
    const int i_loc = 16 * it + fr;
    bf16x8 pf[2];
    { f32x4 pt[4];
#pragma unroll
      for (int t = 0; t < 4; ++t) { f32x4 a = (f32x4){0.f, 0.f, 0.f, 0.f};
#pragma unroll
          for (int s = 0; s < 4; ++s) { const bf16x8 kf = *(const LAS bf16x8*)(Ks + (16 * t + fr) * KST + (32 * s + 8 * fq) * 2); a = __builtin_amdgcn_mfma_f32_16x16x32_bf16(kf, qf[s], a, 0, 0, 0); }
#pragma unroll
          for (int r = 0; r < 4; ++r) { const int dj = i_loc - (16 * t + 4 * fq + r); a[r] *= dec[dj < 0 ? -dj : dj]; }
          pt[t] = a; }
      pf[0] = (bf16x8)pg8::pack8(pt[0], pt[1]); pf[1] = (bf16x8)pg8::pack8(pt[2], pt[3]); }
    f32x4 o[8];
#pragma unroll
    for (int k = 0; k < 8; ++k) o[k] = (f32x4){0.f, 0.f, 0.f, 0.f};
    if (n > 0) {
#pragma unroll
        for (int k = 0; k < 8; ++k)
#pragma unroll
            for (int s = 0; s < 4; ++s) { const bf16x8 sf = *(const LAS bf16x8*)(Ss + (16 * (8 * eh + k) + fr) * SST + (32 * s + 8 * fq) * 2); o[k] = __builtin_amdgcn_mfma_f32_16x16x32_bf16(sf, qf[s], o[k], 0, 0, 0); }
        const float qd = dec[i_loc + 1];
#pragma unroll
        for (int k = 0; k < 8; ++k) o[k] = o[k] * qd;
    }
#pragma unroll
    for (int s = 0; s < 2; ++s)
#pragma unroll
        for (int k = 0; k < 8; ++k) { const LAS unsigned char* vp = Vs + (32 * s + 4 * fq + (fr >> 2)) * VST + (16 * (8 * eh + k) + 4 * (fr & 3)) * 2; const bf16x8 vf = tr_frag(vp, vp + 16 * VST);
            o[k] = __builtin_amdgcn_mfma_f32_16x16x32_bf16(vf, pf[s], o[k], 0, 0, 0); }
    float s1 = 0.f, s2 = 0.f;
#pragma unroll
    for (int k = 0; k < 8; ++k)
#pragma unroll
        for (int r = 0; r < 4; ++r) { s1 += o[k][r]; s2 += o[k][r] * o[k][r]; }
    s1 += xshfl<16>(s1); s1 = sum_halves(s1); s2 += xshfl<16>(s2); s2 = sum_halves(s2);
    if (fq == 0) { red[(w * 16 + fr) * 2] = s1; red[(w * 16 + fr) * 2 + 1] = s2; }
    __syncthreads();
    { const int wo = w ^ 1; s1 += red[(wo * 16 + fr) * 2]; s2 += red[(wo * 16 + fr) * 2 + 1]; }
    const float mu = s1 * (1.0f / 256.0f), var = fmaxf(s2 * (1.0f / 256.0f) - mu * mu, 0.f), rs = rsqrtf(var + EPS);
    const bf16* gp = P + (row0 + i_loc) * EVEN_IN + 2048 + h * 256 + 128 * eh + 4 * fq; unsigned char* dst = (unsigned char*)MIX + (row0 + i_loc) * EVEN_MIX + h * 256 + 128 * eh + 4 * fq;
#pragma unroll
    for (int k = 0; k < 8; ++k) { const uint2 gv = gcur[k];
        const float g0 = __uint_as_float(gv.x << 16), g1 = __uint_as_float(gv.x & 0xffff0000u), g2 = __uint_as_float(gv.y << 16), g3 = __uint_as_float(gv.y & 0xffff0000u);
        *(unsigned*)(dst + 16 * k) = pg8::pk4_fp8((o[k][0] - mu) * rs * g0, (o[k][1] - mu) * rs * g1, (o[k][2] - mu) * rs * g2, (o[k][3] - mu) * rs * g3); }
}
__device__ __forceinline__ void phase_e3(LAS unsigned char* lds, const bf16* P, const bf16* STt, bf16* MIX, int c0, int G) {
    RetRegs R; { const int tid = opaque_tid(), lane = tid & 63; if (c0 < 1024) ret_load(R, P, STt, c0, tid, tid >> 7, lane & 15, lane >> 4); }
    for (int u = c0; u < 1024; u += G) ret_unit(lds, P, STt, MIX, u, R, u + G < 1024 ? u + G : -1);
}
typedef float f32x4g __attribute__((ext_vector_type(4)));
__device__ __forceinline__ void phase_mod(LAS unsigned char* lds, const float* c, const float* ada_w, const float* ada_b, float* MOD, int c0, int G) {
    LAS float* ca = (LAS float*)lds; LAS float* red = (LAS float*)(lds + 32768);
    const int tid = opaque_tid(), lane = tid & 63, w = tid >> 6;
    __syncthreads();
    for (int i = tid; i < 8192; i += 512) { const float v = c[i]; ca[i] = v / (1.0f + __expf(-v)); }
    __syncthreads();
    for (int u = c0; u < DEPTH * 96; u += G) { const int l = u / 96, n0 = (u % 96) * 64;
        const float* wp = ada_w + ((size_t)l * 1024 + 128 * w) * 6144 + n0 + lane; float acc[8];
#pragma unroll
        for (int b = 0; b < 8; ++b) acc[b] = 0.f;
#pragma unroll 32
        for (int k = 0; k < 128; ++k) { const float wv = __builtin_nontemporal_load(wp + (size_t)k * 6144);
#pragma unroll
            for (int b = 0; b < 8; ++b) acc[b] += ca[b * 1024 + 128 * w + k] * wv; }
#pragma unroll
        for (int b = 0; b < 8; ++b) red[(w * 8 + b) * 64 + lane] = acc[b];
        __syncthreads();
        { const int b = tid >> 6; float s = 0.f;
#pragma unroll
          for (int ww = 0; ww < 8; ++ww) s += red[(ww * 8 + b) * 64 + lane];
          MOD[(size_t)(l * 8 + b) * 6144 + n0 + lane] = s + ada_b[l * 6144 + n0 + lane]; }
        __syncthreads(); }
}
__device__ __forceinline__ void phase_rope(float* COS, float* SIN, int gtid, int nthr) {
    for (int i = gtid; i < SEQ * 64; i += nthr) { const int pos = i >> 6, d = i & 63; const float inv = powf(10000.0f, -(float)d / 64.0f); const float ang = (float)pos * inv; COS[i] = cosf(ang); SIN[i] = sinf(ang); }
}
__device__ __forceinline__ f32x4g ld4bf(const bf16* p) { const uint2 y = *(const uint2*)p; return (f32x4g){__uint_as_float(y.x << 16), __uint_as_float(y.x & 0xffff0000u), __uint_as_float(y.y << 16), __uint_as_float(y.y & 0xffff0000u)}; }
__device__ __forceinline__ void st4bf(bf16* p, const f32x4g v) { uint2 pk; pk.x = pg8::cvt_pk_bf16(v[0], v[1]); pk.y = pg8::cvt_pk_bf16(v[2], v[3]); *(uint2*)p = pk; }
template <bool IN_F32, bool OUT_F32> __device__ __forceinline__ void phase_norm1_generic(const void* Xin_, void* Xout_, bool store_x, const bf16* YS, const float* MODprev, bool combine, const float* g, const float* MODl, bf16* H, bool do_norm, int gw, int ngw, bool h_fp8 = false, unsigned char* H8 = nullptr) {
    const int lane = opaque_tid() & 63;
    for (int row = gw; row < T_TOK; row += ngw) { const int b = row / SEQ; f32x4g v[4];
#pragma unroll
        for (int j = 0; j < 4; ++j) { if constexpr (IN_F32) v[j] = *(const f32x4g*)((const float*)Xin_ + (size_t)row * DM + 256 * j + 4 * lane); else v[j] = ld4bf((const bf16*)Xin_ + (size_t)row * DM + 256 * j + 4 * lane); }
        if (combine) { const float* g2 = MODprev + (size_t)b * 6144 + 5120;
#pragma unroll
            for (int j = 0; j < 4; ++j) { f32x4g s = (f32x4g){0.f, 0.f, 0.f, 0.f};
#pragma unroll
                for (int k = 0; k < 4; ++k) { const int y = *(const int*)((const unsigned char*)YS + ((size_t)row * 4 + k) * DM + 256 * j + 4 * lane);
                    const auto lo = __builtin_amdgcn_cvt_pk_f32_fp8(y, false), hi = __builtin_amdgcn_cvt_pk_f32_fp8(y, true); s[0] += lo[0]; s[1] += lo[1]; s[2] += hi[0]; s[3] += hi[1]; }
                v[j] = v[j] + *(const f32x4g*)(g2 + 256 * j + 4 * lane) * (s * YSCALE_INV); } }
        if (store_x) {
#pragma unroll
            for (int j = 0; j < 4; ++j) { if constexpr (OUT_F32) __builtin_nontemporal_store(v[j], (f32x4g*)((float*)Xout_ + (size_t)row * DM + 256 * j + 4 * lane));   else st4bf((bf16*)Xout_ + (size_t)row * DM + 256 * j + 4 * lane, v[j]); } }
        if (do_norm) { float ss = 0.f;
#pragma unroll
            for (int j = 0; j < 4; ++j) ss += (v[j][0] * v[j][0] + v[j][1] * v[j][1]) + (v[j][2] * v[j][2] + v[j][3] * v[j][3]);
            ss = wave_sum(ss); const float r = rsqrtf(ss * (1.0f / DM) + EPS); const float* mod = MODl + (size_t)b * 6144;
#pragma unroll
            for (int j = 0; j < 4; ++j) { const int k = 256 * j + 4 * lane; const f32x4g gv = *(const f32x4g*)(g + k), sc = *(const f32x4g*)(mod + 1024 + k), sh = *(const f32x4g*)(mod + k);
                const f32x4g hv = v[j] * r * gv * (sc + 1.0f) + sh;
                if (H8) *(unsigned*)(H8 + (size_t)row * DM + k) = pg8::pk4_fp8(hv[0], hv[1], hv[2], hv[3]);
                if (h_fp8) *(unsigned*)((unsigned char*)H + (size_t)row * DM + k) = pg8::pk4_fp8(hv[0], hv[1], hv[2], hv[3]);
                else { uint2 pk; pk.x = pg8::cvt_pk_bf16(hv[0], hv[1]); pk.y = pg8::cvt_pk_bf16(hv[2], hv[3]); *(uint2*)(H + (size_t)row * DM + k) = pk; } } }
    }
}
template <bool IN_F32, bool OUT_F32> __device__ __forceinline__ void phase_norm1(const void* Xin_, void* Xout_, bool store_x, const bf16* YS, const float* MODprev, bool combine, const float* g, const float* MODl, bf16* H, bool do_norm, int gw, int ngw, bool h_fp8 = false, unsigned char* H8 = nullptr) {
    const int rpw = T_TOK / ngw;
    if (rpw * ngw != T_TOK || (SEQ % rpw) != 0 || combine != !IN_F32 || do_norm != !OUT_F32 || !store_x) { phase_norm1_generic<IN_F32, OUT_F32>(Xin_, Xout_, store_x, YS, MODprev, combine, g, MODl, H, do_norm, gw, ngw, h_fp8, H8); return; }
    constexpr bool COMB = !IN_F32, NORM = !OUT_F32;
    const int lane = opaque_tid() & 63; const int row0 = gw * rpw, rend = row0 + rpw, b = row0 / SEQ;
    f32x4g g2v[4], gv[4], scv[4], shv[4];
#pragma unroll
    for (int j = 0; j < 4; ++j) { const int k = 256 * j + 4 * lane;
        if constexpr (COMB) g2v[j] = *(const f32x4g*)(MODprev + (size_t)b * 6144 + 5120 + k) * YSCALE_INV;
        if constexpr (NORM) { gv[j] = *(const f32x4g*)(g + k); scv[j] = *(const f32x4g*)(MODl + (size_t)b * 6144 + 1024 + k) + 1.0f; shv[j] = *(const f32x4g*)(MODl + (size_t)b * 6144 + k); gv[j] = gv[j] * scv[j]; } }
    f32x4g xfa[4], xfb[4]; uint2 xba[4], xbb[4]; int ya[16], yb[16];
#define N1_LOAD(XF, XB_, Y, r_) do { \
        _Pragma("unroll") for (int j = 0; j < 4; ++j) { if constexpr (IN_F32) XF[j] = *(const f32x4g*)((const float*)Xin_ + (size_t)(r_) * DM + 256 * j + 4 * lane); else XB_[j] = *(const uint2*)((const bf16*)Xin_ + (size_t)(r_) * DM + 256 * j + 4 * lane); } \
        if constexpr (COMB) { _Pragma("unroll") for (int j = 0; j < 4; ++j) { _Pragma("unroll") for (int k = 0; k < 4; ++k) Y[4 * j + k] = *(const int*)((const unsigned char*)YS + ((size_t)(r_) * 4 + k) * DM + 256 * j + 4 * lane); } } \
    } while (0)
#define N1_PROC(XF, XB_, Y, r_) do { f32x4g v[4]; \
        _Pragma("unroll") for (int j = 0; j < 4; ++j) { if constexpr (IN_F32) v[j] = XF[j]; else v[j] = (f32x4g){__uint_as_float(XB_[j].x << 16), __uint_as_float(XB_[j].x & 0xffff0000u), __uint_as_float(XB_[j].y << 16), __uint_as_float(XB_[j].y & 0xffff0000u)}; } \
        if constexpr (COMB) { _Pragma("unroll") for (int j = 0; j < 4; ++j) { f32x4g s = (f32x4g){0.f, 0.f, 0.f, 0.f}; \
            _Pragma("unroll") for (int k = 0; k < 4; ++k) { const auto lo = __builtin_amdgcn_cvt_pk_f32_fp8(Y[4 * j + k], false), hi = __builtin_amdgcn_cvt_pk_f32_fp8(Y[4 * j + k], true); s[0] += lo[0]; s[1] += lo[1]; s[2] += hi[0]; s[3] += hi[1]; } \
            v[j] = v[j] + g2v[j] * s; } } \
        _Pragma("unroll") for (int j = 0; j < 4; ++j) { if constexpr (OUT_F32) __builtin_nontemporal_store(v[j], (f32x4g*)((float*)Xout_ + (size_t)(r_) * DM + 256 * j + 4 * lane)); else st4bf((bf16*)Xout_ + (size_t)(r_) * DM + 256 * j + 4 * lane, v[j]); } \
        if constexpr (NORM) { float ss = 0.f; \
            _Pragma("unroll") for (int j = 0; j < 4; ++j) ss += (v[j][0] * v[j][0] + v[j][1] * v[j][1]) + (v[j][2] * v[j][2] + v[j][3] * v[j][3]); \
            ss = wave_sum(ss); const float rr = rsqrtf(ss * (1.0f / DM) + EPS); \
            _Pragma("unroll") for (int j = 0; j < 4; ++j) { const int k = 256 * j + 4 * lane; const f32x4g hv = v[j] * rr * gv[j] + shv[j]; \
                if (H8) *(unsigned*)(H8 + (size_t)(r_) * DM + k) = pg8::pk4_fp8(hv[0], hv[1], hv[2], hv[3]); \
                if (h_fp8) *(unsigned*)((unsigned char*)H + (size_t)(r_) * DM + k) = pg8::pk4_fp8(hv[0], hv[1], hv[2], hv[3]); \
                else { uint2 pk; pk.x = pg8::cvt_pk_bf16(hv[0], hv[1]); pk.y = pg8::cvt_pk_bf16(hv[2], hv[3]); *(uint2*)(H + (size_t)(r_) * DM + k) = pk; } } } \
    } while (0)
    int row = row0;
    N1_LOAD(xfa, xba, ya, row);
    for (;;) {
        if (row + 1 >= rend) { N1_PROC(xfa, xba, ya, row); break; }
        N1_LOAD(xfb, xbb, yb, row + 1); asm volatile("" ::: "memory"); N1_PROC(xfa, xba, ya, row); ++row;
        if (row + 1 >= rend) { N1_PROC(xfb, xbb, yb, row); break; }
        N1_LOAD(xfa, xba, ya, row + 1); asm volatile("" ::: "memory"); N1_PROC(xfb, xbb, yb, row); ++row;
    }
#undef N1_LOAD
#undef N1_PROC
}
__device__ __forceinline__ void phase_router(LAS unsigned char* lds, const bf16* X, const float* gffn, const float* MODl, const float* rw, const float* rb, bf16* H,
                                             int* RSLOT, float* RGATE, int* COUNTS, int c0, int G) {
    LAS float* wf = (LAS float*)lds; LAS float* GV = (LAS float*)(lds + 131072); LAS float* SH = GV + 1024;
    LAS float* rs = (LAS float*)(lds + LDS_CTL_OFF + 1536); LAS int* hist = (LAS int*)(rs + 64); LAS int* base = hist + 32; LAS int* rank = base + 32; LAS int* eid = rank + 256; LAS float* gl = (LAS float*)(eid + 256);
    const int tid = opaque_tid(), lane = tid & 63, w = tid >> 6, fr = lane & 15, kq = lane >> 4;
    for (int unit = c0; unit < T_TOK / 64; unit += G) { const int t0 = unit * 64, b = t0 / SEQ; const float* mod = MODl + (size_t)b * 6144;
        __syncthreads();
        f32x4g rwv[16];
#pragma unroll
        for (int i = 0; i < 16; ++i) rwv[i] = *(const f32x4g*)(rw + 4 * (tid + 512 * i));
        for (int k = tid; k < DM; k += 512) { GV[k] = gffn[k] * (1.0f + mod[4096 + k]); SH[k] = mod[3072 + k]; }
        if (tid < 32) hist[tid] = 0;
        __syncthreads();
#pragma unroll
        for (int i = 0; i < 8; ++i) { const int row = t0 + 8 * w + i; f32x4g v[4]; float ss = 0.f;
#pragma unroll
            for (int j = 0; j < 4; ++j) { v[j] = ld4bf(X + (size_t)row * DM + 256 * j + 4 * lane); ss += (v[j][0] * v[j][0] + v[j][1] * v[j][1]) + (v[j][2] * v[j][2] + v[j][3] * v[j][3]); }
            ss = wave_sum(ss); const float r = rsqrtf(ss * (1.0f / DM) + EPS); if (lane == 0) rs[8 * w + i] = r;
#pragma unroll
            for (int j = 0; j < 4; ++j) { const int k = 256 * j + 4 * lane; const f32x4g gv = *(const LAS f32x4g*)(GV + k), sh = *(const LAS f32x4g*)(SH + k);
                const f32x4g hv = v[j] * r * gv + sh; *(unsigned*)((unsigned char*)H + (size_t)row * DM + k) = pg8::pk4_fp8(hv[0], hv[1], hv[2], hv[3]); } }
#pragma unroll
        for (int i = 0; i < 16; ++i) { const int q = tid + 512 * i, k = q >> 3, e = (q & 7) * 4; const int l = (k >> 8) * 16 + (e & 15), et = e >> 4, s = k & 255; LAS float* d = wf + ((s >> 2) * 2 + et) * 256 + 4 * l + (s & 3);
            d[0] = rwv[i][0]; d[4] = rwv[i][1]; d[8] = rwv[i][2]; d[12] = rwv[i][3]; }
        __syncthreads();
        const int tg = w & 3, kh = w >> 2, tok = t0 + 16 * tg + fr; const float r = rs[16 * tg + fr];
        f32x4 acc0 = (f32x4){0.f, 0.f, 0.f, 0.f}, acc1 = (f32x4){0.f, 0.f, 0.f, 0.f};
        { const bf16* xp = X + (size_t)tok * DM + 256 * kq + 128 * kh; const LAS float* gp = GV + 256 * kq + 128 * kh; const LAS float* shp = SH + 256 * kq + 128 * kh; const LAS float* wp = wf + (size_t)(64 * kh) * 256 + 4 * lane;
          uint2 xr[32];
#pragma unroll
          for (int u = 0; u < 32; ++u) xr[u] = *(const uint2*)(xp + 4 * u);
#pragma unroll
          for (int u = 0; u < 32; ++u) { const f32x4g xv = (f32x4g){__uint_as_float(xr[u].x << 16), __uint_as_float(xr[u].x & 0xffff0000u), __uint_as_float(xr[u].y << 16), __uint_as_float(xr[u].y & 0xffff0000u)}, gv = *(const LAS f32x4g*)(gp + 4 * u), sh = *(const LAS f32x4g*)(shp + 4 * u);
              const f32x4g hv = xv * r * gv + sh; const f32x4g w0 = *(const LAS f32x4g*)(wp + (u * 2) * 256), w1 = *(const LAS f32x4g*)(wp + (u * 2 + 1) * 256);
#pragma unroll
              for (int q = 0; q < 4; ++q) { acc0 = __builtin_amdgcn_mfma_f32_16x16x4f32(w0[q], hv[q], acc0, 0, 0, 0); acc1 = __builtin_amdgcn_mfma_f32_16x16x4f32(w1[q], hv[q], acc1, 0, 0, 0); } } }
        __syncthreads();
        if (kh == 1) { *(LAS f32x4*)(wf + (tg * 64 + lane) * 8) = acc0; *(LAS f32x4*)(wf + (tg * 64 + lane) * 8 + 4) = acc1; }
        __syncthreads();
        if (kh == 0) {
            acc0 = acc0 + *(const LAS f32x4*)(wf + (tg * 64 + lane) * 8); acc1 = acc1 + *(const LAS f32x4*)(wf + (tg * 64 + lane) * 8 + 4);
            float vals[8];
#pragma unroll
            for (int q = 0; q < 4; ++q) { vals[q] = acc0[q] + rb[4 * kq + q]; vals[4 + q] = acc1[q] + rb[16 + 4 * kq + q]; }
            unsigned taken = 0u; float tv[4]; int ti[4];
#pragma unroll
            for (int rr = 0; rr < 4; ++rr) { float bv = -3.0e38f; int bi = 64;
#pragma unroll
                for (int cc = 0; cc < 8; ++cc) { const int e = 16 * (cc >> 2) + 4 * kq + (cc & 3); const float v = ((taken >> cc) & 1u) ? -3.0e38f : vals[cc]; if (v > bv || (v == bv && e < bi)) { bv = v; bi = e; } }
                { const float ov = xshfl<16>(bv); const int oi = xshfl_i<16>(bi); if (ov > bv || (ov == bv && oi < bi)) { bv = ov; bi = oi; } }
                { const auto rv = __builtin_amdgcn_permlane32_swap(__float_as_uint(bv), __float_as_uint(bv), false, false); const auto ri = __builtin_amdgcn_permlane32_swap((unsigned)bi, (unsigned)bi, false, false);
                  const float v0 = __uint_as_float(rv[0]), v1 = __uint_as_float(rv[1]); const int i0 = (int)ri[0], i1 = (int)ri[1]; const bool take1 = v1 > v0 || (v1 == v0 && i1 < i0); bv = take1 ? v1 : v0; bi = take1 ? i1 : i0; }
                tv[rr] = bv; ti[rr] = bi; if (((bi >> 2) & 3) == kq) taken |= 1u << (((bi >> 4) << 2) | (bi & 3)); }
            const float e1 = __expf(tv[1] - tv[0]), e2 = __expf(tv[2] - tv[0]), e3 = __expf(tv[3] - tv[0]), inv = 1.0f / (1.0f + e1 + e2 + e3);
            if (kq == 0) { const float gt[4] = {inv, e1 * inv, e2 * inv, e3 * inv};
#pragma unroll
                for (int rr = 0; rr < 4; ++rr) { const int a = (16 * tg + fr) * 4 + rr; eid[a] = ti[rr]; gl[a] = gt[rr]; rank[a] = atomicAdd((int*)(hist + ti[rr]), 1); } }
        }
        __syncthreads();
        if (tid < 32) base[tid] = atomicAdd(&COUNTS[tid], hist[tid]);
        __syncthreads();
        if (tid < 256) { const int e = eid[tid], dest = e * EREG + base[e] + rank[tid]; RSLOT[dest] = t0 * 4 + tid; RGATE[dest] = gl[tid]; }
    }
}
__device__ __forceinline__ void moe_prefix(LAS int* ps, const int* COUNTS) {
    if (opaque_tid() == 0) { int a = 0; for (int e = 0; e < NEXP; ++e) { const int cnt = COUNTS[e]; ps[e] = a; ps[64 + e] = cnt; a += ((cnt + 255) >> 8) << 8; } ps[NEXP] = a; }
    __syncthreads();
}
__device__ __forceinline__ void phase_gather(LAS unsigned char* lds, const bf16* H, const int* TOPI, const float* TOPG, const int* POS, const int* COUNTS, bf16* XS, int* ROWSLOT, float* ROWGATE, int c0, int G) {
    LAS int* ps = (LAS int*)lds; const int tid = opaque_tid(), lane = tid & 63, w = tid >> 6;
    __syncthreads(); moe_prefix(ps, COUNTS);
    for (int a = c0 * 8 + w; a < T_TOK * 4; a += G * 8) { const int t = a >> 2, e = TOPI[a], dest = ps[e] + POS[a];
        const u32x4* src = (const u32x4*)((const unsigned char*)H + (size_t)t * DM); u32x4* dst = (u32x4*)((unsigned char*)XS + (size_t)dest * DM); dst[lane] = src[lane];
        if (lane == 0) { ROWSLOT[dest] = a; ROWGATE[dest] = TOPG[a]; } }
    for (int e = c0; e < NEXP; e += G) for (int r = ps[e] + ps[64 + e] + tid; r < ps[e + 1]; r += 512) ROWSLOT[r] = -1;
}
#define XB_TMO      128
#define XB_XCNT(j)  (256  + 64 * (j))
#define XB_XSUB(j)  (1280 + 64 * (j))
#define XB_XGEN(j)  (2304 + 64 * (j))
#define XB_TOP      3328
#define XB_TOPGEN   3392
#define XCD_BAR_WORDS 3456
#define XB_SPIN_CAP (1u << 18)
#define LAS __attribute__((address_space(3)))

__device__ __forceinline__ unsigned xb_ld(unsigned* p)              { return __hip_atomic_load(p, __ATOMIC_RELAXED, __HIP_MEMORY_SCOPE_AGENT); }
__device__ __forceinline__ unsigned xb_add(unsigned* p, unsigned v) { return __hip_atomic_fetch_add(p, v, __ATOMIC_RELAXED, __HIP_MEMORY_SCOPE_AGENT); }
__device__ __forceinline__ unsigned xb_xcc_id() { return (unsigned)__builtin_amdgcn_s_getreg((3 << 11) | 20) & 0xFu; }
#define XB_SPIN(cond, bar) do { unsigned _sp = 0; while (cond) { __builtin_amdgcn_s_sleep(1); \
    if ((++_sp & 255u) == 0u) { if (xb_ld(&(bar)[XB_TMO])) break; if (_sp > XB_SPIN_CAP) { atomicAdd(&(bar)[XB_TMO], 1u); break; } } } } while (0)

struct XcdBarrier {
    unsigned* bar; unsigned x;
    volatile LAS unsigned* st;
};

__device__ __forceinline__ XcdBarrier xcd_barrier_post(unsigned* bar, volatile LAS unsigned* st) {
    XcdBarrier b; b.bar = bar; b.x = xb_xcc_id(); b.st = st;
    if (opaque_tid() == 0) (void)xb_add(&bar[XB_XCNT(b.x)], 1u);
    return b;
}
__device__ __forceinline__ void xcd_barrier_complete(unsigned* bar, unsigned x, unsigned& nloc, unsigned& nx) {
    const unsigned G = gridDim.x * gridDim.y * gridDim.z;
    unsigned sum, cnt, mine, sp = 0u;
    for (;;) {
        sum = 0u; cnt = 0u; mine = 0u;
#pragma unroll
        for (unsigned j = 0; j < 16; ++j) { const unsigned c = xb_ld(&bar[XB_XCNT(j)]); sum += c; cnt += (c > 0u) ? 1u : 0u; mine = (j == x) ? c : mine; }
        if (sum == G) break;
        __builtin_amdgcn_s_sleep(1);
        if ((++sp & 255u) == 0u) { if (xb_ld(&bar[XB_TMO])) break; if (sp > XB_SPIN_CAP) { atomicAdd(&bar[XB_TMO], 1u); break; } }
    }
    nloc = mine > 0u ? mine : 1u; nx = cnt > 0u ? cnt : 1u;
}

__device__ __forceinline__ void xcd_barrier(const XcdBarrier& b) {
    asm volatile("s_waitcnt vmcnt(0)" ::: "memory");
    __syncthreads();
    if (opaque_tid() == 0) {
        unsigned* bar = b.bar;
        __builtin_amdgcn_s_waitcnt(0);
        unsigned nloc = b.st[0], nx = b.st[1];
        if (nloc == 0u) { xcd_barrier_complete(bar, b.x, nloc, nx); b.st[0] = nloc; b.st[1] = nx; }
        const unsigned old = xb_add(&bar[XB_XSUB(b.x)], 1u);
        const unsigned gen = old / nloc;
        if (old + 1u == (gen + 1u) * nloc) {
            __builtin_amdgcn_fence(__ATOMIC_RELEASE, "agent");
            asm volatile("s_waitcnt vmcnt(0)" ::: "memory");
            const unsigned og = xb_add(&bar[XB_TOP], 1u);
            const unsigned tg = og / nx;
            if (og + 1u == (tg + 1u) * nx) xb_add(&bar[XB_TOPGEN], 1u);
            else XB_SPIN(xb_ld(&bar[XB_TOPGEN]) == tg, bar);
            __builtin_amdgcn_fence(__ATOMIC_ACQUIRE, "agent");
            xb_add(&bar[XB_XGEN(b.x)], 1u);
            asm volatile("s_waitcnt vmcnt(0)" ::: "memory");
        } else {
            XB_SPIN(xb_ld(&bar[XB_XGEN(b.x)]) == gen, bar);
            __builtin_amdgcn_fence(__ATOMIC_ACQUIRE, "agent");
            asm volatile("s_waitcnt vmcnt(0)" ::: "memory");
        }
    }
    __syncthreads();
}
#ifndef PROBE_DUP
#define PROBE_DUP 0
#endif
#define DUP(bit, ...) do { __VA_ARGS__; if (PROBE_DUP & (bit)) { __VA_ARGS__; } } while (0)
#ifndef MK_PER_PHASE
#define MK_PER_PHASE 0
#endif
constexpr int N_PHASES = 2 + 12 * DEPTH;
struct Args { const float* in[23]; float* out; unsigned char* ws; int ph_lo, ph_hi; };
__device__ __forceinline__ void moe_table(LAS int* tab, const int* COUNTS, int NT, int G, int c, const int* RSLOT, LAS unsigned short* gath) {
    __syncthreads();
    const int tid = opaque_tid();
    if (tid < NEXP) tab[160 + tid] = COUNTS[tid];
    __syncthreads();
    if (tid == 0) { int a = 0, row = 0; for (int e = 0; e < NEXP; ++e) { const int mt = (tab[160 + e] + 255) >> 8; tab[e] = a; tab[64 + e] = row; tab[128 + e] = mt; a += mt * NT; row += mt; } tab[32] = a; }
    __syncthreads();
    if (tid < 14) { const int nwg = tab[32]; const long L = (long)tid * G + c;
        if (L < nwg) { int w = (int)L; { const int q = nwg / 8, r = nwg % 8, xcd = w % 8, off = w / 8; w = (xcd < r ? xcd * (q + 1) : r * (q + 1) + (xcd - r) * q) + off; }
            int e = 0; for (int k = 1; k < 32; ++k) e += (w >= tab[k]) ? 1 : 0;
            const int local = w - tab[e], mt = tab[128 + e]; tab[194 + 2 * tid] = tab[64 + e] + local % mt; tab[195 + 2 * tid] = e * NT + local / mt; }
        if (tid == 0) { const int mine = nwg > c ? (nwg - c + G - 1) / G : 0; tab[192] = mine < 14 ? mine : 14; } }
    __syncthreads();
    if (gath) {
        const int mine = tab[192];
        int sl[7]; const int lim = mine * 256;
        if (mine > 0) {
#pragma unroll
        for (int ps = 0; ps < 7; ++ps) { const int idx = tid + 512 * ps, ic = idx < lim ? idx : 0, i = ic >> 8, r = ic & 255, pm = tab[194 + 2 * i], e = tab[195 + 2 * i] / NT, rl = (pm - tab[64 + e]) * 256 + r, cnt = tab[160 + e];
            const int rlc = rl < cnt ? rl : 0; const int v = RSLOT[e * EREG + rlc]; sl[ps] = rl < cnt ? (v >> 2) : 0; }
#pragma unroll
        for (int ps = 0; ps < 7; ++ps) { const int idx = tid + 512 * ps; if (idx < lim) gath[idx] = (unsigned short)sl[ps]; } }
        __syncthreads(); }
}
typedef __attribute__((address_space(1))) unsigned char* gptr_t;
__device__ __forceinline__ unsigned char* opq(unsigned char* p) { gptr_t g = (gptr_t)p; asm volatile("" : "+s"(g)); return (unsigned char*)g; }
__global__ void __launch_bounds__(512, 2) mega(Args a) {
    extern __shared__ __attribute__((aligned(16))) unsigned char lds_raw[];
    LAS unsigned char* L = (LAS unsigned char*)lds_raw;
    const int G = (int)gridDim.x, c0 = (int)blockIdx.x;
    const int lo = a.ph_lo, hi = a.ph_hi;
#define WSP(type, off) ((type*)(opq(a.ws) + (off)))
#define GW (c0 * 8 + __builtin_amdgcn_readfirstlane(opaque_tid() >> 6))
#define NGW (G * 8)
    { const int tid = opaque_tid(); if (tid < 4) ((LAS unsigned*)(L + LDS_CTL_OFF + 1024))[tid] = 0u; }
    __syncthreads();
    XcdBarrier bar = xcd_barrier_post(WSP(unsigned, WS_CTL) + CW_BAR, (volatile LAS unsigned*)(L + LDS_CTL_OFF + 1024));
#define IN(k) (lo <= (k) && (k) < hi)
#define SEAM(k) do { if ((k) + 1 < hi) { XcdBarrier b2_ = bar; b2_.bar = (unsigned*)opq((unsigned char*)bar.bar); xcd_barrier(b2_); if (PROBE_DUP & 8192) { XcdBarrier b3_ = bar; b3_.bar = (unsigned*)opq((unsigned char*)bar.bar); xcd_barrier(b3_); } } } while (0)
    if (IN(0)) {
        DUP(1, {
        phase_rope(WSP(float, WS_COS), WSP(float, WS_SIN), c0 * 512 + opaque_tid(), G * 512);
        phase_mod(L, a.in[1], a.in[2], a.in[3], WSP(float, WS_MOD), c0, G);
        __syncthreads();
        convert_job<1024, 4096, 1, 2, 0, false, 0, 32>(L, a.in[6], WSP(bf16, WS_WEVIN), GW, NGW);
        convert_job<1024, 4096, 1, 2, 512, true, 32, 96>(L, a.in[6], WSP(bf16, WS_WEVIN8), GW, NGW);
        convert_job<1536, 1024, 0, 2, CVT_T0, true>(L, a.in[7], WSP(bf16, WS_WEVOUT), GW, NGW);
        convert_job<1024, 3072, 2, 2, CVT_T0 + CVT_T1, true>(L, a.in[12], WSP(bf16, WS_WODIN), GW, NGW);
        convert_job<1024, 1024, 0, 2, CVT_T0 + CVT_T1 + CVT_T2, true>(L, a.in[13], WSP(bf16, WS_WODOUT), GW, NGW);
        convert_job<1024, 2048, 3, 128, CVT_T0 + CVT_T1 + CVT_T2 + CVT_T3, true>(L, a.in[19], WSP(bf16, WS_W1), GW, NGW);
        convert_job<1024, 1024, 0, 128, CVT_T0 + CVT_T1 + CVT_T2 + CVT_T3 + CVT_T4, true>(L, a.in[21], WSP(bf16, WS_W2), GW, NGW);
        });
        SEAM(0);
    }
    {
        constexpr int l = 0;
        const int pb = 1 + 12 * l, i = l >> 1; const bool odd = (l & 1) != 0;
#define MODL (WSP(float, WS_MOD) + (size_t)l * 8 * 6144)
#define COUNTSL (WSP(int, WS_CTL) + CW_COUNTS + 64 * l)
        if (IN(pb + 0)) { if (l == 0) phase_norm1<true, false>(a.in[0], WSP(bf16, WS_XB), true, WSP(bf16, WS_YS), MODL, false, a.in[4] + l * DM, MODL, WSP(bf16, WS_H), true, GW, NGW, odd, odd ? nullptr : WSP(unsigned char, WS_H8)); else phase_norm1<false, false>(WSP(bf16, WS_XB), WSP(bf16, WS_XB), true, WSP(bf16, WS_YS), MODL - 8 * 6144, true, a.in[4] + l * DM, MODL, WSP(bf16, WS_H), true, GW, NGW, odd, odd ? nullptr : WSP(unsigned char, WS_H8)); SEAM(pb + 0); }
        if (IN(pb + 1)) {
            if (!odd) {
                { pg8::Gemm g{WSP(bf16, WS_H), WSP(bf16, WS_WEVIN) + (size_t)i * EVEN_IN * DM, T_TOK, 1024, DM, 0}; pg8::StaticOrder S; S.init(T_TOK, 1024, G, c0);
                  DUP(2, pg8::gemm_phase<EpiEvenIn, pg8::StaticOrder, true, true>(L, g, S, EpiEvenIn{WSP(bf16, WS_PROJ), WSP(float, WS_COS), WSP(float, WS_SIN), 0, 1.0f})); }
                { pg8::Gemm g{WSP(bf16, WS_H8), WSP(bf16, WS_WEVIN8) + ((size_t)i * EVEN_IN + 1024) * (DM / 2), T_TOK, 3072, DM / 2, 0}; pg8::StaticOrder S; S.init(T_TOK, 3072, G, c0);
                  DUP(2, pg8::gemm_phase<EpiEvenIn, pg8::StaticOrder, true, true, true>(L, g, S, EpiEvenIn{WSP(bf16, WS_PROJ), WSP(float, WS_COS), WSP(float, WS_SIN), 4, WSCALE_INV})); } }
            else { pg8::Gemm g{WSP(bf16, WS_H), WSP(bf16, WS_WODIN) + (size_t)i * 3072 * (DM / 2), T_TOK, 3072, DM / 2, 0}; pg8::StaticOrder S; S.init(T_TOK, 3072, G, c0);
                DUP(2, pg8::gemm_phase<EpiOddIn, pg8::StaticOrder, true, true, true>(L, g, S, EpiOddIn{WSP(bf16, WS_PROJ), a.in[14] + i * 64, a.in[15] + i * 64})); }
            SEAM(pb + 1); }
        if (!odd) {
            if (IN(pb + 2)) { DUP(4, phase_e1(L, WSP(bf16, WS_PROJ), WSP(bf16, WS_KV), a.in[8] + i * 512, a.in[9] + i * 512, a.in[10] + (size_t)i * 4 * 128 * 128, a.in[11] + i * 512, WSP(bf16, WS_MIX), c0, G, 0, 1280)); SEAM(pb + 2); }
            if (IN(pb + 3)) { DUP(256, phase_e2(WSP(bf16, WS_KV), WSP(bf16, WS_ST), c0 * 512 + opaque_tid(), G * 512)); SEAM(pb + 3); }
            if (IN(pb + 4)) { DUP(512, phase_e3(L, WSP(bf16, WS_PROJ), WSP(bf16, WS_ST), WSP(bf16, WS_MIX), c0, G)); SEAM(pb + 4); }
        } else {
            if (IN(pb + 2)) { DUP(128, phase_attn(L, WSP(bf16, WS_PROJ), a.in[16] + (size_t)i * 16 * 320, a.in[14] + i * 64, a.in[15] + i * 64, WSP(bf16, WS_MIX), c0, G)); SEAM(pb + 2); }
        }
        if (IN(pb + 5)) { pg8::StaticOrder S; S.init(T_TOK, DM, G, c0);
            if (odd) { pg8::Gemm g{WSP(bf16, WS_MIX), WSP(bf16, WS_WODOUT) + (size_t)i * DM * (DM / 2), T_TOK, DM, DM / 2, 0}; pg8::gemm_phase<EpiResid, pg8::StaticOrder, true, true, true>(L, g, S, EpiResid{WSP(bf16, WS_XB), MODL, 2048, WSCALE_INV}); }
            else { pg8::Gemm g{WSP(bf16, WS_MIX), WSP(bf16, WS_WEVOUT) + (size_t)i * DM * (EVEN_MIX / 2), T_TOK, DM, EVEN_MIX / 2, 0};
            pg8::gemm_phase<EpiResid, pg8::StaticOrder, true, true, true>(L, g, S, EpiResid{WSP(bf16, WS_XB), MODL, 2048, WSCALE_INV}); } SEAM(pb + 5); }
        if (IN(pb + 6)) { phase_router(L, WSP(bf16, WS_XB), a.in[5] + l * DM, MODL, a.in[17] + (size_t)l * DM * NEXP, a.in[18] + l * NEXP, WSP(bf16, WS_H), WSP(int, WS_RSLOT), WSP(float, WS_RGATE), COUNTSL, c0, G); if (PROBE_DUP & 2048) phase_router(L, WSP(bf16, WS_XB), a.in[5] + l * DM, MODL, a.in[17] + (size_t)l * DM * NEXP, a.in[18] + l * NEXP, WSP(bf16, 920 * MiB), WSP(int, 940 * MiB), WSP(float, 944 * MiB), WSP(int, 948 * MiB), c0, G); SEAM(pb + 6); }
        if (IN(pb + 8)) { LAS int* tab = (LAS int*)(L + LDS_CTL_OFF); LAS unsigned short* gath = (LAS unsigned short*)(L + 131072); moe_table(tab, COUNTSL, 8, G, c0, WSP(int, WS_RSLOT), gath);
            pg8::Gemm g{WSP(bf16, WS_H), WSP(bf16, WS_W1) + (size_t)l * NEXP * 2048 * (DM / 2), CAP, 2048, DM / 2, 0, gath};
            pg8::MoeOrder S; S.tab = tab;
            DUP(16, pg8::gemm_phase<EpiMoe1, pg8::MoeOrder, true, true, true, true>(L, g, S, EpiMoe1{WSP(bf16, WS_ACT), a.in[20] + (size_t)l * NEXP * 2048})); SEAM(pb + 8); }
        if (IN(pb + 9)) { LAS int* tab = (LAS int*)(L + LDS_CTL_OFF); moe_table(tab, COUNTSL, 4, G, c0, nullptr, nullptr); pg8::Gemm g{WSP(bf16, WS_ACT), WSP(bf16, WS_W2) + (size_t)l * NEXP * DM * (DFF / 2), CAP, DM, DFF / 2, 0};
            pg8::MoeOrder S; S.tab = tab;
            DUP(32, pg8::gemm_phase<EpiMoe2, pg8::MoeOrder, true, true, true>(L, g, S, EpiMoe2{WSP(bf16, WS_YS), a.in[22] + (size_t)l * NEXP * DM, WSP(int, WS_RSLOT), WSP(float, WS_RGATE), tab})); SEAM(pb + 9); }
        }
    {
        constexpr int l = 1;
        const int pb = 1 + 12 * l, i = l >> 1; const bool odd = (l & 1) != 0;
#define MODL (WSP(float, WS_MOD) + (size_t)l * 8 * 6144)
#define COUNTSL (WSP(int, WS_CTL) + CW_COUNTS + 64 * l)
        if (IN(pb + 0)) { if (l == 0) phase_norm1<true, false>(a.in[0], WSP(bf16, WS_XB), true, WSP(bf16, WS_YS), MODL, false, a.in[4] + l * DM, MODL, WSP(bf16, WS_H), true, GW, NGW, odd, odd ? nullptr : WSP(unsigned char, WS_H8)); else phase_norm1<false, false>(WSP(bf16, WS_XB), WSP(bf16, WS_XB), true, WSP(bf16, WS_YS), MODL - 8 * 6144, true, a.in[4] + l * DM, MODL, WSP(bf16, WS_H), true, GW, NGW, odd, odd ? nullptr : WSP(unsigned char, WS_H8)); SEAM(pb + 0); }
        if (IN(pb + 1)) {
            if (!odd) {
                { pg8::Gemm g{WSP(bf16, WS_H), WSP(bf16, WS_WEVIN) + (size_t)i * EVEN_IN * DM, T_TOK, 1024, DM, 0}; pg8::StaticOrder S; S.init(T_TOK, 1024, G, c0);
                  DUP(2, pg8::gemm_phase<EpiEvenIn, pg8::StaticOrder, true, true>(L, g, S, EpiEvenIn{WSP(bf16, WS_PROJ), WSP(float, WS_COS), WSP(float, WS_SIN), 0, 1.0f})); }
                { pg8::Gemm g{WSP(bf16, WS_H8), WSP(bf16, WS_WEVIN8) + ((size_t)i * EVEN_IN + 1024) * (DM / 2), T_TOK, 3072, DM / 2, 0}; pg8::StaticOrder S; S.init(T_TOK, 3072, G, c0);
                  DUP(2, pg8::gemm_phase<EpiEvenIn, pg8::StaticOrder, true, true, true>(L, g, S, EpiEvenIn{WSP(bf16, WS_PROJ), WSP(float, WS_COS), WSP(float, WS_SIN), 4, WSCALE_INV})); } }
            else { pg8::Gemm g{WSP(bf16, WS_H), WSP(bf16, WS_WODIN) + (size_t)i * 3072 * (DM / 2), T_TOK, 3072, DM / 2, 0}; pg8::StaticOrder S; S.init(T_TOK, 3072, G, c0);
                DUP(2, pg8::gemm_phase<EpiOddIn, pg8::StaticOrder, true, true, true>(L, g, S, EpiOddIn{WSP(bf16, WS_PROJ), a.in[14] + i * 64, a.in[15] + i * 64})); }
            SEAM(pb + 1); }
        if (!odd) {
            if (IN(pb + 2)) { DUP(4, phase_e1(L, WSP(bf16, WS_PROJ), WSP(bf16, WS_KV), a.in[8] + i * 512, a.in[9] + i * 512, a.in[10] + (size_t)i * 4 * 128 * 128, a.in[11] + i * 512, WSP(bf16, WS_MIX), c0, G, 0, 1280)); SEAM(pb + 2); }
            if (IN(pb + 3)) { DUP(256, phase_e2(WSP(bf16, WS_KV), WSP(bf16, WS_ST), c0 * 512 + opaque_tid(), G * 512)); SEAM(pb + 3); }
            if (IN(pb + 4)) { DUP(512, phase_e3(L, WSP(bf16, WS_PROJ), WSP(bf16, WS_ST), WSP(bf16, WS_MIX), c0, G)); SEAM(pb + 4); }
        } else {
            if (IN(pb + 2)) { DUP(128, phase_attn(L, WSP(bf16, WS_PROJ), a.in[16] + (size_t)i * 16 * 320, a.in[14] + i * 64, a.in[15] + i * 64, WSP(bf16, WS_MIX), c0, G)); SEAM(pb + 2); }
        }
        if (IN(pb + 5)) { pg8::StaticOrder S; S.init(T_TOK, DM, G, c0);
            if (odd) { pg8::Gemm g{WSP(bf16, WS_MIX), WSP(bf16, WS_WODOUT) + (size_t)i * DM * (DM / 2), T_TOK, DM, DM / 2, 0}; pg8::gemm_phase<EpiResid, pg8::StaticOrder, true, true, true>(L, g, S, EpiResid{WSP(bf16, WS_XB), MODL, 2048, WSCALE_INV}); }
            else { pg8::Gemm g{WSP(bf16, WS_MIX), WSP(bf16, WS_WEVOUT) + (size_t)i * DM * (EVEN_MIX / 2), T_TOK, DM, EVEN_MIX / 2, 0};
            pg8::gemm_phase<EpiResid, pg8::StaticOrder, true, true, true>(L, g, S, EpiResid{WSP(bf16, WS_XB), MODL, 2048, WSCALE_INV}); } SEAM(pb + 5); }
        if (IN(pb + 6)) { phase_router(L, WSP(bf16, WS_XB), a.in[5] + l * DM, MODL, a.in[17] + (size_t)l * DM * NEXP, a.in[18] + l * NEXP, WSP(bf16, WS_H), WSP(int, WS_RSLOT), WSP(float, WS_RGATE), COUNTSL, c0, G); if (PROBE_DUP & 2048) phase_router(L, WSP(bf16, WS_XB), a.in[5] + l * DM, MODL, a.in[17] + (size_t)l * DM * NEXP, a.in[18] + l * NEXP, WSP(bf16, 920 * MiB), WSP(int, 940 * MiB), WSP(float, 944 * MiB), WSP(int, 948 * MiB), c0, G); SEAM(pb + 6); }
        if (IN(pb + 8)) { LAS int* tab = (LAS int*)(L + LDS_CTL_OFF); LAS unsigned short* gath = (LAS unsigned short*)(L + 131072); moe_table(tab, COUNTSL, 8, G, c0, WSP(int, WS_RSLOT), gath);
            pg8::Gemm g{WSP(bf16, WS_H), WSP(bf16, WS_W1) + (size_t)l * NEXP * 2048 * (DM / 2), CAP, 2048, DM / 2, 0, gath};
            pg8::MoeOrder S; S.tab = tab;
            DUP(16, pg8::gemm_phase<EpiMoe1, pg8::MoeOrder, true, true, true, true>(L, g, S, EpiMoe1{WSP(bf16, WS_ACT), a.in[20] + (size_t)l * NEXP * 2048})); SEAM(pb + 8); }
        if (IN(pb + 9)) { LAS int* tab = (LAS int*)(L + LDS_CTL_OFF); moe_table(tab, COUNTSL, 4, G, c0, nullptr, nullptr); pg8::Gemm g{WSP(bf16, WS_ACT), WSP(bf16, WS_W2) + (size_t)l * NEXP * DM * (DFF / 2), CAP, DM, DFF / 2, 0};
            pg8::MoeOrder S; S.tab = tab;
            DUP(32, pg8::gemm_phase<EpiMoe2, pg8::MoeOrder, true, true, true>(L, g, S, EpiMoe2{WSP(bf16, WS_YS), a.in[22] + (size_t)l * NEXP * DM, WSP(int, WS_RSLOT), WSP(float, WS_RGATE), tab})); SEAM(pb + 9); }
        }
    {
        constexpr int l = 2;
        const int pb = 1 + 12 * l, i = l >> 1; const bool odd = (l & 1) != 0;
#define MODL (WSP(float, WS_MOD) + (size_t)l * 8 * 6144)
#define COUNTSL (WSP(int, WS_CTL) + CW_COUNTS + 64 * l)
        if (IN(pb + 0)) { if (l == 0) phase_norm1<true, false>(a.in[0], WSP(bf16, WS_XB), true, WSP(bf16, WS_YS), MODL, false, a.in[4] + l * DM, MODL, WSP(bf16, WS_H), true, GW, NGW, odd, odd ? nullptr : WSP(unsigned char, WS_H8)); else phase_norm1<false, false>(WSP(bf16, WS_XB), WSP(bf16, WS_XB), true, WSP(bf16, WS_YS), MODL - 8 * 6144, true, a.in[4] + l * DM, MODL, WSP(bf16, WS_H), true, GW, NGW, odd, odd ? nullptr : WSP(unsigned char, WS_H8)); SEAM(pb + 0); }
        if (IN(pb + 1)) {
            if (!odd) {
                { pg8::Gemm g{WSP(bf16, WS_H), WSP(bf16, WS_WEVIN) + (size_t)i * EVEN_IN * DM, T_TOK, 1024, DM, 0}; pg8::StaticOrder S; S.init(T_TOK, 1024, G, c0);
                  DUP(2, pg8::gemm_phase<EpiEvenIn, pg8::StaticOrder, true, true>(L, g, S, EpiEvenIn{WSP(bf16, WS_PROJ), WSP(float, WS_COS), WSP(float, WS_SIN), 0, 1.0f})); }
                { pg8::Gemm g{WSP(bf16, WS_H8), WSP(bf16, WS_WEVIN8) + ((size_t)i * EVEN_IN + 1024) * (DM / 2), T_TOK, 3072, DM / 2, 0}; pg8::StaticOrder S; S.init(T_TOK, 3072, G, c0);
                  DUP(2, pg8::gemm_phase<EpiEvenIn, pg8::StaticOrder, true, true, true>(L, g, S, EpiEvenIn{WSP(bf16, WS_PROJ), WSP(float, WS_COS), WSP(float, WS_SIN), 4, WSCALE_INV})); } }
            else { pg8::Gemm g{WSP(bf16, WS_H), WSP(bf16, WS_WODIN) + (size_t)i * 3072 * (DM / 2), T_TOK, 3072, DM / 2, 0}; pg8::StaticOrder S; S.init(T_TOK, 3072, G, c0);
                DUP(2, pg8::gemm_phase<EpiOddIn, pg8::StaticOrder, true, true, true>(L, g, S, EpiOddIn{WSP(bf16, WS_PROJ), a.in[14] + i * 64, a.in[15] + i * 64})); }
            SEAM(pb + 1); }
        if (!odd) {
            if (IN(pb + 2)) { DUP(4, phase_e1(L, WSP(bf16, WS_PROJ), WSP(bf16, WS_KV), a.in[8] + i * 512, a.in[9] + i * 512, a.in[10] + (size_t)i * 4 * 128 * 128, a.in[11] + i * 512, WSP(bf16, WS_MIX), c0, G, 0, 1280)); SEAM(pb + 2); }
            if (IN(pb + 3)) { DUP(256, phase_e2(WSP(bf16, WS_KV), WSP(bf16, WS_ST), c0 * 512 + opaque_tid(), G * 512)); SEAM(pb + 3); }
            if (IN(pb + 4)) { DUP(512, phase_e3(L, WSP(bf16, WS_PROJ), WSP(bf16, WS_ST), WSP(bf16, WS_MIX), c0, G)); SEAM(pb + 4); }
        } else {
            if (IN(pb + 2)) { DUP(128, phase_attn(L, WSP(bf16, WS_PROJ), a.in[16] + (size_t)i * 16 * 320, a.in[14] + i * 64, a.in[15] + i * 64, WSP(bf16, WS_MIX), c0, G)); SEAM(pb + 2); }
        }
        if (IN(pb + 5)) { pg8::StaticOrder S; S.init(T_TOK, DM, G, c0);
            if (odd) { pg8::Gemm g{WSP(bf16, WS_MIX), WSP(bf16, WS_WODOUT) + (size_t)i * DM * (DM / 2), T_TOK, DM, DM / 2, 0}; pg8::gemm_phase<EpiResid, pg8::StaticOrder, true, true, true>(L, g, S, EpiResid{WSP(bf16, WS_XB), MODL, 2048, WSCALE_INV}); }
            else { pg8::Gemm g{WSP(bf16, WS_MIX), WSP(bf16, WS_WEVOUT) + (size_t)i * DM * (EVEN_MIX / 2), T_TOK, DM, EVEN_MIX / 2, 0};
            pg8::gemm_phase<EpiResid, pg8::StaticOrder, true, true, true>(L, g, S, EpiResid{WSP(bf16, WS_XB), MODL, 2048, WSCALE_INV}); } SEAM(pb + 5); }
        if (IN(pb + 6)) { phase_router(L, WSP(bf16, WS_XB), a.in[5] + l * DM, MODL, a.in[17] + (size_t)l * DM * NEXP, a.in[18] + l * NEXP, WSP(bf16, WS_H), WSP(int, WS_RSLOT), WSP(float, WS_RGATE), COUNTSL, c0, G); if (PROBE_DUP & 2048) phase_router(L, WSP(bf16, WS_XB), a.in[5] + l * DM, MODL, a.in[17] + (size_t)l * DM * NEXP, a.in[18] + l * NEXP, WSP(bf16, 920 * MiB), WSP(int, 940 * MiB), WSP(float, 944 * MiB), WSP(int, 948 * MiB), c0, G); SEAM(pb + 6); }
        if (IN(pb + 8)) { LAS int* tab = (LAS int*)(L + LDS_CTL_OFF); LAS unsigned short* gath = (LAS unsigned short*)(L + 131072); moe_table(tab, COUNTSL, 8, G, c0, WSP(int, WS_RSLOT), gath);
            pg8::Gemm g{WSP(bf16, WS_H), WSP(bf16, WS_W1) + (size_t)l * NEXP * 2048 * (DM / 2), CAP, 2048, DM / 2, 0, gath};
            pg8::MoeOrder S; S.tab = tab;
            DUP(16, pg8::gemm_phase<EpiMoe1, pg8::MoeOrder, true, true, true, true>(L, g, S, EpiMoe1{WSP(bf16, WS_ACT), a.in[20] + (size_t)l * NEXP * 2048})); SEAM(pb + 8); }
        if (IN(pb + 9)) { LAS int* tab = (LAS int*)(L + LDS_CTL_OFF); moe_table(tab, COUNTSL, 4, G, c0, nullptr, nullptr); pg8::Gemm g{WSP(bf16, WS_ACT), WSP(bf16, WS_W2) + (size_t)l * NEXP * DM * (DFF / 2), CAP, DM, DFF / 2, 0};
            pg8::MoeOrder S; S.tab = tab;
            DUP(32, pg8::gemm_phase<EpiMoe2, pg8::MoeOrder, true, true, true>(L, g, S, EpiMoe2{WSP(bf16, WS_YS), a.in[22] + (size_t)l * NEXP * DM, WSP(int, WS_RSLOT), WSP(float, WS_RGATE), tab})); SEAM(pb + 9); }
        }
    {
        constexpr int l = 3;
        const int pb = 1 + 12 * l, i = l >> 1; const bool odd = (l & 1) != 0;
#define MODL (WSP(float, WS_MOD) + (size_t)l * 8 * 6144)
#define COUNTSL (WSP(int, WS_CTL) + CW_COUNTS + 64 * l)
        if (IN(pb + 0)) { if (l == 0) phase_norm1<true, false>(a.in[0], WSP(bf16, WS_XB), true, WSP(bf16, WS_YS), MODL, false, a.in[4] + l * DM, MODL, WSP(bf16, WS_H), true, GW, NGW, odd, odd ? nullptr : WSP(unsigned char, WS_H8)); else phase_norm1<false, false>(WSP(bf16, WS_XB), WSP(bf16, WS_XB), true, WSP(bf16, WS_YS), MODL - 8 * 6144, true, a.in[4] + l * DM, MODL, WSP(bf16, WS_H), true, GW, NGW, odd, odd ? nullptr : WSP(unsigned char, WS_H8)); SEAM(pb + 0); }
        if (IN(pb + 1)) {
            if (!odd) {
                { pg8::Gemm g{WSP(bf16, WS_H), WSP(bf16, WS_WEVIN) + (size_t)i * EVEN_IN * DM, T_TOK, 1024, DM, 0}; pg8::StaticOrder S; S.init(T_TOK, 1024, G, c0);
                  DUP(2, pg8::gemm_phase<EpiEvenIn, pg8::StaticOrder, true, true>(L, g, S, EpiEvenIn{WSP(bf16, WS_PROJ), WSP(float, WS_COS), WSP(float, WS_SIN), 0, 1.0f})); }
                { pg8::Gemm g{WSP(bf16, WS_H8), WSP(bf16, WS_WEVIN8) + ((size_t)i * EVEN_IN + 1024) * (DM / 2), T_TOK, 3072, DM / 2, 0}; pg8::StaticOrder S; S.init(T_TOK, 3072, G, c0);
                  DUP(2, pg8::gemm_phase<EpiEvenIn, pg8::StaticOrder, true, true, true>(L, g, S, EpiEvenIn{WSP(bf16, WS_PROJ), WSP(float, WS_COS), WSP(float, WS_SIN), 4, WSCALE_INV})); } }
            else { pg8::Gemm g{WSP(bf16, WS_H), WSP(bf16, WS_WODIN) + (size_t)i * 3072 * (DM / 2), T_TOK, 3072, DM / 2, 0}; pg8::StaticOrder S; S.init(T_TOK, 3072, G, c0);
                DUP(2, pg8::gemm_phase<EpiOddIn, pg8::StaticOrder, true, true, true>(L, g, S, EpiOddIn{WSP(bf16, WS_PROJ), a.in[14] + i * 64, a.in[15] + i * 64})); }
            SEAM(pb + 1); }
        if (!odd) {
            if (IN(pb + 2)) { DUP(4, phase_e1(L, WSP(bf16, WS_PROJ), WSP(bf16, WS_KV), a.in[8] + i * 512, a.in[9] + i * 512, a.in[10] + (size_t)i * 4 * 128 * 128, a.in[11] + i * 512, WSP(bf16, WS_MIX), c0, G, 0, 1280)); SEAM(pb + 2); }
            if (IN(pb + 3)) { DUP(256, phase_e2(WSP(bf16, WS_KV), WSP(bf16, WS_ST), c0 * 512 + opaque_tid(), G * 512)); SEAM(pb + 3); }
            if (IN(pb + 4)) { DUP(512, phase_e3(L, WSP(bf16, WS_PROJ), WSP(bf16, WS_ST), WSP(bf16, WS_MIX), c0, G)); SEAM(pb + 4); }
        } else {
            if (IN(pb + 2)) { DUP(128, phase_attn(L, WSP(bf16, WS_PROJ), a.in[16] + (size_t)i * 16 * 320, a.in[14] + i * 64, a.in[15] + i * 64, WSP(bf16, WS_MIX), c0, G)); SEAM(pb + 2); }
        }
        if (IN(pb + 5)) { pg8::StaticOrder S; S.init(T_TOK, DM, G, c0);
            if (odd) { pg8::Gemm g{WSP(bf16, WS_MIX), WSP(bf16, WS_WODOUT) + (size_t)i * DM * (DM / 2), T_TOK, DM, DM / 2, 0}; pg8::gemm_phase<EpiResid, pg8::StaticOrder, true, true, true>(L, g, S, EpiResid{WSP(bf16, WS_XB), MODL, 2048, WSCALE_INV}); }
            else { pg8::Gemm g{WSP(bf16, WS_MIX), WSP(bf16, WS_WEVOUT) + (size_t)i * DM * (EVEN_MIX / 2), T_TOK, DM, EVEN_MIX / 2, 0};
            pg8::gemm_phase<EpiResid, pg8::StaticOrder, true, true, true>(L, g, S, EpiResid{WSP(bf16, WS_XB), MODL, 2048, WSCALE_INV}); } SEAM(pb + 5); }
        if (IN(pb + 6)) { phase_router(L, WSP(bf16, WS_XB), a.in[5] + l * DM, MODL, a.in[17] + (size_t)l * DM * NEXP, a.in[18] + l * NEXP, WSP(bf16, WS_H), WSP(int, WS_RSLOT), WSP(float, WS_RGATE), COUNTSL, c0, G); if (PROBE_DUP & 2048) phase_router(L, WSP(bf16, WS_XB), a.in[5] + l * DM, MODL, a.in[17] + (size_t)l * DM * NEXP, a.in[18] + l * NEXP, WSP(bf16, 920 * MiB), WSP(int, 940 * MiB), WSP(float, 944 * MiB), WSP(int, 948 * MiB), c0, G); SEAM(pb + 6); }
        if (IN(pb + 8)) { LAS int* tab = (LAS int*)(L + LDS_CTL_OFF); LAS unsigned short* gath = (LAS unsigned short*)(L + 131072); moe_table(tab, COUNTSL, 8, G, c0, WSP(int, WS_RSLOT), gath);
            pg8::Gemm g{WSP(bf16, WS_H), WSP(bf16, WS_W1) + (size_t)l * NEXP * 2048 * (DM / 2), CAP, 2048, DM / 2, 0, gath};
            pg8::MoeOrder S; S.tab = tab;
            DUP(16, pg8::gemm_phase<EpiMoe1, pg8::MoeOrder, true, true, true, true>(L, g, S, EpiMoe1{WSP(bf16, WS_ACT), a.in[20] + (size_t)l * NEXP * 2048})); SEAM(pb + 8); }
        if (IN(pb + 9)) { LAS int* tab = (LAS int*)(L + LDS_CTL_OFF); moe_table(tab, COUNTSL, 4, G, c0, nullptr, nullptr); pg8::Gemm g{WSP(bf16, WS_ACT), WSP(bf16, WS_W2) + (size_t)l * NEXP * DM * (DFF / 2), CAP, DM, DFF / 2, 0};
            pg8::MoeOrder S; S.tab = tab;
            DUP(32, pg8::gemm_phase<EpiMoe2, pg8::MoeOrder, true, true, true>(L, g, S, EpiMoe2{WSP(bf16, WS_YS), a.in[22] + (size_t)l * NEXP * DM, WSP(int, WS_RSLOT), WSP(float, WS_RGATE), tab})); SEAM(pb + 9); }
        }
    if (IN(N_PHASES - 1)) phase_norm1<false, true>(WSP(bf16, WS_XB), a.out, true, WSP(bf16, WS_YS), WSP(float, WS_MOD) + (size_t)(DEPTH - 1) * 8 * 6144, true, nullptr, nullptr, nullptr, false, GW, NGW);
#undef IN
#undef SEAM
}
extern "C" void kernel_launch(void* const* d_in, const int* in_sizes, int n_in, void* d_out, int out_size, void* d_ws, size_t ws_size, hipStream_t stream) {
    (void)in_sizes; (void)out_size; (void)ws_size;
    static int grid = 0;
    if (!grid) {
        (void)hipFuncSetAttribute((const void*)mega, hipFuncAttributeMaxDynamicSharedMemorySize, LDS_BYTES);
        int dev = 0, cus = 0, per_cu = 0; (void)hipGetDevice(&dev); (void)hipDeviceGetAttribute(&cus, hipDeviceAttributeMultiprocessorCount, dev);
        (void)hipOccupancyMaxActiveBlocksPerMultiprocessor(&per_cu, (const void*)mega, 512, LDS_BYTES); (void)hipGetLastError();
        grid = cus > 0 ? cus : 256;
    }
    (void)hipMemsetAsync((unsigned char*)d_ws + WS_CTL, 0, CTL_ZERO_BYTES, stream);
    Args a{};
    for (int i = 0; i < 23 && i < n_in; ++i) a.in[i] = (const float*)d_in[i];
    a.out = (float*)d_out; a.ws = (unsigned char*)d_ws;
#if MK_PER_PHASE
    for (int p = 0; p < N_PHASES; ++p) {
        if (p >= 1 && p < N_PHASES - 1) { const int l = (p - 1) / 12, j = (p - 1) % 12; if (j >= 10) continue; if ((l & 1) && (j == 3 || j == 4)) continue; }
        a.ph_lo = p; a.ph_hi = p + 1; hipLaunchKernelGGL(mega, dim3(grid), dim3(512), LDS_BYTES, stream, a);
    }
#else
    a.ph_lo = 0; a.ph_hi = N_PHASES; hipLaunchKernelGGL(mega, dim3(grid), dim3(512), LDS_BYTES, stream, a);
#endif
}
```

```cpp
#include <hip/hip_runtime.h>
#include <stdint.h>
#include <stdio.h>

typedef unsigned short bf16;

constexpr int NB = 8, SEQ = 2048, DM = 1024, T_TOK = NB * SEQ, DEPTH = 4;
constexpr int CHUNK = 64, NCH = SEQ / CHUNK;
constexpr int EVEN_IN = 4096, EVEN_MIX = 1536;
constexpr int NEXP = 32, TOPK = 4, DFF = 1024;
constexpr int CAP = T_TOK * TOPK + NEXP * 256;
constexpr float EPS = 1e-6f;

constexpr size_t MiB = 1u << 20;
constexpr size_t WS_CTL = 0;
constexpr size_t WS_MOD = 1 * MiB;
constexpr size_t WS_COS = 2 * MiB;
constexpr size_t WS_SIN = 3 * MiB;
constexpr size_t WS_H = 4 * MiB;
constexpr size_t WS_PROJ = 36 * MiB;
constexpr size_t WS_MIX = 164 * MiB;
constexpr size_t WS_TOPI = 212 * MiB;
constexpr size_t WS_TOPG = 213 * MiB;
constexpr size_t WS_POS = 214 * MiB;
constexpr size_t WS_ROWSLOT = 215 * MiB;
constexpr size_t WS_ROWGATE = 216 * MiB;
constexpr size_t WS_H8 = 220 * MiB;
constexpr size_t WS_WEVIN8 = 240 * MiB;
constexpr size_t WS_XS = 260 * MiB;
constexpr size_t WS_ACT = 364 * MiB;
constexpr size_t WS_YS = 508 * MiB;
constexpr size_t WS_KV = 636 * MiB;
constexpr size_t WS_ST = 772 * MiB;
constexpr size_t WS_XB = 960 * MiB;
constexpr size_t WS_RSLOT = 900 * MiB, WS_RGATE = 904 * MiB;
constexpr int EREG = 16384;
constexpr size_t WS_WEVIN = 2500 * MiB, WS_WEVOUT = 2516 * MiB, WS_WODIN = 2524 * MiB, WS_WODOUT = 2540 * MiB, WS_W1 = 2560 * MiB, WS_W2 = 3072 * MiB;
constexpr int CW_COUNTS = 64;
constexpr int CW_BAR = 4096;
constexpr size_t CTL_ZERO_BYTES = 64 * 1024;

__device__ __forceinline__ int opaque_tid() { int t = threadIdx.x; asm volatile("" : "+v"(t)); return t; }
__device__ __forceinline__ float bf2f(bf16 v) { return __uint_as_float(((unsigned)v) << 16); }
template <int M> __device__ __forceinline__ float xshfl(float v) { return __int_as_float(__builtin_amdgcn_ds_swizzle(__float_as_int(v), (M << 10) | 0x1f)); }
template <int M> __device__ __forceinline__ int xshfl_i(int v) { return __builtin_amdgcn_ds_swizzle(v, (M << 10) | 0x1f); }
__device__ __forceinline__ float sum_halves(float v) { const auto r = __builtin_amdgcn_permlane32_swap(__float_as_uint(v), __float_as_uint(v), false, false); return __uint_as_float(r[0]) + __uint_as_float(r[1]); }
__device__ __forceinline__ float max_halves(float v) { const auto r = __builtin_amdgcn_permlane32_swap(__float_as_uint(v), __float_as_uint(v), false, false); return fmaxf(__uint_as_float(r[0]), __uint_as_float(r[1])); }
__device__ __forceinline__ float wave_sum(float v) { v += xshfl<1>(v); v += xshfl<2>(v); v += xshfl<4>(v); v += xshfl<8>(v); v += xshfl<16>(v); return sum_halves(v); }
#define LAS __attribute__((address_space(3)))
namespace pg8 {
#define PG8_LAS __attribute__((address_space(3)))
typedef unsigned short bf16_t;
typedef short bf16x8 __attribute__((ext_vector_type(8)));
typedef float f32x4 __attribute__((ext_vector_type(4)));
typedef unsigned u32x4 __attribute__((ext_vector_type(4)));
constexpr int BM = 256, BK = 64, HALF = 128, HTB = HALF * BK * 2  , STAGE_BYTES = 8 * HTB, NXCD = 8, WGM = 8;
__host__ __device__ __forceinline__ int lds_byte(int r, int c) { const int st = (r >> 4) * 2 + (c >> 5), rr = r & 15, cc = c & 31, ob = rr * 64 + cc * 2; return st * 1024 + (ob ^ (((ob >> 9) & 1) << 5)); }
__host__ __device__ __forceinline__ void stage_rc(int b, int& R, int& C) { const int st = b / 1024, sb = b % 1024, swz = sb ^ (((sb >> 9) & 1) << 5); R = (st >> 1) * 16 + swz / 64; C = (st & 1) * 32 + (swz % 64) / 2; }
__host__ __device__ __forceinline__ int perm32(int rho) { const int n = rho >> 4, i = rho & 15; return 8 * (i >> 2) + 4 * n + (i & 3); }
__device__ __forceinline__ unsigned stage_voff(int i, int K) { const int t = opaque_tid(); int R, C; stage_rc(t * 16 + i * 8192, R, C); return (unsigned)(R * K + C) * 2u; }
__device__ __forceinline__ unsigned rc2vo(unsigned rc, int K) { return (rc >> 16) * (unsigned)(K * 2) + (rc & 0xffffu); }
struct Unit { int pm, pn; };
struct Gemm { const bf16_t* A; const bf16_t* Bt; int M, N, K, pad; const PG8_LAS unsigned short* gath; };
struct StaticOrder {
    int nM, nN, nwg, G, c;
    __host__ __device__ void init(int M, int N, int G_, int c_) { nM = M / BM; nN = N / BM; nwg = nM * nN; G = G_; c = c_; }
    __host__ __device__ bool next(int i, Unit& u) const {
        const long L = (long)i * G + c; if (L >= nwg) return false;
        int wgid = (int)L; { const int q = nwg / NXCD, r = nwg % NXCD, xcd = wgid % NXCD, off = wgid / NXCD; wgid = (xcd < r ? xcd * (q + 1) : r * (q + 1) + (xcd - r) * q) + off; }
        const int nig = WGM * nN, gid = wgid / nig, fm = gid * WGM, gsz = (nM - fm) < WGM ? (nM - fm) : WGM;
        u.pm = fm + ((wgid % nig) % gsz); u.pn = (wgid % nig) / gsz; return true;
    }
    __device__ __forceinline__ void a_ready(const Unit&) const {}
    __device__ __forceinline__ void done(const Unit&) const {}
};
struct MoeOrder {
    const PG8_LAS int* tab;
    __device__ __forceinline__ bool next(int i, Unit& u) const {
        if (i >= __builtin_amdgcn_readfirstlane(tab[192])) return false;
        u.pm = __builtin_amdgcn_readfirstlane(tab[194 + 2 * i]); u.pn = __builtin_amdgcn_readfirstlane(tab[195 + 2 * i]); return true;
    }
    __device__ __forceinline__ void a_ready(const Unit&) const {}
    __device__ __forceinline__ void done(const Unit&) const {}
};
typedef __bf16 bf16x2_t __attribute__((ext_vector_type(2)));
typedef float f32x2_t __attribute__((ext_vector_type(2)));
__device__ __forceinline__ unsigned cvt_pk_bf16(float lo, float hi) { const f32x2_t v = {lo, hi}; const bf16x2_t b = __builtin_convertvector(v, bf16x2_t); return __builtin_bit_cast(unsigned, b); }
typedef int i32x4_t __attribute__((ext_vector_type(4)));
typedef int i32x8_t __attribute__((ext_vector_type(8)));
__device__ __forceinline__ i32x8_t cat8(const bf16x8 a, const bf16x8 b) { return __builtin_shufflevector((i32x4_t)a, (i32x4_t)b, 0, 1, 2, 3, 4, 5, 6, 7); }
__device__ __forceinline__ unsigned pk4_fp8(float a, float b, float c, float d) { int w = 0; w = __builtin_amdgcn_cvt_pk_fp8_f32(a, b, w, false); w = __builtin_amdgcn_cvt_pk_fp8_f32(c, d, w, true); return (unsigned)w; }
__device__ __forceinline__ u32x4 pack8(const f32x4 a, const f32x4 b) { u32x4 w; w.x = cvt_pk_bf16(a[0], a[1]); w.y = cvt_pk_bf16(a[2], a[3]); w.z = cvt_pk_bf16(b[0], b[1]); w.w = cvt_pk_bf16(b[2], b[3]); return w; }
template <class Epi, class Sched, bool ALIGN_EPI = false, bool SP2 = false, bool FP8 = false, bool GATHER = false>
__device__ __forceinline__ void gemm_phase(PG8_LAS unsigned char* lds, const Gemm g, const Sched& S, const Epi& E) {
    const int tid = opaque_tid(), wid = __builtin_amdgcn_readfirstlane(tid >> 6), lane = tid & 63, wr = wid >> 2, wc = wid & 3, fr = lane & 15, fq = lane >> 4;
    const int K = g.K, nt = K / BK;
    unsigned voffA[2], voffB[2];
#pragma unroll
    for (int i = 0; i < 2; ++i) { int R, C; stage_rc(tid * 16 + i * 8192, R, C); const int Rb = Epi::PERM ? ((R & ~31) + perm32(R & 31)) : R;
        voffA[i] = (unsigned)(R * K + C) * 2u; voffB[i] = (unsigned)(Rb * K + C) * 2u; }
    const size_t kstep = (size_t)(BK * 2);
    const size_t hstep = (size_t)HALF * K * 2;
    const size_t tstep = 2 * hstep;
    const unsigned ldsw = (unsigned)wid * 1024u;
    const int aoff = lds_byte(wr * 64 + fr, fq * 8), boff = lds_byte(wc * 32 + fr, fq * 8);
#define PG8_SA(b, h) (((b) * 2 + (h)) * HTB)
#define PG8_SB(b, h) ((4 + (b) * 2 + (h)) * HTB)
    const __amdgpu_buffer_rsrc_t rsA = __builtin_amdgcn_make_buffer_rsrc((void*)g.A, 0, -1, 0x00020000);
    const unsigned relB = (unsigned)(size_t)((const char*)g.Bt - (const char*)g.A);
#define rsB rsA
    PG8_LAS unsigned* voT = (PG8_LAS unsigned*)(lds + 141312);
    if constexpr (FP8) {
#pragma unroll
        for (int i = 0; i < 2; ++i) { int R, C; stage_rc(tid * 16 + i * 8192, R, C); voT[i * 512 + tid] = ((unsigned)R << 16) | (unsigned)(C * 2); } }
#define PG8_DMA(rs, bufoff, ptr, vo, i) __builtin_amdgcn_raw_ptr_buffer_load_lds(rs, (PG8_LAS void*)(lds + (bufoff) + ldsw + (i) * 8192), 16, (vo), (unsigned)(size_t)(ptr), 0, 0)
#define PG8_VO(arr, i) (FP8 ? rc2vo(voT[(i) * 512 + opaque_tid()], K) : (arr)[i])
    const unsigned vob0 = voffB[0];
    constexpr bool VO1 = Epi::VO1;
#define PG8_STAGE_B(bufoff, ptr) do { _Pragma("unroll") for (int _i = 0; _i < 2; ++_i) { if constexpr (GATHER) PG8_DMA(rsA, bufoff, (ptr) + relB + (size_t)_i * (size_t)(64 * K * 2), vob0, _i); else if constexpr (FP8 && VO1) PG8_DMA(rsA, bufoff, (ptr) + relB + (size_t)_i * (size_t)(64 * K * 2), vob0, _i); else PG8_DMA(rsA, bufoff, (ptr) + relB, PG8_VO(voffB, _i), _i); } } while (0)
#define PG8_STAGE_A0(bufoff, ptr) do { _Pragma("unroll") for (int _i = 0; _i < 2; ++_i) { if constexpr (FP8 && VO1) PG8_DMA(rsA, bufoff, (ptr) + (size_t)_i * (size_t)(64 * K * 2), vob0, _i); else PG8_DMA(rsA, bufoff, ptr, PG8_VO(voffA, _i), _i); } } while (0)
    unsigned gvo[2][2];
#define PG8_GVO_AT(slot_, half_, i_) ((unsigned)g.gath[(slot_) * 256 + (half_) * 128 + (voT[(i_) * 512 + opaque_tid()] >> 16)] * (unsigned)(K * 2) + (voT[(i_) * 512 + opaque_tid()] & 0xffffu))
#define PG8_GVO_LOAD(slot_) do { if constexpr (GATHER) { _Pragma("unroll") for (int h_ = 0; h_ < 2; ++h_) _Pragma("unroll") for (int i_ = 0; i_ < 2; ++i_) gvo[h_][i_] = PG8_GVO_AT(slot_, h_, i_); } } while (0)
#define PG8_STAGE_A(bufoff, ptr, half, slot) do { if constexpr (GATHER) { if ((slot) == ui) { _Pragma("unroll") for (int _i = 0; _i < 2; ++_i) PG8_DMA(rsA, bufoff, ptr, gvo[half][_i], _i); } \
            else { _Pragma("unroll") for (int _i = 0; _i < 2; ++_i) { const unsigned vo_ = PG8_GVO_AT(slot, half, _i); PG8_DMA(rsA, bufoff, ptr, vo_, _i); } } } \
        else { PG8_STAGE_A0(bufoff, (ptr) + (half) * hstep); } } while (0)
#define PG8_LDA(dst, b, h) do { _Pragma("unroll") for (int m = 0; m < 4; ++m) _Pragma("unroll") for (int k = 0; k < 2; ++k) dst[m][k] = *(const PG8_LAS bf16x8*)(lds + PG8_SA(b, h) + aoff + m * 2048 + k * 1024); } while (0)
#define PG8_LDB(dst, b, h) do { _Pragma("unroll") for (int n = 0; n < 2; ++n) _Pragma("unroll") for (int k = 0; k < 2; ++k) dst[n][k] = *(const PG8_LAS bf16x8*)(lds + PG8_SB(b, h) + boff + n * 2048 + k * 1024); } while (0)
#define PG8_MMA(ai, bj, At, Bt) do { __builtin_amdgcn_s_setprio(1); _Pragma("unroll") for (int m = 0; m < 4; ++m) _Pragma("unroll") for (int n = 0; n < 2; ++n) { \
        if constexpr (FP8) { acc[ai][bj][m][n] = __builtin_amdgcn_mfma_scale_f32_16x16x128_f8f6f4(cat8(Bt[n][0], Bt[n][1]), cat8(At[m][0], At[m][1]), acc[ai][bj][m][n], 0, 0, 0, 0, 0, 0); } \
        else { _Pragma("unroll") for (int k = 0; k < 2; ++k) acc[ai][bj][m][n] = __builtin_amdgcn_mfma_f32_16x16x32_bf16(Bt[n][k], At[m][k], acc[ai][bj][m][n], 0, 0, 0); } } \
        __builtin_amdgcn_s_setprio(0); } while (0)
#define PG8_WAIT_V(n) asm volatile("s_waitcnt vmcnt(" #n ")" ::: "memory")
#define PG8_WAIT_L(n) asm volatile("s_waitcnt lgkmcnt(" #n ")" ::: "memory")
#define PG8_BAR __builtin_amdgcn_s_barrier()
#define PG8_SCHED __builtin_amdgcn_sched_barrier(0)

#define PG8_PIN_ACC() do { \
        asm volatile("" : "+v"(acc[0][0][0][0]), "+v"(acc[0][0][0][1]), "+v"(acc[0][0][1][0]), "+v"(acc[0][0][1][1]), "+v"(acc[0][0][2][0]), "+v"(acc[0][0][2][1]), "+v"(acc[0][0][3][0]), "+v"(acc[0][0][3][1]), \
                          "+v"(acc[0][1][0][0]), "+v"(acc[0][1][0][1]), "+v"(acc[0][1][1][0]), "+v"(acc[0][1][1][1]), "+v"(acc[0][1][2][0]), "+v"(acc[0][1][2][1]), "+v"(acc[0][1][3][0]), "+v"(acc[0][1][3][1])); \
        asm volatile("" : "+v"(acc[1][0][0][0]), "+v"(acc[1][0][0][1]), "+v"(acc[1][0][1][0]), "+v"(acc[1][0][1][1]), "+v"(acc[1][0][2][0]), "+v"(acc[1][0][2][1]), "+v"(acc[1][0][3][0]), "+v"(acc[1][0][3][1]), \
                          "+v"(acc[1][1][0][0]), "+v"(acc[1][1][0][1]), "+v"(acc[1][1][1][0]), "+v"(acc[1][1][1][1]), "+v"(acc[1][1][2][0]), "+v"(acc[1][1][2][1]), "+v"(acc[1][1][3][0]), "+v"(acc[1][1][3][1])); } while (0)
    Unit cur, nxt; int ui = 0;
    if (!S.next(0, cur)) return;
    f32x4 acc[2][2][4][2];
#pragma unroll
    for (int a = 0; a < 2; ++a)
#pragma unroll
        for (int b = 0; b < 2; ++b)
#pragma unroll
            for (int m = 0; m < 4; ++m)
#pragma unroll
                for (int n = 0; n < 2; ++n) acc[a][b][m][n] = (f32x4){0.f, 0.f, 0.f, 0.f};
    int pf_b = 131072, pf_s = 133120; if constexpr (Epi::PREF) pf_b = Epi::L_BIAS;
    if constexpr (Epi::PREF) { if (wr == 0) E.pref(lds, cur, pf_b, pf_s, wid, lane); PG8_WAIT_V(0); PG8_BAR; E.init_lds(acc, lds, pf_b, wc, fq); }
    else if constexpr (Epi::INIT) E.init(acc, cur, wc, fq);
    else if constexpr (FP8) PG8_PIN_ACC();
    bf16x8 At[4][2], B0[2][2], B1[2][2];
    static_assert(!GATHER || SP2, "GATHER is written for the SP2 loop");
    const char* cA = (const char*)0 + (GATHER ? (size_t)0 : (size_t)cur.pm * tstep); const char* cB = (const char*)0 + (size_t)cur.pn * tstep;
    S.a_ready(cur);
    PG8_GVO_LOAD(0);
    if constexpr (SP2) {
        PG8_STAGE_B(PG8_SB(0, 0), cB); PG8_STAGE_B(PG8_SB(0, 1), cB + hstep); PG8_STAGE_A(PG8_SA(0, 0), cA, 0, 0); PG8_STAGE_A(PG8_SA(0, 1), cA, 1, 0);
        if (wr == 1) PG8_BAR;
        PG8_WAIT_V(2); PG8_BAR;
        PG8_STAGE_B(PG8_SB(1, 0), cB + kstep); PG8_STAGE_A(PG8_SA(1, 0), cA + kstep, 0, 0); PG8_STAGE_B(PG8_SB(1, 1), cB + hstep + kstep);
        PG8_WAIT_V(6); PG8_BAR;
    } else {
        PG8_STAGE_B(PG8_SB(0, 0), cB); PG8_STAGE_A0(PG8_SA(0, 0), cA); PG8_STAGE_B(PG8_SB(0, 1), cB + hstep); PG8_STAGE_A0(PG8_SA(0, 1), cA + hstep);
        if (wr == 1) PG8_BAR;
        PG8_WAIT_V(4); PG8_BAR;
        PG8_STAGE_B(PG8_SB(1, 0), cB + kstep); PG8_STAGE_A0(PG8_SA(1, 0), cA + kstep); PG8_STAGE_B(PG8_SB(1, 1), cB + hstep + kstep);
        PG8_WAIT_V(6); PG8_BAR;
    }
    for (;;) {
        const bool has_next = S.next(ui + 1, nxt);
        const char* nA = has_next ? (const char*)0 + (GATHER ? (size_t)0 : (size_t)nxt.pm * tstep) : cA; const char* nB = has_next ? (const char*)0 + (size_t)nxt.pn * tstep : cB;
        const int nslot = has_next ? ui + 1 : ui;
        const int pf_nb = pf_b ^ 1024, pf_ns = (pf_s == 133120 + 4096) ? 133120 : pf_s + 2048;
        if constexpr (Epi::PREF) { if (wr == 0 && has_next) E.pref(lds, nxt, pf_nb, pf_ns, wid, lane); }
        for (int t = 0; t < nt; t += 2) {
            const bool last = (t == nt - 2);
            const char* a1 = cA + (size_t)(t + 1) * kstep;
            const char* a2 = last ? nA : cA + (size_t)(t + 2) * kstep; const char* b2 = last ? nB : cB + (size_t)(t + 2) * kstep;
            const char* a3 = a2 + kstep; const char* b3 = b2 + kstep;
            if (last && has_next) S.a_ready(nxt);
            if constexpr (SP2) {
            PG8_LDB(B0, 0, 0); PG8_LDB(B1, 0, 1); PG8_SCHED; PG8_LDA(At, 0, 0); PG8_STAGE_A(PG8_SA(1, 1), a1, 1, ui);
            PG8_WAIT_V(8); PG8_WAIT_L(0); PG8_BAR;
            PG8_MMA(0, 0, At, B0); PG8_MMA(0, 1, At, B1); PG8_BAR; PG8_SCHED;
            PG8_LDA(At, 0, 1); PG8_STAGE_B(PG8_SB(0, 0), b2); PG8_STAGE_B(PG8_SB(0, 1), b2 + hstep); PG8_STAGE_A(PG8_SA(0, 0), a2, 0, (last ? nslot : ui));
            PG8_WAIT_V(8); PG8_WAIT_L(0); PG8_BAR; PG8_MMA(1, 0, At, B0); PG8_MMA(1, 1, At, B1); PG8_BAR; PG8_SCHED;
            PG8_LDB(B0, 1, 0); PG8_LDB(B1, 1, 1); PG8_SCHED; PG8_LDA(At, 1, 0); PG8_STAGE_A(PG8_SA(0, 1), a2, 1, (last ? nslot : ui));
            PG8_WAIT_V(8); PG8_WAIT_L(0); PG8_BAR; PG8_MMA(0, 0, At, B0); PG8_MMA(0, 1, At, B1); PG8_BAR; PG8_SCHED;
            PG8_LDA(At, 1, 1); PG8_STAGE_B(PG8_SB(1, 0), b3); PG8_STAGE_B(PG8_SB(1, 1), b3 + hstep); PG8_STAGE_A(PG8_SA(1, 0), a3, 0, (last ? nslot : ui));
            PG8_WAIT_V(8); PG8_WAIT_L(0); PG8_BAR; PG8_MMA(1, 0, At, B0); PG8_MMA(1, 1, At, B1); PG8_BAR; PG8_SCHED;
            } else {
            PG8_LDB(B0, 0, 0); PG8_SCHED; PG8_LDA(At, 0, 0); PG8_STAGE_A0(PG8_SA(1, 1), a1 + hstep);
            PG8_WAIT_L(8); PG8_BAR; PG8_WAIT_L(0); PG8_MMA(0, 0, At, B0); PG8_BAR; PG8_SCHED;
            PG8_LDB(B1, 0, 1); PG8_STAGE_B(PG8_SB(0, 0), b2);
            PG8_BAR; PG8_WAIT_L(0); PG8_MMA(0, 1, At, B1); PG8_BAR;
            PG8_LDA(At, 0, 1); PG8_STAGE_A0(PG8_SA(0, 0), a2);
            PG8_BAR; PG8_WAIT_L(0); PG8_MMA(1, 0, At, B0); PG8_BAR; PG8_SCHED;
            PG8_STAGE_B(PG8_SB(0, 1), b2 + hstep);
            PG8_WAIT_V(6); PG8_BAR; PG8_MMA(1, 1, At, B1); PG8_BAR;
            PG8_LDB(B0, 1, 0); PG8_SCHED; PG8_LDA(At, 1, 0); PG8_STAGE_A0(PG8_SA(0, 1), a2 + hstep);
            PG8_WAIT_L(8); PG8_BAR; PG8_WAIT_L(0); PG8_MMA(0, 0, At, B0); PG8_BAR; PG8_SCHED;
            PG8_LDB(B1, 1, 1); PG8_STAGE_B(PG8_SB(1, 0), b3);
            PG8_BAR; PG8_WAIT_L(0); PG8_MMA(0, 1, At, B1); PG8_BAR;
            PG8_LDA(At, 1, 1); PG8_STAGE_A0(PG8_SA(1, 0), a3);
            PG8_BAR; PG8_WAIT_L(0); PG8_MMA(1, 0, At, B0); PG8_BAR; PG8_SCHED;
            PG8_STAGE_B(PG8_SB(1, 1), b3 + hstep);
            PG8_WAIT_V(6); PG8_BAR; PG8_MMA(1, 1, At, B1); PG8_BAR;
            }
        }
        if constexpr (ALIGN_EPI) { if (wr == 0) PG8_BAR; }
        if constexpr (Epi::PREF) { E.epi_lds(acc, cur, lds, pf_s, wr, wc, fr, fq); pf_s = pf_ns; S.done(cur); }
        else if constexpr (!Epi::AFTER_DRAIN) { E(acc, cur, wr, wc, fr, fq); S.done(cur); }
        if (!has_next) break;
#pragma unroll
        for (int a = 0; a < 2; ++a)
#pragma unroll
            for (int b = 0; b < 2; ++b)
#pragma unroll
                for (int m = 0; m < 4; ++m)
#pragma unroll
                    for (int n = 0; n < 2; ++n) acc[a][b][m][n] = (f32x4){0.f, 0.f, 0.f, 0.f};
        if constexpr (Epi::PREF) { E.init_lds(acc, lds, pf_nb, wc, fq); pf_b = pf_nb; } else if constexpr (Epi::INIT) E.init(acc, nxt, wc, fq);
        else if constexpr (FP8) PG8_PIN_ACC();
        cur = nxt; cA = nA; cB = nB; ++ui;
        PG8_GVO_LOAD(ui);
        if constexpr (ALIGN_EPI) { if (wr == 1) PG8_BAR; }
    }
    PG8_WAIT_V(0);
    if constexpr (!ALIGN_EPI) { if (wr == 0) PG8_BAR; }
    PG8_BAR;
    if constexpr (Epi::AFTER_DRAIN) { E.fused(acc, cur, wr, wc, fr, fq, lds, wid, lane); S.done(cur); }
#undef PG8_SA
#undef PG8_SB
#undef PG8_DMA
#undef PG8_VO
#undef rsB
#undef PG8_STAGE_B
#undef PG8_STAGE_A0
#undef PG8_STAGE_A
#undef PG8_LDA
#undef PG8_LDB
#undef PG8_MMA
#undef PG8_WAIT_V
#undef PG8_WAIT_L
#undef PG8_BAR
#undef PG8_SCHED
#undef PG8_PIN_ACC
}
}

using pg8::f32x4; using pg8::u32x4; using pg8::Unit;
typedef unsigned u32x2 __attribute__((ext_vector_type(2)));
__device__ __forceinline__ float fsigmoid(float x) { return __builtin_amdgcn_rcpf(1.0f + __builtin_amdgcn_exp2f(-1.4426950408889634f * x)); }
__device__ __forceinline__ float fgelu(float x) { const float u = -2.302208198f * (x + 0.044715f * x * x * x); return x * __builtin_amdgcn_rcpf(1.0f + __builtin_amdgcn_exp2f(u)); }
constexpr float WSCALE = 32.0f, WSCALE_INV = 1.0f / 32.0f;
struct EpiResid {
    static constexpr bool PERM = false, AFTER_DRAIN = false, INIT = false, PREF = false, VO1 = true;
    bf16* X; const float* MODl; int g_off; float scale;
    __device__ __forceinline__ void operator()(const f32x4 (&acc)[2][2][4][2], const Unit& u, int wr, int wc, int fr, int fq) const {
        const int row0 = u.pm * 256 + wr * 64 + fr, b = (u.pm * 256) / SEQ, col0 = u.pn * 256 + wc * 32 + 8 * fq;
        const float* gp = MODl + (size_t)b * 6144 + g_off + col0; f32x4 gv[2][2];
#pragma unroll
        for (int bj = 0; bj < 2; ++bj)
#pragma unroll
            for (int n = 0; n < 2; ++n) gv[bj][n] = *(const f32x4*)(gp + bj * 128 + 4 * n) * scale;
#pragma unroll
        for (int ai = 0; ai < 2; ++ai)
#pragma unroll
            for (int m = 0; m < 4; ++m) { bf16* rowp = X + (size_t)(row0 + ai * 128 + m * 16) * DM + col0;
#pragma unroll
                for (int bj = 0; bj < 2; ++bj) { const u32x4 xv = *(const u32x4*)(rowp + bj * 128);
                    const f32x4 x0 = (f32x4){__uint_as_float(xv[0] << 16), __uint_as_float(xv[0] & 0xffff0000u), __uint_as_float(xv[1] << 16), __uint_as_float(xv[1] & 0xffff0000u)};
                    const f32x4 x1 = (f32x4){__uint_as_float(xv[2] << 16), __uint_as_float(xv[2] & 0xffff0000u), __uint_as_float(xv[3] << 16), __uint_as_float(xv[3] & 0xffff0000u)};
                    *(u32x4*)(rowp + bj * 128) = pg8::pack8(x0 + gv[bj][0] * acc[ai][bj][m][0], x1 + gv[bj][1] * acc[ai][bj][m][1]); } }
    }
};
struct EpiEvenIn {
    static constexpr bool PERM = false, AFTER_DRAIN = false, INIT = false, PREF = false, VO1 = false;
    bf16* P; const float* COS; const float* SIN; int pn0; float scale;
    __device__ __forceinline__ void operator()(const f32x4 (&acc)[2][2][4][2], const Unit& u, int wr, int wc, int fr, int fq) const {
        const int row0 = u.pm * 256 + wr * 64 + fr, pn = u.pn + pn0;
        if (pn < 4) {
            const float sc = pn >= 2 ? 0.08838834764831845f : 1.0f; const int dlow = 32 * (wc & 1) + 8 * fq, col1 = pn * 256 + 128 * (wc >> 1) + dlow;
#pragma unroll
            for (int ai = 0; ai < 2; ++ai)
#pragma unroll
                for (int m = 0; m < 4; ++m) { const int row = row0 + ai * 128 + m * 16, pos = row & (SEQ - 1);
                    const f32x4 c0 = *(const f32x4*)(COS + pos * 64 + dlow), c1 = *(const f32x4*)(COS + pos * 64 + dlow + 4), s0 = *(const f32x4*)(SIN + pos * 64 + dlow), s1 = *(const f32x4*)(SIN + pos * 64 + dlow + 4);
                    const f32x4 x1a = acc[ai][0][m][0], x1b = acc[ai][0][m][1], x2a = acc[ai][1][m][0], x2b = acc[ai][1][m][1];
                    const f32x4 o1a = (x1a * c0 - x2a * s0) * sc, o1b = (x1b * c1 - x2b * s1) * sc, o2a = (x1a * s0 + x2a * c0) * sc, o2b = (x1b * s1 + x2b * c1) * sc;
                    bf16* rp = P + (size_t)row * EVEN_IN + col1; *(u32x4*)rp = pg8::pack8(o1a, o1b); *(u32x4*)(rp + 64) = pg8::pack8(o2a, o2b); }
        } else {
            const int mode = pn < 8 ? 0 : (pn < 12 ? 1 : 2); const int col0 = pn * 256 + wc * 32 + 8 * fq;
#pragma unroll
            for (int ai = 0; ai < 2; ++ai)
#pragma unroll
                for (int m = 0; m < 4; ++m) { bf16* rp = P + (size_t)(row0 + ai * 128 + m * 16) * EVEN_IN + col0;
#pragma unroll
                    for (int bj = 0; bj < 2; ++bj) { f32x4 v0 = acc[ai][bj][m][0] * scale, v1 = acc[ai][bj][m][1] * scale;
                        if (mode == 1) {
#pragma unroll
                            for (int j = 0; j < 4; ++j) { v0[j] = v0[j] * fsigmoid(v0[j]); v1[j] = v1[j] * fsigmoid(v1[j]); } }
                        else if (mode == 2) {
#pragma unroll
                            for (int j = 0; j < 4; ++j) { v0[j] = fgelu(v0[j]); v1[j] = fgelu(v1[j]); } }
                        *(u32x4*)(rp + bj * 128) = pg8::pack8(v0, v1); } }
        }
    }
};
struct EpiOddIn {
    static constexpr bool PERM = false, AFTER_DRAIN = false, INIT = false, PREF = false, VO1 = true;
    bf16* P; const float* qg; const float* kg;
    __device__ __forceinline__ void operator()(const f32x4 (&acc)[2][2][4][2], const Unit& u, int wr, int wc, int fr, int fq) const {
        const int row0 = u.pm * 256 + wr * 64 + fr, pn = u.pn;
        if (pn < 8) {
            const float* g = pn < 4 ? qg : kg; const float sc = pn < 4 ? 0.125f * 1.4426950408889634f : 1.0f; f32x4 gv[2][2];
#pragma unroll
            for (int bj = 0; bj < 2; ++bj)
#pragma unroll
                for (int n = 0; n < 2; ++n) gv[bj][n] = *(const f32x4*)(g + 32 * bj + 8 * fq + 4 * n) * sc;
            const int col0 = pn * 256 + 64 * wc + 8 * fq;
#pragma unroll
            for (int ai = 0; ai < 2; ++ai)
#pragma unroll
                for (int m = 0; m < 4; ++m) { float ss = 0.f;
#pragma unroll
                    for (int bj = 0; bj < 2; ++bj)
#pragma unroll
                        for (int n = 0; n < 2; ++n) { const f32x4 v = acc[ai][bj][m][n]; ss += (v[0] * v[0] + v[1] * v[1]) + (v[2] * v[2] + v[3] * v[3]); }
                    ss += xshfl<16>(ss); ss = sum_halves(ss); ss *= WSCALE_INV * WSCALE_INV;
                    const float r = rsqrtf(ss * (1.0f / 64.0f) + EPS) * WSCALE_INV; bf16* rp = P + (size_t)(row0 + ai * 128 + m * 16) * 3072 + col0;
#pragma unroll
                    for (int bj = 0; bj < 2; ++bj) *(u32x4*)(rp + 32 * bj) = pg8::pack8(acc[ai][bj][m][0] * gv[bj][0] * r, acc[ai][bj][m][1] * gv[bj][1] * r); }
        } else {
            const int col0 = pn * 256 + wc * 32 + 8 * fq;
#pragma unroll
            for (int ai = 0; ai < 2; ++ai)
#pragma unroll
                for (int m = 0; m < 4; ++m) { bf16* rp = P + (size_t)(row0 + ai * 128 + m * 16) * 3072 + col0;
#pragma unroll
                    for (int bj = 0; bj < 2; ++bj) *(u32x4*)(rp + bj * 128) = pg8::pack8(acc[ai][bj][m][0] * WSCALE_INV, acc[ai][bj][m][1] * WSCALE_INV); }
        }
    }
};
struct EpiMoe1 {
    static constexpr bool PERM = false, AFTER_DRAIN = false, INIT = true, PREF = true, VO1 = false; static constexpr int L_BIAS = 145408;
    bf16* ACT; const float* b1l;
    __device__ __forceinline__ void init(f32x4 (&acc)[2][2][4][2], const Unit& u, int wc, int fq) const {
        const int e = u.pn >> 3, pnl = u.pn & 7, c0 = 128 * pnl + 32 * wc + 8 * fq; const float* bp = b1l + (size_t)e * 2048 + c0;
#pragma unroll
        for (int n = 0; n < 2; ++n) { const f32x4 bg = *(const f32x4*)(bp + 4 * n) * WSCALE, bl = *(const f32x4*)(bp + 1024 + 4 * n) * WSCALE;
#pragma unroll
            for (int ai = 0; ai < 2; ++ai)
#pragma unroll
                for (int m = 0; m < 4; ++m) { acc[ai][0][m][n] = bg; acc[ai][1][m][n] = bl; } }
    }
    __device__ __forceinline__ void operator()(const f32x4 (&acc)[2][2][4][2], const Unit& u, int wr, int wc, int fr, int fq) const {
        const int pnl = u.pn & 7, c0 = 128 * pnl + 32 * wc + 8 * fq, row0 = u.pm * 256 + wr * 64 + fr;
#pragma unroll
        for (int ai = 0; ai < 2; ++ai)
#pragma unroll
            for (int m = 0; m < 4; ++m) { f32x4 a[2];
#pragma unroll
                for (int n = 0; n < 2; ++n) { const f32x4 hg = acc[ai][0][m][n], hl = acc[ai][1][m][n];
                    f32x4 xg, xl;
#pragma unroll
                    for (int j = 0; j < 4; ++j) { xg[j] = __builtin_amdgcn_fmed3f(hg[j], -1.0e30f, 7.0f * WSCALE); xl[j] = __builtin_amdgcn_fmed3f(hl[j], -7.0f * WSCALE, 7.0f * WSCALE); }
                    const f32x4 ea = xg * (-1.702f * 1.4426950408889634f * WSCALE_INV); f32x4 t;
#pragma unroll
                    for (int j = 0; j < 4; ++j) t[j] = __builtin_amdgcn_exp2f(ea[j]);
                    const f32x4 d = t * (WSCALE * WSCALE) + (WSCALE * WSCALE); f32x4 r;
#pragma unroll
                    for (int j = 0; j < 4; ++j) r[j] = __builtin_amdgcn_rcpf(d[j]);
                    a[n] = (xg * (xl + WSCALE)) * r; }
                uint2 pk; pk.x = pg8::pk4_fp8(a[0][0], a[0][1], a[0][2], a[0][3]); pk.y = pg8::pk4_fp8(a[1][0], a[1][1], a[1][2], a[1][3]);
                *(uint2*)((unsigned char*)ACT + (size_t)(row0 + ai * 128 + m * 16) * DFF + c0) = pk; }
    }
    __device__ __forceinline__ void pref(LAS unsigned char* lds, const Unit& u, int boff, int, int wid, int lane) const {
        const int e = u.pn >> 3, pnl = u.pn & 7, L = wid * 64 + lane;
        const __amdgpu_buffer_rsrc_t rb = __builtin_amdgcn_make_buffer_rsrc((void*)(b1l + (size_t)e * 2048 + 128 * pnl), 0, -1, 0x00020000);
        __builtin_amdgcn_raw_ptr_buffer_load_lds(rb, (LAS void*)(lds + boff + wid * 256), 4, (unsigned)((L & 127) + (L >> 7) * 1024) * 4u, 0u, 0, 0);
    }
    __device__ __forceinline__ void init_lds(f32x4 (&acc)[2][2][4][2], LAS unsigned char* lds, int boff, int wc, int fq) const {
        const LAS float* bp = (const LAS float*)(lds + boff) + 32 * wc + 8 * fq;
#pragma unroll
        for (int n = 0; n < 2; ++n) { const f32x4 bg = *(const LAS f32x4*)(bp + 4 * n) * WSCALE, bl = *(const LAS f32x4*)(bp + 128 + 4 * n) * WSCALE;
#pragma unroll
            for (int ai = 0; ai < 2; ++ai)
#pragma unroll
                for (int m = 0; m < 4; ++m) { acc[ai][0][m][n] = bg; acc[ai][1][m][n] = bl; } }
    }
    __device__ __forceinline__ void epi_lds(const f32x4 (&acc)[2][2][4][2], const Unit& u, LAS unsigned char*, int, int wr, int wc, int fr, int fq) const { (*this)(acc, u, wr, wc, fr, fq); }
};
constexpr float YSCALE = 16.0f, YSCALE_INV = 1.0f / 16.0f;
struct EpiMoe2 {
    static constexpr bool PERM = false, AFTER_DRAIN = false, INIT = true, PREF = true, VO1 = false; static constexpr int L_BIAS = 131072;
    bf16* YS; const float* b2l; const int* RSLOT; const float* RGATE; const LAS int* tab;
    __device__ __forceinline__ void init(f32x4 (&acc)[2][2][4][2], const Unit& u, int wc, int fq) const {
        const int e = u.pn >> 2, pnl = u.pn & 3, col0 = 256 * pnl + 32 * wc + 8 * fq; const float* bp = b2l + (size_t)e * 1024 + col0;
#pragma unroll
        for (int bj = 0; bj < 2; ++bj)
#pragma unroll
            for (int n = 0; n < 2; ++n) { const f32x4 bv = *(const f32x4*)(bp + bj * 128 + 4 * n) * WSCALE;
#pragma unroll
                for (int ai = 0; ai < 2; ++ai)
#pragma unroll
                    for (int m = 0; m < 4; ++m) acc[ai][bj][m][n] = bv; }
    }
    __device__ __forceinline__ void operator()(const f32x4 (&acc)[2][2][4][2], const Unit& u, int wr, int wc, int fr, int fq) const {
        const int e = u.pn >> 2, pnl = u.pn & 3, col0 = 256 * pnl + 32 * wc + 8 * fq, rl0 = (u.pm - tab[64 + e]) * 256 + wr * 64 + fr, cnt = tab[160 + e];
        int slot[2][4]; float gt[2][4];
#pragma unroll
        for (int ai = 0; ai < 2; ++ai)
#pragma unroll
            for (int m = 0; m < 4; ++m) { const int rl = rl0 + ai * 128 + m * 16; const bool ok = rl < cnt; slot[ai][m] = ok ? RSLOT[e * EREG + rl] : -1; gt[ai][m] = ok ? RGATE[e * EREG + rl] * WSCALE_INV : 0.f; }
#pragma unroll
        for (int ai = 0; ai < 2; ++ai)
#pragma unroll
            for (int m = 0; m < 4; ++m) { unsigned char* rp = (slot[ai][m] >= 0 ? (unsigned char*)YS + (size_t)slot[ai][m] * DM : (unsigned char*)YS + (size_t)T_TOK * 4 * DM + (size_t)(32u << 20)) + col0; const float g = gt[ai][m] * YSCALE;
#pragma unroll
                for (int bj = 0; bj < 2; ++bj) { const f32x4 y0 = acc[ai][bj][m][0] * g, y1 = acc[ai][bj][m][1] * g; uint2 pk; pk.x = pg8::pk4_fp8(y0[0], y0[1], y0[2], y0[3]); pk.y = pg8::pk4_fp8(y1[0], y1[1], y1[2], y1[3]); *(uint2*)(rp + bj * 128) = pk; } }
    }
    __device__ __forceinline__ void pref(LAS unsigned char* lds, const Unit& u, int boff, int soff, int wid, int lane) const {
        const int e = u.pn >> 2, pnl = u.pn & 3, rl = (u.pm - tab[64 + e]) * 256 + wid * 64 + lane;
        const __amdgpu_buffer_rsrc_t rs = __builtin_amdgcn_make_buffer_rsrc((void*)RSLOT, 0, -1, 0x00020000);
        const unsigned relg = (unsigned)(size_t)((const char*)RGATE - (const char*)RSLOT);
        __builtin_amdgcn_raw_ptr_buffer_load_lds(rs, (LAS void*)(lds + soff + wid * 256), 4, (unsigned)rl * 4u, (unsigned)(e * EREG) * 4u, 0, 0);
        __builtin_amdgcn_raw_ptr_buffer_load_lds(rs, (LAS void*)(lds + soff + 1024 + wid * 256), 4, (unsigned)rl * 4u, (unsigned)(e * EREG) * 4u + relg, 0, 0);
        const __amdgpu_buffer_rsrc_t rb = __builtin_amdgcn_make_buffer_rsrc((void*)(b2l + (size_t)e * 1024 + 256 * pnl), 0, -1, 0x00020000);
        __builtin_amdgcn_raw_ptr_buffer_load_lds(rb, (LAS void*)(lds + boff + wid * 256), 4, (unsigned)(wid * 64 + lane) * 4u, 0u, 0, 0);
    }
    __device__ __forceinline__ void init_lds(f32x4 (&acc)[2][2][4][2], LAS unsigned char* lds, int boff, int wc, int fq) const {
        const LAS float* bp = (const LAS float*)(lds + boff) + 32 * wc + 8 * fq;
#pragma unroll
        for (int bj = 0; bj < 2; ++bj)
#pragma unroll
            for (int n = 0; n < 2; ++n) { const f32x4 bv = *(const LAS f32x4*)(bp + bj * 128 + 4 * n) * WSCALE;
#pragma unroll
                for (int ai = 0; ai < 2; ++ai)
#pragma unroll
                    for (int m = 0; m < 4; ++m) acc[ai][bj][m][n] = bv; }
    }
    __device__ __forceinline__ void epi_lds(const f32x4 (&acc)[2][2][4][2], const Unit& u, LAS unsigned char* lds, int soff, int wr, int wc, int fr, int fq) const {
        const int e = u.pn >> 2, pnl = u.pn & 3, col0 = 256 * pnl + 32 * wc + 8 * fq, r0 = wr * 64 + fr, rl0 = (u.pm - tab[64 + e]) * 256 + r0, cnt = tab[160 + e];
        const LAS int* sl = (const LAS int*)(lds + soff); const LAS float* gl = (const LAS float*)(sl + 256);
        int slot[2][4]; float gt[2][4];
#pragma unroll
        for (int ai = 0; ai < 2; ++ai)
#pragma unroll
            for (int m = 0; m < 4; ++m) { const int r = ai * 128 + m * 16; const bool ok = rl0 + r < cnt; slot[ai][m] = ok ? sl[r0 + r] : -1; gt[ai][m] = ok ? gl[r0 + r] * WSCALE_INV : 0.f; }
#pragma unroll
        for (int ai = 0; ai < 2; ++ai)
#pragma unroll
            for (int m = 0; m < 4; ++m) { unsigned char* rp = (slot[ai][m] >= 0 ? (unsigned char*)YS + (size_t)slot[ai][m] * DM : (unsigned char*)YS + (size_t)T_TOK * 4 * DM + (size_t)(32u << 20)) + col0; const float g = gt[ai][m] * YSCALE;
#pragma unroll
                for (int bj = 0; bj < 2; ++bj) { const f32x4 y0 = acc[ai][bj][m][0] * g, y1 = acc[ai][bj][m][1] * g; uint2 pk; pk.x = pg8::pk4_fp8(y0[0], y0[1], y0[2], y0[3]); pk.y = pg8::pk4_fp8(y1[0], y1[1], y1[2], y1[3]); *(uint2*)(rp + bj * 128) = pk; } }
    }
};

struct EpiNull { static constexpr bool PERM = false, AFTER_DRAIN = false, INIT = false, PREF = false, VO1 = false; float* sink;
    __device__ __forceinline__ void operator()(const f32x4 (&acc)[2][2][4][2], const Unit& u, int wr, int wc, int fr, int fq) const { f32x4 s = acc[0][0][0][0];
#pragma unroll
        for (int ai = 0; ai < 2; ++ai)
#pragma unroll
            for (int bj = 0; bj < 2; ++bj)
#pragma unroll
                for (int m = 0; m < 4; ++m)
#pragma unroll
                    for (int n = 0; n < 2; ++n) s = s + acc[ai][bj][m][n];
        if (s[0] + s[1] + s[2] + s[3] == 12345.678f) sink[0] = s[0]; } };
constexpr int LDS_STAGE = 131072, LDS_CTL_OFF = 139264, LDS_BYTES = 147456;
__device__ __forceinline__ int logical_group_base(int mode, int gp) {
    const int pn = gp >> 3, bj = (gp >> 2) & 1, wc = gp & 3;
    if (mode == 1) return pn < 4 ? 256 * pn + 128 * (wc >> 1) + 64 * bj + 32 * (wc & 1) : 32 * gp;
    if (mode == 2) return pn < 8 ? 256 * pn + 64 * wc + 32 * bj : 32 * gp;
    if (mode == 3) return 1024 * bj + 128 * pn + 32 * wc;
    return 32 * gp;
}
__device__ __forceinline__ void load_item(float4 (&v)[16], const float* W, int N, int mode, int kb, int gp, int lane) {
    const float* src = W + (size_t)(128 * kb + (lane >> 3)) * N + logical_group_base(mode, gp) + (lane & 7) * 4;
#pragma unroll
    for (int i = 0; i < 16; ++i) { const f32x4 t = __builtin_nontemporal_load((const f32x4*)(src + (size_t)(8 * i) * N)); v[i] = make_float4(t[0], t[1], t[2], t[3]); }
}
template <bool F8> __device__ __forceinline__ void store_item(const float4 (&v)[16], int K, bf16* out, int kb, int gp, LAS float* scr, int lane) {
    const int k0 = 128 * kb;
#pragma unroll
    for (int i = 0; i < 16; ++i) { LAS float* d = scr + (8 * i + (lane >> 3)) * 33 + (lane & 7) * 4; d[0] = v[i].x; d[1] = v[i].y; d[2] = v[i].z; d[3] = v[i].w; }
    asm volatile("s_waitcnt lgkmcnt(0)" ::: "memory");
    const int c = lane & 15;
#pragma unroll
    for (int jj = 0; jj < 8; ++jj) { const int ip = (lane >> 4) + 4 * jj; const int il = 8 * ((ip >> 2) & 3) + 4 * (ip >> 4) + (ip & 3);
        const LAS float* s = scr + (8 * c) * 33 + il; u32x4 o;
        if constexpr (F8) { uint2 p; p.x = pg8::pk4_fp8(s[0 * 33] * WSCALE, s[1 * 33] * WSCALE, s[2 * 33] * WSCALE, s[3 * 33] * WSCALE); p.y = pg8::pk4_fp8(s[4 * 33] * WSCALE, s[5 * 33] * WSCALE, s[6 * 33] * WSCALE, s[7 * 33] * WSCALE);
            __builtin_nontemporal_store(*(const u32x2*)&p, (u32x2*)((unsigned char*)out + (size_t)(32 * gp + ip) * K + k0 + 8 * c)); }
        else { o.x = pg8::cvt_pk_bf16(s[0 * 33], s[1 * 33]); o.y = pg8::cvt_pk_bf16(s[2 * 33], s[3 * 33]); o.z = pg8::cvt_pk_bf16(s[4 * 33], s[5 * 33]); o.w = pg8::cvt_pk_bf16(s[6 * 33], s[7 * 33]);
            __builtin_nontemporal_store(o, (u32x4*)(out + (size_t)(32 * gp + ip) * K + k0 + 8 * c)); } }
    asm volatile("s_waitcnt lgkmcnt(0)" ::: "memory");
}
__device__ __forceinline__ void load_half(float4 (&v)[8], const float* W, int N, int mode, int kb, int gp, int half, int lane) {
    const float* src = W + (size_t)(128 * kb + 64 * half + (lane >> 3)) * N + logical_group_base(mode, gp) + (lane & 7) * 4;
#pragma unroll
    for (int i = 0; i < 8; ++i) { const f32x4 t = __builtin_nontemporal_load((const f32x4*)(src + (size_t)(8 * i) * N)); v[i] = make_float4(t[0], t[1], t[2], t[3]); }
}
__device__ __forceinline__ void write_half(const float4 (&v)[8], int half, LAS float* scr, int lane) {
#pragma unroll
    for (int i = 0; i < 8; ++i) { LAS float* d = scr + (64 * half + 8 * i + (lane >> 3)) * 33 + (lane & 7) * 4; d[0] = v[i].x; d[1] = v[i].y; d[2] = v[i].z; d[3] = v[i].w; }
}
template <bool F8> __device__ __forceinline__ void process_item(int K, bf16* out, int kb, int gp, LAS float* scr, int lane) {
    const int k0 = 128 * kb;
    asm volatile("s_waitcnt lgkmcnt(0)" ::: "memory");
    const int c = lane & 15;
#pragma unroll
    for (int jj = 0; jj < 8; ++jj) { const int ip = (lane >> 4) + 4 * jj; const int il = 8 * ((ip >> 2) & 3) + 4 * (ip >> 4) + (ip & 3);
        const LAS float* s = scr + (8 * c) * 33 + il; u32x4 o;
        if constexpr (F8) { uint2 p; p.x = pg8::pk4_fp8(s[0 * 33] * WSCALE, s[1 * 33] * WSCALE, s[2 * 33] * WSCALE, s[3 * 33] * WSCALE); p.y = pg8::pk4_fp8(s[4 * 33] * WSCALE, s[5 * 33] * WSCALE, s[6 * 33] * WSCALE, s[7 * 33] * WSCALE);
            __builtin_nontemporal_store(*(const u32x2*)&p, (u32x2*)((unsigned char*)out + (size_t)(32 * gp + ip) * K + k0 + 8 * c)); }
        else { o.x = pg8::cvt_pk_bf16(s[0 * 33], s[1 * 33]); o.y = pg8::cvt_pk_bf16(s[2 * 33], s[3 * 33]); o.z = pg8::cvt_pk_bf16(s[4 * 33], s[5 * 33]); o.w = pg8::cvt_pk_bf16(s[6 * 33], s[7 * 33]);
            __builtin_nontemporal_store(o, (u32x4*)(out + (size_t)(32 * gp + ip) * K + k0 + 8 * c)); } }
    asm volatile("s_waitcnt lgkmcnt(0)" ::: "memory");
}
template <int K, int N, int MODE, int NMAT, int BASE, bool F8 = false, int GP0 = 0, int GPN = N / 32>
__device__ __forceinline__ void convert_job(LAS unsigned char* lds, const float* W, bf16* out, int gw, int ngw) {
    const int tid = opaque_tid(), lane = tid & 63, wave = tid >> 6; LAS float* scr = (LAS float*)(lds + wave * 16896);
    constexpr int ng = GPN, per = (K / 128) * ng, tot = per * NMAT;
    int it = gw - (BASE % ngw); if (it < 0) it += ngw;
    if (it >= tot) return;
    float4 va[8], vb[8];
#define CVT_LOADH(dst, item, half) do { const int m2_ = (item) / per, r2_ = (item) % per; load_half(dst, W + (size_t)m2_ * K * N, N, MODE, r2_ / ng, GP0 + r2_ % ng, half, lane); } while (0)
#define CVT_PROC(item) do { const int m_ = (item) / per, r_ = (item) % per; process_item<F8>(K, F8 ? (bf16*)((unsigned char*)out + (size_t)m_ * K * N) : out + (size_t)m_ * K * N, r_ / ng, GP0 + r_ % ng, scr, lane); } while (0)
    CVT_LOADH(va, it, 0); CVT_LOADH(vb, it, 1);
    const int nmin = tot / ngw; int kk = 0;
#define CVT_SYNC() do { if (kk < nmin) __builtin_amdgcn_s_barrier(); ++kk; } while (0)
    for (;;) {
        if (it + ngw >= tot) { CVT_SYNC(); write_half(va, 0, scr, lane); write_half(vb, 1, scr, lane); CVT_PROC(it); break; }
        CVT_SYNC(); write_half(va, 0, scr, lane); asm volatile("" ::: "memory"); CVT_LOADH(va, it + ngw, 0); asm volatile("" ::: "memory");
        write_half(vb, 1, scr, lane); asm volatile("" ::: "memory"); CVT_LOADH(vb, it + ngw, 1); asm volatile("" ::: "memory");
        CVT_PROC(it); it += ngw;
    }
#undef CVT_SYNC
#undef CVT_LOADH
#undef CVT_PROC
}
constexpr int CVT_T0 = (1024 / 128) * (4096 / 32) * 2, CVT_T1 = (1536 / 128) * (1024 / 32) * 2, CVT_T2 = (1024 / 128) * (3072 / 32) * 2, CVT_T3 = (1024 / 128) * (1024 / 32) * 2, CVT_T4 = (1024 / 128) * (2048 / 32) * 128;
typedef short s16x4 __attribute__((ext_vector_type(4)));
using pg8::bf16x8;
__device__ __forceinline__ bf16x8 tr_frag(const LAS unsigned char* p0, const LAS unsigned char* p1) {
    const s16x4 a = __builtin_amdgcn_ds_read_tr16_b64_v4i16((LAS s16x4*)p0), b = __builtin_amdgcn_ds_read_tr16_b64_v4i16((LAS s16x4*)p1);
    return (bf16x8){a[0], a[1], a[2], a[3], b[0], b[1], b[2], b[3]};
}
__device__ __forceinline__ void phase_attn(LAS unsigned char* lds, const bf16* P, const float* relb, const float* qg, const float* kg, bf16* MIX, int c0, int G) {
    constexpr float LOG2E = 1.4426950408889634f; constexpr int KS = 144, HB = 18432, BUF = 2 * HB;
    LAS float* rt = (LAS float*)(lds + 2 * BUF); LAS float* red = rt + 1280;
    const int tid = opaque_tid(), lane = tid & 63, w = tid >> 6, fr = lane & 15, fq = lane >> 4;
    const int skey = tid >> 3, sseg = tid & 7, hw = w >> 2;
    float Mref;
    { float m1 = 0.f, m2 = 0.f, m3 = -1.0e30f;
      if (tid < 64) { m1 = fabsf(qg[tid]); m2 = fabsf(kg[tid]); }
      for (int i = tid; i < 16 * 320; i += 512) m3 = fmaxf(m3, relb[i]);
#define WMAX(v) do { v = fmaxf(v, xshfl<1>(v)); v = fmaxf(v, xshfl<2>(v)); v = fmaxf(v, xshfl<4>(v)); v = fmaxf(v, xshfl<8>(v)); v = fmaxf(v, xshfl<16>(v)); v = max_halves(v); } while (0)
      WMAX(m1); WMAX(m2); WMAX(m3);
#undef WMAX
      __syncthreads();
      if (lane == 0) { red[w] = m1; red[8 + w] = m2; red[16 + w] = m3; }
      __syncthreads();
      float g1 = 0.f, g2 = 0.f, g3 = -1.0e30f;
#pragma unroll
      for (int i = 0; i < 8; ++i) { g1 = fmaxf(g1, red[i]); g2 = fmaxf(g2, red[8 + i]); g3 = fmaxf(g3, red[16 + i]); }
      Mref = (8.0f * g1 * g2 * 1.01f + g3 + 0.1f) * LOG2E; }
    if ((G & 127) == 0) { const int hp0 = (c0 >> 4) & 7; float tv[3];
#pragma unroll
        for (int k = 0; k < 3; ++k) { const int i = tid + 512 * k, ic = i < 1280 ? i : 0, hj = ic >= 640 ? 1 : 0, j = 639 - (ic - 640 * hj); tv[k] = relb[(2 * hp0 + hj) * 320 + (j > 319 ? 319 : j)]; }
#pragma unroll
        for (int k = 0; k < 3; ++k) { const int i = tid + 512 * k; if (i < 1280) rt[i] = tv[k] * LOG2E - Mref; } }
    for (int u = c0; u < NB * 8 * 16; u += G) {
        const int b = u >> 7, hp = (u >> 4) & 7, cp = ((u & 15) + 4 * (u >> 8)) & 15, h = 2 * hp + hw, nq = 2 * cp + ((w >> 1) & 1);
        const int kc_lo = 2 * cp - 8 < 0 ? 0 : 2 * cp - 8, kc_hi = 2 * cp + 1;
        const bf16* srcb = P + ((size_t)b * SEQ + skey) * 3072 + 1024 + (2 * hp) * 64 + sseg * 8;
        u32x4 ka = *(const u32x4*)(srcb + (size_t)kc_lo * 64 * 3072), kb = *(const u32x4*)(srcb + (size_t)kc_lo * 64 * 3072 + 64), va = *(const u32x4*)(srcb + (size_t)kc_lo * 64 * 3072 + 1024), vb = *(const u32x4*)(srcb + (size_t)kc_lo * 64 * 3072 + 1024 + 64);
        __syncthreads();
        if ((G & 127) != 0) { for (int i = tid; i < 1280; i += 512) { const int hj = i >= 640 ? 1 : 0, j = 639 - (i - 640 * hj); rt[i] = relb[(2 * hp + hj) * 320 + (j > 319 ? 319 : j)] * LOG2E - Mref; } }
        { LAS unsigned char* d = lds + skey * KS + sseg * 16; *(LAS u32x4*)d = ka; *(LAS u32x4*)(d + 9216) = va; *(LAS u32x4*)(d + HB) = kb; *(LAS u32x4*)(d + HB + 9216) = vb; }
        bf16x8 qf[2][2];
#pragma unroll
        for (int qt = 0; qt < 2; ++qt)
#pragma unroll
            for (int s = 0; s < 2; ++s) qf[qt][s] = *(const bf16x8*)(P + ((size_t)b * SEQ + nq * 64 + 32 * (w & 1) + 16 * qt + fr) * 3072 + h * 64 + 32 * s + 8 * fq);
        f32x4 o[2][4]; float lrow[2];
#pragma unroll
        for (int qt = 0; qt < 2; ++qt) { lrow[qt] = 0.f;
#pragma unroll
            for (int dt = 0; dt < 4; ++dt) o[qt][dt] = (f32x4){0.f, 0.f, 0.f, 0.f}; }
        const LAS float* rtw = rt + 640 * hw;
        __builtin_amdgcn_s_waitcnt(0x0F70);
        __syncthreads();
        for (int kc = kc_lo; kc <= kc_hi; ++kc) {
            LAS unsigned char* Ks = lds + ((kc - kc_lo) & 1) * BUF + hw * HB; LAS unsigned char* Vs = Ks + 9216;
            if (kc < kc_hi) { const bf16* sp = srcb + (size_t)(kc + 1) * 64 * 3072; ka = *(const u32x4*)sp; kb = *(const u32x4*)(sp + 64); va = *(const u32x4*)(sp + 1024); vb = *(const u32x4*)(sp + 1024 + 64); }
            if (kc >= nq - 8 && kc <= nq) {
                const int delta = nq - kc;
                f32x4 st[2][4];
#pragma unroll
                for (int qt = 0; qt < 2; ++qt) {
                    if (delta >= 5) { const float cb = rtw[320];
#pragma unroll
                        for (int t = 0; t < 4; ++t) st[qt][t] = (f32x4){cb, cb, cb, cb}; }
                    else { const int qi = 32 * (w & 1) + 16 * qt + fr; const LAS float* bp = rtw + (639 - (qi - 4 * fq + 64 * delta + 63));
#pragma unroll
                        for (int t = 0; t < 4; ++t)
#pragma unroll
                            for (int r = 0; r < 4; ++r) st[qt][t][r] = bp[16 * t + r]; } }
#pragma unroll
                for (int t = 0; t < 4; ++t) {
                    const bf16x8 k0 = *(const LAS bf16x8*)(Ks + (16 * t + fr) * KS + (8 * fq) * 2), k1 = *(const LAS bf16x8*)(Ks + (16 * t + fr) * KS + (32 + 8 * fq) * 2);
#pragma unroll
                    for (int qt = 0; qt < 2; ++qt) { f32x4 a = st[qt][t];
                        a = __builtin_amdgcn_mfma_f32_16x16x32_bf16(k0, qf[qt][0], a, 0, 0, 0); a = __builtin_amdgcn_mfma_f32_16x16x32_bf16(k1, qf[qt][1], a, 0, 0, 0); st[qt][t] = a; }
                }
                bf16x8 pf[2][2];
#pragma unroll
                for (int qt = 0; qt < 2; ++qt) {
                    float ps = 0.f;
#pragma unroll
                    for (int t = 0; t < 4; ++t)
#pragma unroll
                        for (int r = 0; r < 4; ++r) { const float p = __builtin_amdgcn_exp2f(st[qt][t][r]); st[qt][t][r] = p; ps += p; }
                    lrow[qt] += ps;
                    pf[qt][0] = (bf16x8)pg8::pack8(st[qt][0], st[qt][1]); pf[qt][1] = (bf16x8)pg8::pack8(st[qt][2], st[qt][3]);
                }
#pragma unroll
                for (int s = 0; s < 2; ++s)
#pragma unroll
                    for (int dt = 0; dt < 4; ++dt) {
                        const LAS unsigned char* vp = Vs + (32 * s + 4 * fq + (fr >> 2)) * KS + (16 * dt + 4 * (fr & 3)) * 2;
                        const bf16x8 vf = tr_frag(vp, vp + 16 * KS);
#pragma unroll
                        for (int qt = 0; qt < 2; ++qt) o[qt][dt] = __builtin_amdgcn_mfma_f32_16x16x32_bf16(vf, pf[qt][s], o[qt][dt], 0, 0, 0);
                    }
            }
            if (kc < kc_hi) { LAS unsigned char* d = lds + (((kc - kc_lo) & 1) ^ 1) * BUF + skey * KS + sseg * 16; *(LAS u32x4*)d = ka; *(LAS u32x4*)(d + 9216) = va; *(LAS u32x4*)(d + HB) = kb; *(LAS u32x4*)(d + HB + 9216) = vb; }
            __syncthreads();
        }
#pragma unroll
        for (int qt = 0; qt < 2; ++qt) { float l = lrow[qt]; l += xshfl<16>(l); l = sum_halves(l); const float inv = __builtin_amdgcn_rcpf(l);
            unsigned char* dst = (unsigned char*)MIX + ((size_t)b * SEQ + nq * 64 + 32 * (w & 1) + 16 * qt + fr) * DM + h * 64 + 4 * fq;
#pragma unroll
            for (int dt = 0; dt < 4; ++dt) { const f32x4 v = o[qt][dt] * inv; *(unsigned*)(dst + 16 * dt) = pg8::pk4_fp8(v[0], v[1], v[2], v[3]); } }
    }
}
struct KvRegs { u32x4 k[2], v[4]; };
__device__ __forceinline__ void kv_load(KvRegs& R, const bf16* P, int u, int tid) {
    const int h = u & 3, n = (u >> 2) & 31, b = u >> 7; const size_t row0 = (size_t)b * SEQ + (size_t)n * 64;
#pragma unroll
    for (int i = 0; i < 2; ++i) { const int id = tid + 512 * i, j = id >> 4, seg = id & 15; R.k[i] = *(const u32x4*)(P + (row0 + j) * EVEN_IN + 512 + h * 128 + seg * 8); }
#pragma unroll
    for (int i = 0; i < 4; ++i) { const int id = tid + 512 * i, j = id >> 5, seg = id & 31; R.v[i] = *(const u32x4*)(P + (row0 + j) * EVEN_IN + 1024 + h * 256 + seg * 8); }
}
__device__ __forceinline__ void kv_unit(LAS unsigned char* lds, const bf16* P, bf16* KV, int u, KvRegs& R, int unext) {
    constexpr int KST = 272, VST = 528;
    LAS unsigned char* Ks = lds; LAS unsigned char* Vs = lds + 64 * KST;
    const int tid = opaque_tid(), lane = tid & 63, w = tid >> 6, fr = lane & 15, fq = lane >> 4;
    const int h = u & 3, n = (u >> 2) & 31, b = u >> 7;
    const float log2g = log2f(1.0f - exp2f(-5.0f - (float)h));
    const size_t row0 = (size_t)b * SEQ + (size_t)n * 64;
    __syncthreads();
#pragma unroll
    for (int i = 0; i < 2; ++i) { const int id = tid + 512 * i, j = id >> 4, seg = id & 15; const u32x4 v = R.k[i];
        const float kd = exp2f(log2g * (float)(63 - j)); u32x4 o;
#pragma unroll
        for (int q = 0; q < 4; ++q) { const float lo = __uint_as_float(v[q] << 16) * kd, hi = __uint_as_float(v[q] & 0xffff0000u) * kd; o[q] = pg8::cvt_pk_bf16(lo, hi); }
        *(LAS u32x4*)(Ks + j * KST + seg * 16) = o; }
#pragma unroll
    for (int i = 0; i < 4; ++i) { const int id = tid + 512 * i, j = id >> 5, seg = id & 31; *(LAS u32x4*)(Vs + j * VST + seg * 16) = R.v[i]; }
    __syncthreads();
    if (unext >= 0) kv_load(R, P, unext, tid);
    f32x4 acc[8][2];
#pragma unroll
    for (int dt = 0; dt < 8; ++dt) { acc[dt][0] = (f32x4){0.f, 0.f, 0.f, 0.f}; acc[dt][1] = (f32x4){0.f, 0.f, 0.f, 0.f}; }
#pragma unroll
    for (int s = 0; s < 2; ++s) {
        bf16x8 vf[2];
#pragma unroll
        for (int e2 = 0; e2 < 2; ++e2) { const LAS unsigned char* vp = Vs + (32 * s + 8 * fq + (fr >> 2)) * VST + (16 * (2 * w + e2) + 4 * (fr & 3)) * 2; vf[e2] = tr_frag(vp, vp + 4 * VST); }
#pragma unroll
        for (int dt = 0; dt < 8; ++dt) { const LAS unsigned char* kp = Ks + (32 * s + 8 * fq + (fr >> 2)) * KST + (16 * dt + 4 * (fr & 3)) * 2; const bf16x8 kf = tr_frag(kp, kp + 4 * KST);
#pragma unroll
            for (int e2 = 0; e2 < 2; ++e2) acc[dt][e2] = __builtin_amdgcn_mfma_f32_16x16x32_bf16(kf, vf[e2], acc[dt][e2], 0, 0, 0); }
    }
    bf16* dst = KV + (size_t)u * 32768;
#pragma unroll
    for (int e2 = 0; e2 < 2; ++e2)
#pragma unroll
        for (int dt = 0; dt < 8; ++dt) { const f32x4 v = acc[dt][e2]; uint2 pk; pk.x = pg8::cvt_pk_bf16(v[0], v[1]); pk.y = pg8::cvt_pk_bf16(v[2], v[3]);
            *(uint2*)(dst + (16 * (2 * w + e2) + fr) * 128 + 16 * dt + 4 * fq) = pk; }
}
struct GmRegs { float4 w4[8]; u32x4 z2[4]; f32x4 lg0, lg1, lb0, lb1; uint2 uv[8]; float bs[8]; };
__device__ __forceinline__ void gm_load(GmRegs& R, const bf16* P, const float* lng, const float* lnb, const float* sgw, const float* sgb, size_t t0, int g, int tid, int w, int fr, int fq) {
    const int c8 = (tid & 15) * 8;
#pragma unroll
    for (int i = 0; i < 8; ++i) { const int id = tid + 512 * i, r = id >> 5, c4 = (id & 31) * 4; R.w4[i] = *(const float4*)(sgw + ((size_t)g * 128 + r) * 128 + c4); }
#pragma unroll
    for (int i = 0; i < 4; ++i) { const int id = tid + 512 * i, j = id >> 4; R.z2[i] = *(const u32x4*)(P + (t0 + j) * EVEN_IN + 3584 + g * 128 + c8); }
    R.lg0 = *(const f32x4*)(lng + g * 128 + c8); R.lg1 = *(const f32x4*)(lng + g * 128 + c8 + 4); R.lb0 = *(const f32x4*)(lnb + g * 128 + c8); R.lb1 = *(const f32x4*)(lnb + g * 128 + c8 + 4);
}
__device__ __forceinline__ void gm_load_epi(GmRegs& R, const bf16* P, const float* sgb, size_t t0, int g, int w, int fr, int fq) {
#pragma unroll
    for (int it = 0; it < 8; ++it) { const int i = 16 * it + fr; R.bs[it] = sgb[g * 128 + i]; R.uv[it] = *(const uint2*)(P + (t0 + i) * EVEN_IN + 3072 + g * 128 + 16 * w + 4 * fq); }
}
__device__ __forceinline__ void gmlp_unit(LAS unsigned char* lds, const bf16* P, const float* lng, const float* lnb, const float* sgw, const float* sgb, bf16* MIX, int u) {
    constexpr int ST = 272;
    LAS unsigned char* Wl = lds; LAS unsigned char* Zt = lds + 128 * ST; LAS float* stat = (LAS float*)(lds + 256 * ST);
    const int tid = opaque_tid(), lane = tid & 63, w = tid >> 6, fr = lane & 15, fq = lane >> 4;
    const int gp2 = u & 1, p = (u >> 1) & 15, b = u >> 5; const size_t t0 = (size_t)b * SEQ + (size_t)p * 128;
    const int c8 = (tid & 15) * 8;
    u32x4 zv[16];
#pragma unroll
    for (int i = 0; i < 16; ++i) zv[i] = *(const u32x4*)(P + (t0 + 16 * w + i) * EVEN_IN + 3584 + lane * 8);
    GmRegs R; gm_load(R, P, lng, lnb, sgw, sgb, t0, 2 * gp2, tid, w, fr, fq); gm_load_epi(R, P, sgb, t0, 2 * gp2, w, fr, fq);
    __syncthreads();
    { float val[32];
#pragma unroll
      for (int i = 0; i < 16; ++i) { float s = 0.f, q = 0.f;
#pragma unroll
          for (int k = 0; k < 4; ++k) { const float lo = __uint_as_float(zv[i][k] << 16), hi = __uint_as_float(zv[i][k] & 0xffff0000u); s += lo + hi; q += lo * lo + hi * hi; }
          val[2 * i] = sum_halves(s); val[2 * i + 1] = sum_halves(q); }
#define RS_STEP(M, HALF) do { const bool up = (lane & (M)) != 0; _Pragma("unroll") for (int i = 0; i < (HALF); ++i) { const float snd = up ? val[i] : val[i + (HALF)], kp = up ? val[i + (HALF)] : val[i]; val[i] = kp + xshfl<(M)>(snd); } } while (0)
      RS_STEP(16, 16); RS_STEP(8, 8); RS_STEP(4, 4); RS_STEP(2, 2); RS_STEP(1, 1);
#undef RS_STEP
      const float mine = val[0], other = xshfl<1>(mine);
      if ((lane & 33) == 0) { const float mu = mine * (1.0f / 512.0f); const float var = fmaxf(other * (1.0f / 512.0f) - mu * mu, 0.f); const int row = 16 * w + ((lane & 31) >> 1); stat[2 * row] = mu; stat[2 * row + 1] = rsqrtf(var + EPS); } }
#pragma unroll 1
    for (int gi = 0; gi < 2; ++gi) { const int g = 2 * gp2 + gi;
        if (gi == 1) __syncthreads();
#pragma unroll
        for (int i = 0; i < 8; ++i) { const int id = tid + 512 * i, r = id >> 5, c4 = (id & 31) * 4; float4 v = R.w4[i];
            if (r < 64 && c4 >= 64) v = make_float4(0.f, 0.f, 0.f, 0.f);
            u32x2 pk; pk.x = pg8::cvt_pk_bf16(v.x, v.y); pk.y = pg8::cvt_pk_bf16(v.z, v.w); *(LAS u32x2*)(Wl + r * ST + c4 * 2) = pk; }
        __syncthreads();
#pragma unroll
        for (int i = 0; i < 4; ++i) { const int id = tid + 512 * i, j = id >> 4; const u32x4 zz = R.z2[i];
            const float mu = stat[2 * j], rs = stat[2 * j + 1];
#pragma unroll
            for (int k = 0; k < 4; ++k) { const float gl_ = k < 2 ? R.lg0[2 * k] : R.lg1[2 * k - 4], gh_ = k < 2 ? R.lg0[2 * k + 1] : R.lg1[2 * k - 3], bl_ = k < 2 ? R.lb0[2 * k] : R.lb1[2 * k - 4], bh_ = k < 2 ? R.lb0[2 * k + 1] : R.lb1[2 * k - 3];
                const float lo = (__uint_as_float(zz[k] << 16) - mu) * rs * gl_ + bl_, hi = (__uint_as_float(zz[k] & 0xffff0000u) - mu) * rs * gh_ + bh_;
                const unsigned pk = pg8::cvt_pk_bf16(lo, hi);
                *(LAS unsigned short*)(Zt + (c8 + 2 * k) * ST + j * 2) = (unsigned short)(pk & 0xffffu); *(LAS unsigned short*)(Zt + (c8 + 2 * k + 1) * ST + j * 2) = (unsigned short)(pk >> 16); } }
        __syncthreads();
        if (gi == 0) gm_load(R, P, lng, lnb, sgw, sgb, t0, g + 1, tid, w, fr, fq);
        f32x4 acc[8];
#pragma unroll
        for (int it = 0; it < 8; ++it) acc[it] = (f32x4){0.f, 0.f, 0.f, 0.f};
#pragma unroll
        for (int s = 0; s < 4; ++s) { const bf16x8 zf = *(const LAS bf16x8*)(Zt + (16 * w + fr) * ST + (32 * s + 8 * fq) * 2);
#pragma unroll
            for (int it = 0; it < 8; ++it) { if (s >= 2 && it < 4) continue; const bf16x8 wf = *(const LAS bf16x8*)(Wl + (16 * it + fr) * ST + (32 * s + 8 * fq) * 2);
                acc[it] = __builtin_amdgcn_mfma_f32_16x16x32_bf16(zf, wf, acc[it], 0, 0, 0); } }
#pragma unroll
        for (int it = 0; it < 8; ++it) { const int i = 16 * it + fr; const float bs = R.bs[it]; const uint2 uv = R.uv[it];
            const float u0 = __uint_as_float(uv.x << 16), u1 = __uint_as_float(uv.x & 0xffff0000u), u2 = __uint_as_float(uv.y << 16), u3 = __uint_as_float(uv.y & 0xffff0000u);
            *(unsigned*)((unsigned char*)MIX + (t0 + i) * EVEN_MIX + 1024 + g * 128 + 16 * w + 4 * fq) = pg8::pk4_fp8(u0 * (acc[it][0] + bs), u1 * (acc[it][1] + bs), u2 * (acc[it][2] + bs), u3 * (acc[it][3] + bs)); }
        if (gi == 0) gm_load_epi(R, P, sgb, t0, g + 1, w, fr, fq);
    }
}
__device__ __forceinline__ void phase_e1(LAS unsigned char* lds, const bf16* P, bf16* KV, const float* lng, const float* lnb, const float* sgw, const float* sgb, bf16* MIX, int c0, int G, int ulo, int uhi) {
    KvRegs R; bool have = false;
    for (int u = ulo + c0; u < uhi; u += G) {
        if (u < 1024) { if (((u >> 2) & 31) == 31) continue;
            if (!have) kv_load(R, P, u, opaque_tid());
            int un = u + G; while (un < uhi && un < 1024 && ((un >> 2) & 31) == 31) un += G;
            const int unext = (un < uhi && un < 1024) ? un : -1;
            kv_unit(lds, P, KV, u, R, unext); have = unext >= 0; }
        else gmlp_unit(lds, P, lng, lnb, sgw, sgb, MIX, u - 1024);
    }
}
__device__ __forceinline__ void phase_e2(const bf16* KV, bf16* STt, int gtid, int nthr) {
    for (int idx = gtid; idx < NB * 4 * 4096; idx += nthr) {
        const int bh = idx >> 12, rem = (idx & 4095) * 8, b = bh >> 2, h = bh & 3;
        const float g64 = exp2f(64.0f * log2f(1.0f - exp2f(-5.0f - (float)h)));
        float S[8];
#pragma unroll
        for (int k = 0; k < 8; ++k) S[k] = 0.f;
        u32x4 kvv[31];
#pragma unroll
        for (int n = 0; n < 31; ++n) kvv[n] = *(const u32x4*)(KV + ((size_t)((b * 32 + n) * 4 + h)) * 32768 + rem);
#pragma unroll
        for (int n = 0; n < 31; ++n) { const size_t off = ((size_t)((b * 32 + n) * 4 + h)) * 32768 + rem; const u32x4 v = kvv[n];
#pragma unroll
            for (int k = 0; k < 4; ++k) { S[2 * k] = S[2 * k] * g64 + __uint_as_float(v[k] << 16); S[2 * k + 1] = S[2 * k + 1] * g64 + __uint_as_float(v[k] & 0xffff0000u); }
            u32x4 o;
#pragma unroll
            for (int k = 0; k < 4; ++k) o[k] = pg8::cvt_pk_bf16(S[2 * k], S[2 * k + 1]);
            *(u32x4*)(STt + off + 4 * 32768) = o; }
    }
}
struct RetRegs { u32x4 k[2], v[4], s[8]; bf16x8 q[4]; uint2 g[8]; };
__device__ __forceinline__ void ret_load(RetRegs& R, const bf16* P, const bf16* STt, int u, int tid, int it, int fr, int fq) {
    const int h = u & 3, n = (u >> 2) & 31, b = u >> 7; const size_t row0 = (size_t)b * SEQ + (size_t)n * 64;
#pragma unroll
    for (int i = 0; i < 2; ++i) { const int id = tid + 512 * i, j = id >> 4, seg = id & 15; R.k[i] = *(const u32x4*)(P + (row0 + j) * EVEN_IN + 512 + h * 128 + seg * 8); }
#pragma unroll
    for (int i = 0; i < 4; ++i) { const int id = tid + 512 * i, j = id >> 5, seg = id & 31; R.v[i] = *(const u32x4*)(P + (row0 + j) * EVEN_IN + 1024 + h * 256 + seg * 8); }
    if (n > 0) {
#pragma unroll
        for (int i = 0; i < 8; ++i) { const int id = tid + 512 * i, e = id >> 4, seg = id & 15; R.s[i] = *(const u32x4*)(STt + (size_t)u * 32768 + e * 128 + seg * 8); } }
#pragma unroll
    for (int s = 0; s < 4; ++s) R.q[s] = *(const bf16x8*)(P + (row0 + 16 * it + fr) * EVEN_IN + h * 128 + 32 * s + 8 * fq);
    { const int eh = (tid >> 6) & 1; const bf16* gp = P + (row0 + 16 * it + fr) * EVEN_IN + 2048 + h * 256 + 128 * eh + 4 * fq;
#pragma unroll
      for (int k = 0; k < 8; ++k) R.g[k] = *(const uint2*)(gp + 16 * k); }
}
__device__ __forceinline__ void ret_unit(LAS unsigned char* lds, const bf16* P, const bf16* STt, bf16* MIX, int u, RetRegs& R, int unext) {
    constexpr int KST = 272, VST = 528, SST = 272;
    LAS unsigned char* Ks = lds; LAS unsigned char* Vs = lds + 64 * KST; LAS unsigned char* Ss = Vs + 64 * VST; LAS float* dec = (LAS float*)(Ss + 256 * SST); LAS float* red = dec + 128;
    const int tid = opaque_tid(), lane = tid & 63, w = tid >> 6, fr = lane & 15, fq = lane >> 4, it = w >> 1, eh = w & 1;
    const int h = u & 3, n = (u >> 2) & 31, b = u >> 7;
    const float log2g = log2f(1.0f - exp2f(-5.0f - (float)h));
    const size_t row0 = (size_t)b * SEQ + (size_t)n * 64;
    __syncthreads();
    if (tid < 65) dec[tid] = exp2f(log2g * (float)tid);
#pragma unroll
    for (int i = 0; i < 2; ++i) { const int id = tid + 512 * i, j = id >> 4, seg = id & 15; *(LAS u32x4*)(Ks + j * KST + seg * 16) = R.k[i]; }
#pragma unroll
    for (int i = 0; i < 4; ++i) { const int id = tid + 512 * i, j = id >> 5, seg = id & 31; *(LAS u32x4*)(Vs + j * VST + seg * 16) = R.v[i]; }
    if (n > 0) {
#pragma unroll
        for (int i = 0; i < 8; ++i) { const int id = tid + 512 * i, e = id >> 4, seg = id & 15; *(LAS u32x4*)(Ss + e * SST + seg * 16) = R.s[i]; } }
    bf16x8 qf[4];
#pragma unroll
    for (int s = 0; s < 4; ++s) qf[s] = R.q[s];
    uint2 gcur[8];
#pragma unroll
    for (int k = 0; k < 8; ++k) gcur[k] = R.g[k];
    __syncthreads();
    if (unext >= 0) ret_load(R, P, STt, unext, tid, it, fr, fq);
    const int i_loc = 16 * it + fr;
    bf16x8 pf[2];
    { f32x4 pt[4];
#pragma unroll
      for (int t = 0; t < 4; ++t) { f32x4 a = (f32x4){0.f, 0.f, 0.f, 0.f};
#pragma unroll
          for (int s = 0; s < 4; ++s) { const bf16x8 kf = *(const LAS bf16x8*)(Ks + (16 * t + fr) * KST + (32 * s + 8 * fq) * 2); a = __builtin_amdgcn_mfma_f32_16x16x32_bf16(kf, qf[s], a, 0, 0, 0); }
#pragma unroll
          for (int r = 0; r < 4; ++r) { const int dj = i_loc - (16 * t + 4 * fq + r); a[r] *= dec[dj < 0 ? -dj : dj]; }
          pt[t] = a; }
      pf[0] = (bf16x8)pg8::pack8(pt[0], pt[1]); pf[1] = (bf16x8)pg8::pack8(pt[2], pt[3]); }
    f32x4 o[8];
#pragma unroll
    for (int k = 0; k < 8; ++k) o[k] = (f32x4){0.f, 0.f, 0.f, 0.f};
    if (n > 0) {
#pragma unroll
        for (int k = 0; k < 8; ++k)
#pragma unroll
            for (int s = 0; s < 4; ++s) { const bf16x8 sf = *(const LAS bf16x8*)(Ss + (16 * (8 * eh + k) + fr) * SST + (32 * s + 8 * fq) * 2); o[k] = __builtin_amdgcn_mfma_f32_16x16x32_bf16(sf, qf[s], o[k], 0, 0, 0); }
        const float qd = dec[i_loc + 1];
#pragma unroll
        for (int k = 0; k < 8; ++k) o[k] = o[k] * qd;
    }
#pragma unroll
    for (int s = 0; s < 2; ++s)
#pragma unroll
        for (int k = 0; k < 8; ++k) { const LAS unsigned char* vp = Vs + (32 * s + 4 * fq + (fr >> 2)) * VST + (16 * (8 * eh + k) + 4 * (fr & 3)) * 2; const bf16x8 vf = tr_frag(vp, vp + 16 * VST);
            o[k] = __builtin_amdgcn_mfma_f32_16x16x32_bf16(vf, pf[s], o[k], 0, 0, 0); }
    float s1 = 0.f, s2 = 0.f;
#pragma unroll
    for (int k = 0; k < 8; ++k)
#pragma unroll
        for (int r = 0; r < 4; ++r) { s1 += o[k][r]; s2 += o[k][r] * o[k][r]; }
    s1 += xshfl<16>(s1); s1 = sum_halves(s1); s2 += xshfl<16>(s2); s2 = sum_halves(s2);
    if (fq == 0) { red[(w * 16 + fr) * 2] = s1; red[(w * 16 + fr) * 2 + 1] = s2; }
    __syncthreads();
    { const int wo = w ^ 1; s1 += red[(wo * 16 + fr) * 2]; s2 += red[(wo * 16 + fr) * 2 + 1]; }
    const float mu = s1 * (1.0f / 256.0f), var = fmaxf(s2 * (1.0f / 256.0f) - mu * mu, 0.f), rs = rsqrtf(var + EPS);
    const bf16* gp = P + (row0 + i_loc) * EVEN_IN + 2048 + h * 256 + 128 * eh + 4 * fq; unsigned char* dst = (unsigned char*)MIX + (row0 + i_loc) * EVEN_MIX + h * 256 + 128 * eh + 4 * fq;
#pragma unroll
    for (int k = 0; k < 8; ++k) { const uint2 gv = gcur[k];
        const float g0 = __uint_as_float(gv.x << 16), g1 = __uint_as_float(gv.x & 0xffff0000u), g2 = __uint_as_float(gv.y << 16), g3 = __uint_as_float(gv.y & 0xffff0000u);
        *(unsigned*)(dst + 16 * k) = pg8::pk4_fp8((o[k][0] - mu) * rs * g0, (o[k][1] - mu) * rs * g1, (o[k][2] - mu) * rs * g2, (o[k][3] - mu) * rs * g3); }
}
__device__ __forceinline__ void phase_e3(LAS unsigned char* lds, const bf16* P, const bf16* STt, bf16* MIX, int c0, int G) {
    RetRegs R; { const int tid = opaque_tid(), lane = tid & 63; if (c0 < 1024) ret_load(R, P, STt, c0, tid, tid >> 7, lane & 15, lane >> 4); }
    for (int u = c0; u < 1024; u += G) ret_unit(lds, P, STt, MIX, u, R, u + G < 1024 ? u + G : -1);
}
typedef float f32x4g __attribute__((ext_vector_type(4)));
__device__ __forceinline__ void phase_mod(LAS unsigned char* lds, const float* c, const float* ada_w, const float* ada_b, float* MOD, int c0, int G) {
    LAS float* ca = (LAS float*)lds; LAS float* red = (LAS float*)(lds + 32768);
    const int tid = opaque_tid(), lane = tid & 63, w = tid >> 6;
    __syncthreads();
    for (int i = tid; i < 8192; i += 512) { const float v = c[i]; ca[i] = v / (1.0f + __expf(-v)); }
    __syncthreads();
    for (int u = c0; u < DEPTH * 96; u += G) { const int l = u / 96, n0 = (u % 96) * 64;
        const float* wp = ada_w + ((size_t)l * 1024 + 128 * w) * 6144 + n0 + lane; float acc[8];
#pragma unroll
        for (int b = 0; b < 8; ++b) acc[b] = 0.f;
#pragma unroll 32
        for (int k = 0; k < 128; ++k) { const float wv = __builtin_nontemporal_load(wp + (size_t)k * 6144);
#pragma unroll
            for (int b = 0; b < 8; ++b) acc[b] += ca[b * 1024 + 128 * w + k] * wv; }
#pragma unroll
        for (int b = 0; b < 8; ++b) red[(w * 8 + b) * 64 + lane] = acc[b];
        __syncthreads();
        { const int b = tid >> 6; float s = 0.f;
#pragma unroll
          for (int ww = 0; ww < 8; ++ww) s += red[(ww * 8 + b) * 64 + lane];
          MOD[(size_t)(l * 8 + b) * 6144 + n0 + lane] = s + ada_b[l * 6144 + n0 + lane]; }
        __syncthreads(); }
}
__device__ __forceinline__ void phase_rope(float* COS, float* SIN, int gtid, int nthr) {
    for (int i = gtid; i < SEQ * 64; i += nthr) { const int pos = i >> 6, d = i & 63; const float inv = powf(10000.0f, -(float)d / 64.0f); const float ang = (float)pos * inv; COS[i] = cosf(ang); SIN[i] = sinf(ang); }
}
__device__ __forceinline__ f32x4g ld4bf(const bf16* p) { const uint2 y = *(const uint2*)p; return (f32x4g){__uint_as_float(y.x << 16), __uint_as_float(y.x & 0xffff0000u), __uint_as_float(y.y << 16), __uint_as_float(y.y & 0xffff0000u)}; }
__device__ __forceinline__ void st4bf(bf16* p, const f32x4g v) { uint2 pk; pk.x = pg8::cvt_pk_bf16(v[0], v[1]); pk.y = pg8::cvt_pk_bf16(v[2], v[3]); *(uint2*)p = pk; }
template <bool IN_F32, bool OUT_F32> __device__ __forceinline__ void phase_norm1_generic(const void* Xin_, void* Xout_, bool store_x, const bf16* YS, const float* MODprev, bool combine, const float* g, const float* MODl, bf16* H, bool do_norm, int gw, int ngw, bool h_fp8 = false, unsigned char* H8 = nullptr) {
    const int lane = opaque_tid() & 63;
    for (int row = gw; row < T_TOK; row += ngw) { const int b = row / SEQ; f32x4g v[4];
#pragma unroll
        for (int j = 0; j < 4; ++j) { if constexpr (IN_F32) v[j] = *(const f32x4g*)((const float*)Xin_ + (size_t)row * DM + 256 * j + 4 * lane); else v[j] = ld4bf((const bf16*)Xin_ + (size_t)row * DM + 256 * j + 4 * lane); }
        if (combine) { const float* g2 = MODprev + (size_t)b * 6144 + 5120;
#pragma unroll
            for (int j = 0; j < 4; ++j) { f32x4g s = (f32x4g){0.f, 0.f, 0.f, 0.f};
#pragma unroll
                for (int k = 0; k < 4; ++k) { const int y = *(const int*)((const unsigned char*)YS + ((size_t)row * 4 + k) * DM + 256 * j + 4 * lane);
                    const auto lo = __builtin_amdgcn_cvt_pk_f32_fp8(y, false), hi = __builtin_amdgcn_cvt_pk_f32_fp8(y, true); s[0] += lo[0]; s[1] += lo[1]; s[2] += hi[0]; s[3] += hi[1]; }
                v[j] = v[j] + *(const f32x4g*)(g2 + 256 * j + 4 * lane) * (s * YSCALE_INV); } }
        if (store_x) {
#pragma unroll
            for (int j = 0; j < 4; ++j) { if constexpr (OUT_F32) __builtin_nontemporal_store(v[j], (f32x4g*)((float*)Xout_ + (size_t)row * DM + 256 * j + 4 * lane));   else st4bf((bf16*)Xout_ + (size_t)row * DM + 256 * j + 4 * lane, v[j]); } }
        if (do_norm) { float ss = 0.f;
#pragma unroll
            for (int j = 0; j < 4; ++j) ss += (v[j][0] * v[j][0] + v[j][1] * v[j][1]) + (v[j][2] * v[j][2] + v[j][3] * v[j][3]);
            ss = wave_sum(ss); const float r = rsqrtf(ss * (1.0f / DM) + EPS); const float* mod = MODl + (size_t)b * 6144;
#pragma unroll
            for (int j = 0; j < 4; ++j) { const int k = 256 * j + 4 * lane; const f32x4g gv = *(const f32x4g*)(g + k), sc = *(const f32x4g*)(mod + 1024 + k), sh = *(const f32x4g*)(mod + k);
                const f32x4g hv = v[j] * r * gv * (sc + 1.0f) + sh;
                if (H8) *(unsigned*)(H8 + (size_t)row * DM + k) = pg8::pk4_fp8(hv[0], hv[1], hv[2], hv[3]);
                if (h_fp8) *(unsigned*)((unsigned char*)H + (size_t)row * DM + k) = pg8::pk4_fp8(hv[0], hv[1], hv[2], hv[3]);
                else { uint2 pk; pk.x = pg8::cvt_pk_bf16(hv[0], hv[1]); pk.y = pg8::cvt_pk_bf16(hv[2], hv[3]); *(uint2*)(H + (size_t)row * DM + k) = pk; } } }
    }
}
template <bool IN_F32, bool OUT_F32> __device__ __forceinline__ void phase_norm1(const void* Xin_, void* Xout_, bool store_x, const bf16* YS, const float* MODprev, bool combine, const float* g, const float* MODl, bf16* H, bool do_norm, int gw, int ngw, bool h_fp8 = false, unsigned char* H8 = nullptr) {
    const int rpw = T_TOK / ngw;
    if (rpw * ngw != T_TOK || (SEQ % rpw) != 0 || combine != !IN_F32 || do_norm != !OUT_F32 || !store_x) { phase_norm1_generic<IN_F32, OUT_F32>(Xin_, Xout_, store_x, YS, MODprev, combine, g, MODl, H, do_norm, gw, ngw, h_fp8, H8); return; }
    constexpr bool COMB = !IN_F32, NORM = !OUT_F32;
    const int lane = opaque_tid() & 63; const int row0 = gw * rpw, rend = row0 + rpw, b = row0 / SEQ;
    f32x4g g2v[4], gv[4], scv[4], shv[4];
#pragma unroll
    for (int j = 0; j < 4; ++j) { const int k = 256 * j + 4 * lane;
        if constexpr (COMB) g2v[j] = *(const f32x4g*)(MODprev + (size_t)b * 6144 + 5120 + k) * YSCALE_INV;
        if constexpr (NORM) { gv[j] = *(const f32x4g*)(g + k); scv[j] = *(const f32x4g*)(MODl + (size_t)b * 6144 + 1024 + k) + 1.0f; shv[j] = *(const f32x4g*)(MODl + (size_t)b * 6144 + k); gv[j] = gv[j] * scv[j]; } }
    f32x4g xfa[4], xfb[4]; uint2 xba[4], xbb[4]; int ya[16], yb[16];
#define N1_LOAD(XF, XB_, Y, r_) do { \
        _Pragma("unroll") for (int j = 0; j < 4; ++j) { if constexpr (IN_F32) XF[j] = *(const f32x4g*)((const float*)Xin_ + (size_t)(r_) * DM + 256 * j + 4 * lane); else XB_[j] = *(const uint2*)((const bf16*)Xin_ + (size_t)(r_) * DM + 256 * j + 4 * lane); } \
        if constexpr (COMB) { _Pragma("unroll") for (int j = 0; j < 4; ++j) { _Pragma("unroll") for (int k = 0; k < 4; ++k) Y[4 * j + k] = *(const int*)((const unsigned char*)YS + ((size_t)(r_) * 4 + k) * DM + 256 * j + 4 * lane); } } \
    } while (0)
#define N1_PROC(XF, XB_, Y, r_) do { f32x4g v[4]; \
        _Pragma("unroll") for (int j = 0; j < 4; ++j) { if constexpr (IN_F32) v[j] = XF[j]; else v[j] = (f32x4g){__uint_as_float(XB_[j].x << 16), __uint_as_float(XB_[j].x & 0xffff0000u), __uint_as_float(XB_[j].y << 16), __uint_as_float(XB_[j].y & 0xffff0000u)}; } \
        if constexpr (COMB) { _Pragma("unroll") for (int j = 0; j < 4; ++j) { f32x4g s = (f32x4g){0.f, 0.f, 0.f, 0.f}; \
            _Pragma("unroll") for (int k = 0; k < 4; ++k) { const auto lo = __builtin_amdgcn_cvt_pk_f32_fp8(Y[4 * j + k], false), hi = __builtin_amdgcn_cvt_pk_f32_fp8(Y[4 * j + k], true); s[0] += lo[0]; s[1] += lo[1]; s[2] += hi[0]; s[3] += hi[1]; } \
            v[j] = v[j] + g2v[j] * s; } } \
        _Pragma("unroll") for (int j = 0; j < 4; ++j) { if constexpr (OUT_F32) __builtin_nontemporal_store(v[j], (f32x4g*)((float*)Xout_ + (size_t)(r_) * DM + 256 * j + 4 * lane)); else st4bf((bf16*)Xout_ + (size_t)(r_) * DM + 256 * j + 4 * lane, v[j]); } \
        if constexpr (NORM) { float ss = 0.f; \
            _Pragma("unroll") for (int j = 0; j < 4; ++j) ss += (v[j][0] * v[j][0] + v[j][1] * v[j][1]) + (v[j][2] * v[j][2] + v[j][3] * v[j][3]); \
            ss = wave_sum(ss); const float rr = rsqrtf(ss * (1.0f / DM) + EPS); \
            _Pragma("unroll") for (int j = 0; j < 4; ++j) { const int k = 256 * j + 4 * lane; const f32x4g hv = v[j] * rr * gv[j] + shv[j]; \
                if (H8) *(unsigned*)(H8 + (size_t)(r_) * DM + k) = pg8::pk4_fp8(hv[0], hv[1], hv[2], hv[3]); \
                if (h_fp8) *(unsigned*)((unsigned char*)H + (size_t)(r_) * DM + k) = pg8::pk4_fp8(hv[0], hv[1], hv[2], hv[3]); \
                else { uint2 pk; pk.x = pg8::cvt_pk_bf16(hv[0], hv[1]); pk.y = pg8::cvt_pk_bf16(hv[2], hv[3]); *(uint2*)(H + (size_t)(r_) * DM + k) = pk; } } } \
    } while (0)
    int row = row0;
    N1_LOAD(xfa, xba, ya, row);
    for (;;) {
        if (row + 1 >= rend) { N1_PROC(xfa, xba, ya, row); break; }
        N1_LOAD(xfb, xbb, yb, row + 1); asm volatile("" ::: "memory"); N1_PROC(xfa, xba, ya, row); ++row;
        if (row + 1 >= rend) { N1_PROC(xfb, xbb, yb, row); break; }
        N1_LOAD(xfa, xba, ya, row + 1); asm volatile("" ::: "memory"); N1_PROC(xfb, xbb, yb, row); ++row;
    }
#undef N1_LOAD
#undef N1_PROC
}
__device__ __forceinline__ void phase_router(LAS unsigned char* lds, const bf16* X, const float* gffn, const float* MODl, const float* rw, const float* rb, bf16* H,
                                             int* RSLOT, float* RGATE, int* COUNTS, int c0, int G) {
    LAS float* wf = (LAS float*)lds; LAS float* GV = (LAS float*)(lds + 131072); LAS float* SH = GV + 1024;
    LAS float* rs = (LAS float*)(lds + LDS_CTL_OFF + 1536); LAS int* hist = (LAS int*)(rs + 64); LAS int* base = hist + 32; LAS int* rank = base + 32; LAS int* eid = rank + 256; LAS float* gl = (LAS float*)(eid + 256);
    const int tid = opaque_tid(), lane = tid & 63, w = tid >> 6, fr = lane & 15, kq = lane >> 4;
    for (int unit = c0; unit < T_TOK / 64; unit += G) { const int t0 = unit * 64, b = t0 / SEQ; const float* mod = MODl + (size_t)b * 6144;
        __syncthreads();
        f32x4g rwv[16];
#pragma unroll
        for (int i = 0; i < 16; ++i) rwv[i] = *(const f32x4g*)(rw + 4 * (tid + 512 * i));
        for (int k = tid; k < DM; k += 512) { GV[k] = gffn[k] * (1.0f + mod[4096 + k]); SH[k] = mod[3072 + k]; }
        if (tid < 32) hist[tid] = 0;
        __syncthreads();
#pragma unroll
        for (int i = 0; i < 8; ++i) { const int row = t0 + 8 * w + i; f32x4g v[4]; float ss = 0.f;
#pragma unroll
            for (int j = 0; j < 4; ++j) { v[j] = ld4bf(X + (size_t)row * DM + 256 * j + 4 * lane); ss += (v[j][0] * v[j][0] + v[j][1] * v[j][1]) + (v[j][2] * v[j][2] + v[j][3] * v[j][3]); }
            ss = wave_sum(ss); const float r = rsqrtf(ss * (1.0f / DM) + EPS); if (lane == 0) rs[8 * w + i] = r;
#pragma unroll
            for (int j = 0; j < 4; ++j) { const int k = 256 * j + 4 * lane; const f32x4g gv = *(const LAS f32x4g*)(GV + k), sh = *(const LAS f32x4g*)(SH + k);
                const f32x4g hv = v[j] * r * gv + sh; *(unsigned*)((unsigned char*)H + (size_t)row * DM + k) = pg8::pk4_fp8(hv[0], hv[1], hv[2], hv[3]); } }
#pragma unroll
        for (int i = 0; i < 16; ++i) { const int q = tid + 512 * i, k = q >> 3, e = (q & 7) * 4; const int l = (k >> 8) * 16 + (e & 15), et = e >> 4, s = k & 255; LAS float* d = wf + ((s >> 2) * 2 + et) * 256 + 4 * l + (s & 3);
            d[0] = rwv[i][0]; d[4] = rwv[i][1]; d[8] = rwv[i][2]; d[12] = rwv[i][3]; }
        __syncthreads();
        const int tg = w & 3, kh = w >> 2, tok = t0 + 16 * tg + fr; const float r = rs[16 * tg + fr];
        f32x4 acc0 = (f32x4){0.f, 0.f, 0.f, 0.f}, acc1 = (f32x4){0.f, 0.f, 0.f, 0.f};
        { const bf16* xp = X + (size_t)tok * DM + 256 * kq + 128 * kh; const LAS float* gp = GV + 256 * kq + 128 * kh; const LAS float* shp = SH + 256 * kq + 128 * kh; const LAS float* wp = wf + (size_t)(64 * kh) * 256 + 4 * lane;
          uint2 xr[32];
#pragma unroll
          for (int u = 0; u < 32; ++u) xr[u] = *(const uint2*)(xp + 4 * u);
#pragma unroll
          for (int u = 0; u < 32; ++u) { const f32x4g xv = (f32x4g){__uint_as_float(xr[u].x << 16), __uint_as_float(xr[u].x & 0xffff0000u), __uint_as_float(xr[u].y << 16), __uint_as_float(xr[u].y & 0xffff0000u)}, gv = *(const LAS f32x4g*)(gp + 4 * u), sh = *(const LAS f32x4g*)(shp + 4 * u);
              const f32x4g hv = xv * r * gv + sh; const f32x4g w0 = *(const LAS f32x4g*)(wp + (u * 2) * 256), w1 = *(const LAS f32x4g*)(wp + (u * 2 + 1) * 256);
#pragma unroll
              for (int q = 0; q < 4; ++q) { acc0 = __builtin_amdgcn_mfma_f32_16x16x4f32(w0[q], hv[q], acc0, 0, 0, 0); acc1 = __builtin_amdgcn_mfma_f32_16x16x4f32(w1[q], hv[q], acc1, 0, 0, 0); } } }
        __syncthreads();
        if (kh == 1) { *(LAS f32x4*)(wf + (tg * 64 + lane) * 8) = acc0; *(LAS f32x4*)(wf + (tg * 64 + lane) * 8 + 4) = acc1; }
        __syncthreads();
        if (kh == 0) {
            acc0 = acc0 + *(const LAS f32x4*)(wf + (tg * 64 + lane) * 8); acc1 = acc1 + *(const LAS f32x4*)(wf + (tg * 64 + lane) * 8 + 4);
            float vals[8];
#pragma unroll
            for (int q = 0; q < 4; ++q) { vals[q] = acc0[q] + rb[4 * kq + q]; vals[4 + q] = acc1[q] + rb[16 + 4 * kq + q]; }
            unsigned taken = 0u; float tv[4]; int ti[4];
#pragma unroll
            for (int rr = 0; rr < 4; ++rr) { float bv = -3.0e38f; int bi = 64;
#pragma unroll
                for (int cc = 0; cc < 8; ++cc) { const int e = 16 * (cc >> 2) + 4 * kq + (cc & 3); const float v = ((taken >> cc) & 1u) ? -3.0e38f : vals[cc]; if (v > bv || (v == bv && e < bi)) { bv = v; bi = e; } }
                { const float ov = xshfl<16>(bv); const int oi = xshfl_i<16>(bi); if (ov > bv || (ov == bv && oi < bi)) { bv = ov; bi = oi; } }
                { const auto rv = __builtin_amdgcn_permlane32_swap(__float_as_uint(bv), __float_as_uint(bv), false, false); const auto ri = __builtin_amdgcn_permlane32_swap((unsigned)bi, (unsigned)bi, false, false);
                  const float v0 = __uint_as_float(rv[0]), v1 = __uint_as_float(rv[1]); const int i0 = (int)ri[0], i1 = (int)ri[1]; const bool take1 = v1 > v0 || (v1 == v0 && i1 < i0); bv = take1 ? v1 : v0; bi = take1 ? i1 : i0; }
                tv[rr] = bv; ti[rr] = bi; if (((bi >> 2) & 3) == kq) taken |= 1u << (((bi >> 4) << 2) | (bi & 3)); }
            const float e1 = __expf(tv[1] - tv[0]), e2 = __expf(tv[2] - tv[0]), e3 = __expf(tv[3] - tv[0]), inv = 1.0f / (1.0f + e1 + e2 + e3);
            if (kq == 0) { const float gt[4] = {inv, e1 * inv, e2 * inv, e3 * inv};
#pragma unroll
                for (int rr = 0; rr < 4; ++rr) { const int a = (16 * tg + fr) * 4 + rr; eid[a] = ti[rr]; gl[a] = gt[rr]; rank[a] = atomicAdd((int*)(hist + ti[rr]), 1); } }
        }
        __syncthreads();
        if (tid < 32) base[tid] = atomicAdd(&COUNTS[tid], hist[tid]);
        __syncthreads();
        if (tid < 256) { const int e = eid[tid], dest = e * EREG + base[e] + rank[tid]; RSLOT[dest] = t0 * 4 + tid; RGATE[dest] = gl[tid]; }
    }
}
__device__ __forceinline__ void moe_prefix(LAS int* ps, const int* COUNTS) {
    if (opaque_tid() == 0) { int a = 0; for (int e = 0; e < NEXP; ++e) { const int cnt = COUNTS[e]; ps[e] = a; ps[64 + e] = cnt; a += ((cnt + 255) >> 8) << 8; } ps[NEXP] = a; }
    __syncthreads();
}
__device__ __forceinline__ void phase_gather(LAS unsigned char* lds, const bf16* H, const int* TOPI, const float* TOPG, const int* POS, const int* COUNTS, bf16* XS, int* ROWSLOT, float* ROWGATE, int c0, int G) {
    LAS int* ps = (LAS int*)lds; const int tid = opaque_tid(), lane = tid & 63, w = tid >> 6;
    __syncthreads(); moe_prefix(ps, COUNTS);
    for (int a = c0 * 8 + w; a < T_TOK * 4; a += G * 8) { const int t = a >> 2, e = TOPI[a], dest = ps[e] + POS[a];
        const u32x4* src = (const u32x4*)((const unsigned char*)H + (size_t)t * DM); u32x4* dst = (u32x4*)((unsigned char*)XS + (size_t)dest * DM); dst[lane] = src[lane];
        if (lane == 0) { ROWSLOT[dest] = a; ROWGATE[dest] = TOPG[a]; } }
    for (int e = c0; e < NEXP; e += G) for (int r = ps[e] + ps[64 + e] + tid; r < ps[e + 1]; r += 512) ROWSLOT[r] = -1;
}
#define XB_TMO      128
#define XB_XCNT(j)  (256  + 64 * (j))
#define XB_XSUB(j)  (1280 + 64 * (j))
#define XB_XGEN(j)  (2304 + 64 * (j))
#define XB_TOP      3328
#define XB_TOPGEN   3392
#define XCD_BAR_WORDS 3456
#define XB_SPIN_CAP (1u << 18)
#define LAS __attribute__((address_space(3)))

__device__ __forceinline__ unsigned xb_ld(unsigned* p)              { return __hip_atomic_load(p, __ATOMIC_RELAXED, __HIP_MEMORY_SCOPE_AGENT); }
__device__ __forceinline__ unsigned xb_add(unsigned* p, unsigned v) { return __hip_atomic_fetch_add(p, v, __ATOMIC_RELAXED, __HIP_MEMORY_SCOPE_AGENT); }
__device__ __forceinline__ unsigned xb_xcc_id() { return (unsigned)__builtin_amdgcn_s_getreg((3 << 11) | 20) & 0xFu; }
#define XB_SPIN(cond, bar) do { unsigned _sp = 0; while (cond) { __builtin_amdgcn_s_sleep(1); \
    if ((++_sp & 255u) == 0u) { if (xb_ld(&(bar)[XB_TMO])) break; if (_sp > XB_SPIN_CAP) { atomicAdd(&(bar)[XB_TMO], 1u); break; } } } } while (0)

struct XcdBarrier {
    unsigned* bar; unsigned x;
    volatile LAS unsigned* st;
};

__device__ __forceinline__ XcdBarrier xcd_barrier_post(unsigned* bar, volatile LAS unsigned* st) {
    XcdBarrier b; b.bar = bar; b.x = xb_xcc_id(); b.st = st;
    if (opaque_tid() == 0) (void)xb_add(&bar[XB_XCNT(b.x)], 1u);
    return b;
}
__device__ __forceinline__ void xcd_barrier_complete(unsigned* bar, unsigned x, unsigned& nloc, unsigned& nx) {
    const unsigned G = gridDim.x * gridDim.y * gridDim.z;
    unsigned sum, cnt, mine, sp = 0u;
    for (;;) {
        sum = 0u; cnt = 0u; mine = 0u;
#pragma unroll
        for (unsigned j = 0; j < 16; ++j) { const unsigned c = xb_ld(&bar[XB_XCNT(j)]); sum += c; cnt += (c > 0u) ? 1u : 0u; mine = (j == x) ? c : mine; }
        if (sum == G) break;
        __builtin_amdgcn_s_sleep(1);
        if ((++sp & 255u) == 0u) { if (xb_ld(&bar[XB_TMO])) break; if (sp > XB_SPIN_CAP) { atomicAdd(&bar[XB_TMO], 1u); break; } }
    }
    nloc = mine > 0u ? mine : 1u; nx = cnt > 0u ? cnt : 1u;
}

__device__ __forceinline__ void xcd_barrier(const XcdBarrier& b) {
    asm volatile("s_waitcnt vmcnt(0)" ::: "memory");
    __syncthreads();
    if (opaque_tid() == 0) {
        unsigned* bar = b.bar;
        __builtin_amdgcn_s_waitcnt(0);
        unsigned nloc = b.st[0], nx = b.st[1];
        if (nloc == 0u) { xcd_barrier_complete(bar, b.x, nloc, nx); b.st[0] = nloc; b.st[1] = nx; }
        const unsigned old = xb_add(&bar[XB_XSUB(b.x)], 1u);
        const unsigned gen = old / nloc;
        if (old + 1u == (gen + 1u) * nloc) {
            __builtin_amdgcn_fence(__ATOMIC_RELEASE, "agent");
            asm volatile("s_waitcnt vmcnt(0)" ::: "memory");
            const unsigned og = xb_add(&bar[XB_TOP], 1u);
            const unsigned tg = og / nx;
            if (og + 1u == (tg + 1u) * nx) xb_add(&bar[XB_TOPGEN], 1u);
            else XB_SPIN(xb_ld(&bar[XB_TOPGEN]) == tg, bar);
            __builtin_amdgcn_fence(__ATOMIC_ACQUIRE, "agent");
            xb_add(&bar[XB_XGEN(b.x)], 1u);
            asm volatile("s_waitcnt vmcnt(0)" ::: "memory");
        } else {
            XB_SPIN(xb_ld(&bar[XB_XGEN(b.x)]) == gen, bar);
            __builtin_amdgcn_fence(__ATOMIC_ACQUIRE, "agent");
            asm volatile("s_waitcnt vmcnt(0)" ::: "memory");
        }
    }
    __syncthreads();
}
#ifndef PROBE_DUP
#define PROBE_DUP 0
#endif
#define DUP(bit, ...) do { __VA_ARGS__; if (PROBE_DUP & (bit)) { __VA_ARGS__; } } while (0)
#ifndef MK_PER_PHASE
#define MK_PER_PHASE 0
#endif
constexpr int N_PHASES = 2 + 12 * DEPTH;
struct Args { const float* in[23]; float* out; unsigned char* ws; int ph_lo, ph_hi; };
__device__ __forceinline__ void moe_table(LAS int* tab, const int* COUNTS, int NT, int G, int c, const int* RSLOT, LAS unsigned short* gath) {
    __syncthreads();
    const int tid = opaque_tid();
    if (tid < NEXP) tab[160 + tid] = COUNTS[tid];
    __syncthreads();
    if (tid == 0) { int a = 0, row = 0; for (int e = 0; e < NEXP; ++e) { const int mt = (tab[160 + e] + 255) >> 8; tab[e] = a; tab[64 + e] = row; tab[128 + e] = mt; a += mt * NT; row += mt; } tab[32] = a; }
    __syncthreads();
    if (tid < 14) { const int nwg = tab[32]; const long L = (long)tid * G + c;
        if (L < nwg) { int w = (int)L; { const int q = nwg / 8, r = nwg % 8, xcd = w % 8, off = w / 8; w = (xcd < r ? xcd * (q + 1) : r * (q + 1) + (xcd - r) * q) + off; }
            int e = 0; for (int k = 1; k < 32; ++k) e += (w >= tab[k]) ? 1 : 0;
            const int local = w - tab[e], mt = tab[128 + e]; tab[194 + 2 * tid] = tab[64 + e] + local % mt; tab[195 + 2 * tid] = e * NT + local / mt; }
        if (tid == 0) { const int mine = nwg > c ? (nwg - c + G - 1) / G : 0; tab[192] = mine < 14 ? mine : 14; } }
    __syncthreads();
    if (gath) {
        const int mine = tab[192];
        int sl[7]; const int lim = mine * 256;
        if (mine > 0) {
#pragma unroll
        for (int ps = 0; ps < 7; ++ps) { const int idx = tid + 512 * ps, ic = idx < lim ? idx : 0, i = ic >> 8, r = ic & 255, pm = tab[194 + 2 * i], e = tab[195 + 2 * i] / NT, rl = (pm - tab[64 + e]) * 256 + r, cnt = tab[160 + e];
            const int rlc = rl < cnt ? rl : 0; const int v = RSLOT[e * EREG + rlc]; sl[ps] = rl < cnt ? (v >> 2) : 0; }
#pragma unroll
        for (int ps = 0; ps < 7; ++ps) { const int idx = tid + 512 * ps; if (idx < lim) gath[idx] = (unsigned short)sl[ps]; } }
        __syncthreads(); }
}
typedef __attribute__((address_space(1))) unsigned char* gptr_t;
__device__ __forceinline__ unsigned char* opq(unsigned char* p) { gptr_t g = (gptr_t)p; asm volatile("" : "+s"(g)); return (unsigned char*)g; }
__global__ void __launch_bounds__(512, 2) mega(Args a) {
    extern __shared__ __attribute__((aligned(16))) unsigned char lds_raw[];
    LAS unsigned char* L = (LAS unsigned char*)lds_raw;
    const int G = (int)gridDim.x, c0 = (int)blockIdx.x;
    const int lo = a.ph_lo, hi = a.ph_hi;
#define WSP(type, off) ((type*)(opq(a.ws) + (off)))
#define GW (c0 * 8 + __builtin_amdgcn_readfirstlane(opaque_tid() >> 6))
#define NGW (G * 8)
    { const int tid = opaque_tid(); if (tid < 4) ((LAS unsigned*)(L + LDS_CTL_OFF + 1024))[tid] = 0u; }
    __syncthreads();
    XcdBarrier bar = xcd_barrier_post(WSP(unsigned, WS_CTL) + CW_BAR, (volatile LAS unsigned*)(L + LDS_CTL_OFF + 1024));
#define IN(k) (lo <= (k) && (k) < hi)
#define SEAM(k) do { if ((k) + 1 < hi) { XcdBarrier b2_ = bar; b2_.bar = (unsigned*)opq((unsigned char*)bar.bar); xcd_barrier(b2_); if (PROBE_DUP & 8192) { XcdBarrier b3_ = bar; b3_.bar = (unsigned*)opq((unsigned char*)bar.bar); xcd_barrier(b3_); } } } while (0)
    if (IN(0)) {
        DUP(1, {
        phase_rope(WSP(float, WS_COS), WSP(float, WS_SIN), c0 * 512 + opaque_tid(), G * 512);
        phase_mod(L, a.in[1], a.in[2], a.in[3], WSP(float, WS_MOD), c0, G);
        __syncthreads();
        convert_job<1024, 4096, 1, 2, 0, false, 0, 32>(L, a.in[6], WSP(bf16, WS_WEVIN), GW, NGW);
        convert_job<1024, 4096, 1, 2, 512, true, 32, 96>(L, a.in[6], WSP(bf16, WS_WEVIN8), GW, NGW);
        convert_job<1536, 1024, 0, 2, CVT_T0, true>(L, a.in[7], WSP(bf16, WS_WEVOUT), GW, NGW);
        convert_job<1024, 3072, 2, 2, CVT_T0 + CVT_T1, true>(L, a.in[12], WSP(bf16, WS_WODIN), GW, NGW);
        convert_job<1024, 1024, 0, 2, CVT_T0 + CVT_T1 + CVT_T2, true>(L, a.in[13], WSP(bf16, WS_WODOUT), GW, NGW);
        convert_job<1024, 2048, 3, 128, CVT_T0 + CVT_T1 + CVT_T2 + CVT_T3, true>(L, a.in[19], WSP(bf16, WS_W1), GW, NGW);
        convert_job<1024, 1024, 0, 128, CVT_T0 + CVT_T1 + CVT_T2 + CVT_T3 + CVT_T4, true>(L, a.in[21], WSP(bf16, WS_W2), GW, NGW);
        });
        SEAM(0);
    }
    {
        constexpr int l = 0;
        const int pb = 1 + 12 * l, i = l >> 1; const bool odd = (l & 1) != 0;
#define MODL (WSP(float, WS_MOD) + (size_t)l * 8 * 6144)
#define COUNTSL (WSP(int, WS_CTL) + CW_COUNTS + 64 * l)
        if (IN(pb + 0)) { if (l == 0) phase_norm1<true, false>(a.in[0], WSP(bf16, WS_XB), true, WSP(bf16, WS_YS), MODL, false, a.in[4] + l * DM, MODL, WSP(bf16, WS_H), true, GW, NGW, odd, odd ? nullptr : WSP(unsigned char, WS_H8)); else phase_norm1<false, false>(WSP(bf16, WS_XB), WSP(bf16, WS_XB), true, WSP(bf16, WS_YS), MODL - 8 * 6144, true, a.in[4] + l * DM, MODL, WSP(bf16, WS_H), true, GW, NGW, odd, odd ? nullptr : WSP(unsigned char, WS_H8)); SEAM(pb + 0); }
        if (IN(pb + 1)) {
            if (!odd) {
                { pg8::Gemm g{WSP(bf16, WS_H), WSP(bf16, WS_WEVIN) + (size_t)i * EVEN_IN * DM, T_TOK, 1024, DM, 0}; pg8::StaticOrder S; S.init(T_TOK, 1024, G, c0);
                  DUP(2, pg8::gemm_phase<EpiEvenIn, pg8::StaticOrder, true, true>(L, g, S, EpiEvenIn{WSP(bf16, WS_PROJ), WSP(float, WS_COS), WSP(float, WS_SIN), 0, 1.0f})); }
                { pg8::Gemm g{WSP(bf16, WS_H8), WSP(bf16, WS_WEVIN8) + ((size_t)i * EVEN_IN + 1024) * (DM / 2), T_TOK, 3072, DM / 2, 0}; pg8::StaticOrder S; S.init(T_TOK, 3072, G, c0);
                  DUP(2, pg8::gemm_phase<EpiEvenIn, pg8::StaticOrder, true, true, true>(L, g, S, EpiEvenIn{WSP(bf16, WS_PROJ), WSP(float, WS_COS), WSP(float, WS_SIN), 4, WSCALE_INV})); } }
            else { pg8::Gemm g{WSP(bf16, WS_H), WSP(bf16, WS_WODIN) + (size_t)i * 3072 * (DM / 2), T_TOK, 3072, DM / 2, 0}; pg8::StaticOrder S; S.init(T_TOK, 3072, G, c0);
                DUP(2, pg8::gemm_phase<EpiOddIn, pg8::StaticOrder, true, true, true>(L, g, S, EpiOddIn{WSP(bf16, WS_PROJ), a.in[14] + i * 64, a.in[15] + i * 64})); }
            SEAM(pb + 1); }
        if (!odd) {
            if (IN(pb + 2)) { DUP(4, phase_e1(L, WSP(bf16, WS_PROJ), WSP(bf16, WS_KV), a.in[8] + i * 512, a.in[9] + i * 512, a.in[10] + (size_t)i * 4 * 128 * 128, a.in[11] + i * 512, WSP(bf16, WS_MIX), c0, G, 0, 1280)); SEAM(pb + 2); }
            if (IN(pb + 3)) { DUP(256, phase_e2(WSP(bf16, WS_KV), WSP(bf16, WS_ST), c0 * 512 + opaque_tid(), G * 512)); SEAM(pb + 3); }
            if (IN(pb + 4)) { DUP(512, phase_e3(L, WSP(bf16, WS_PROJ), WSP(bf16, WS_ST), WSP(bf16, WS_MIX), c0, G)); SEAM(pb + 4); }
        } else {
            if (IN(pb + 2)) { DUP(128, phase_attn(L, WSP(bf16, WS_PROJ), a.in[16] + (size_t)i * 16 * 320, a.in[14] + i * 64, a.in[15] + i * 64, WSP(bf16, WS_MIX), c0, G)); SEAM(pb + 2); }
        }
        if (IN(pb + 5)) { pg8::StaticOrder S; S.init(T_TOK, DM, G, c0);
            if (odd) { pg8::Gemm g{WSP(bf16, WS_MIX), WSP(bf16, WS_WODOUT) + (size_t)i * DM * (DM / 2), T_TOK, DM, DM / 2, 0}; pg8::gemm_phase<EpiResid, pg8::StaticOrder, true, true, true>(L, g, S, EpiResid{WSP(bf16, WS_XB), MODL, 2048, WSCALE_INV}); }
            else { pg8::Gemm g{WSP(bf16, WS_MIX), WSP(bf16, WS_WEVOUT) + (size_t)i * DM * (EVEN_MIX / 2), T_TOK, DM, EVEN_MIX / 2, 0};
            pg8::gemm_phase<EpiResid, pg8::StaticOrder, true, true, true>(L, g, S, EpiResid{WSP(bf16, WS_XB), MODL, 2048, WSCALE_INV}); } SEAM(pb + 5); }
        if (IN(pb + 6)) { phase_router(L, WSP(bf16, WS_XB), a.in[5] + l * DM, MODL, a.in[17] + (size_t)l * DM * NEXP, a.in[18] + l * NEXP, WSP(bf16, WS_H), WSP(int, WS_RSLOT), WSP(float, WS_RGATE), COUNTSL, c0, G); if (PROBE_DUP & 2048) phase_router(L, WSP(bf16, WS_XB), a.in[5] + l * DM, MODL, a.in[17] + (size_t)l * DM * NEXP, a.in[18] + l * NEXP, WSP(bf16, 920 * MiB), WSP(int, 940 * MiB), WSP(float, 944 * MiB), WSP(int, 948 * MiB), c0, G); SEAM(pb + 6); }
        if (IN(pb + 8)) { LAS int* tab = (LAS int*)(L + LDS_CTL_OFF); LAS unsigned short* gath = (LAS unsigned short*)(L + 131072); moe_table(tab, COUNTSL, 8, G, c0, WSP(int, WS_RSLOT), gath);
            pg8::Gemm g{WSP(bf16, WS_H), WSP(bf16, WS_W1) + (size_t)l * NEXP * 2048 * (DM / 2), CAP, 2048, DM / 2, 0, gath};
            pg8::MoeOrder S; S.tab = tab;
            DUP(16, pg8::gemm_phase<EpiMoe1, pg8::MoeOrder, true, true, true, true>(L, g, S, EpiMoe1{WSP(bf16, WS_ACT), a.in[20] + (size_t)l * NEXP * 2048})); SEAM(pb + 8); }
        if (IN(pb + 9)) { LAS int* tab = (LAS int*)(L + LDS_CTL_OFF); moe_table(tab, COUNTSL, 4, G, c0, nullptr, nullptr); pg8::Gemm g{WSP(bf16, WS_ACT), WSP(bf16, WS_W2) + (size_t)l * NEXP * DM * (DFF / 2), CAP, DM, DFF / 2, 0};
            pg8::MoeOrder S; S.tab = tab;
            DUP(32, pg8::gemm_phase<EpiMoe2, pg8::MoeOrder, true, true, true>(L, g, S, EpiMoe2{WSP(bf16, WS_YS), a.in[22] + (size_t)l * NEXP * DM, WSP(int, WS_RSLOT), WSP(float, WS_RGATE), tab})); SEAM(pb + 9); }
        }
    {
        constexpr int l = 1;
        const int pb = 1 + 12 * l, i = l >> 1; const bool odd = (l & 1) != 0;
#define MODL (WSP(float, WS_MOD) + (size_t)l * 8 * 6144)
#define COUNTSL (WSP(int, WS_CTL) + CW_COUNTS + 64 * l)
        if (IN(pb + 0)) { if (l == 0) phase_norm1<true, false>(a.in[0], WSP(bf16, WS_XB), true, WSP(bf16, WS_YS), MODL, false, a.in[4] + l * DM, MODL, WSP(bf16, WS_H), true, GW, NGW, odd, odd ? nullptr : WSP(unsigned char, WS_H8)); else phase_norm1<false, false>(WSP(bf16, WS_XB), WSP(bf16, WS_XB), true, WSP(bf16, WS_YS), MODL - 8 * 6144, true, a.in[4] + l * DM, MODL, WSP(bf16, WS_H), true, GW, NGW, odd, odd ? nullptr : WSP(unsigned char, WS_H8)); SEAM(pb + 0); }
        if (IN(pb + 1)) {
            if (!odd) {
                { pg8::Gemm g{WSP(bf16, WS_H), WSP(bf16, WS_WEVIN) + (size_t)i * EVEN_IN * DM, T_TOK, 1024, DM, 0}; pg8::StaticOrder S; S.init(T_TOK, 1024, G, c0);
                  DUP(2, pg8::gemm_phase<EpiEvenIn, pg8::StaticOrder, true, true>(L, g, S, EpiEvenIn{WSP(bf16, WS_PROJ), WSP(float, WS_COS), WSP(float, WS_SIN), 0, 1.0f})); }
                { pg8::Gemm g{WSP(bf16, WS_H8), WSP(bf16, WS_WEVIN8) + ((size_t)i * EVEN_IN + 1024) * (DM / 2), T_TOK, 3072, DM / 2, 0}; pg8::StaticOrder S; S.init(T_TOK, 3072, G, c0);
                  DUP(2, pg8::gemm_phase<EpiEvenIn, pg8::StaticOrder, true, true, true>(L, g, S, EpiEvenIn{WSP(bf16, WS_PROJ), WSP(float, WS_COS), WSP(float, WS_SIN), 4, WSCALE_INV})); } }
            else { pg8::Gemm g{WSP(bf16, WS_H), WSP(bf16, WS_WODIN) + (size_t)i * 3072 * (DM / 2), T_TOK, 3072, DM / 2, 0}; pg8::StaticOrder S; S.init(T_TOK, 3072, G, c0);
                DUP(2, pg8::gemm_phase<EpiOddIn, pg8::StaticOrder, true, true, true>(L, g, S, EpiOddIn{WSP(bf16, WS_PROJ), a.in[14] + i * 64, a.in[15] + i * 64})); }
            SEAM(pb + 1); }
        if (!odd) {
            if (IN(pb + 2)) { DUP(4, phase_e1(L, WSP(bf16, WS_PROJ), WSP(bf16, WS_KV), a.in[8] + i * 512, a.in[9] + i * 512, a.in[10] + (size_t)i * 4 * 128 * 128, a.in[11] + i * 512, WSP(bf16, WS_MIX), c0, G, 0, 1280)); SEAM(pb + 2); }
            if (IN(pb + 3)) { DUP(256, phase_e2(WSP(bf16, WS_KV), WSP(bf16, WS_ST), c0 * 512 + opaque_tid(), G * 512)); SEAM(pb + 3); }
            if (IN(pb + 4)) { DUP(512, phase_e3(L, WSP(bf16, WS_PROJ), WSP(bf16, WS_ST), WSP(bf16, WS_MIX), c0, G)); SEAM(pb + 4); }
        } else {
            if (IN(pb + 2)) { DUP(128, phase_attn(L, WSP(bf16, WS_PROJ), a.in[16] + (size_t)i * 16 * 320, a.in[14] + i * 64, a.in[15] + i * 64, WSP(bf16, WS_MIX), c0, G)); SEAM(pb + 2); }
        }
        if (IN(pb + 5)) { pg8::StaticOrder S; S.init(T_TOK, DM, G, c0);
            if (odd) { pg8::Gemm g{WSP(bf16, WS_MIX), WSP(bf16, WS_WODOUT) + (size_t)i * DM * (DM / 2), T_TOK, DM, DM / 2, 0}; pg8::gemm_phase<EpiResid, pg8::StaticOrder, true, true, true>(L, g, S, EpiResid{WSP(bf16, WS_XB), MODL, 2048, WSCALE_INV}); }
            else { pg8::Gemm g{WSP(bf16, WS_MIX), WSP(bf16, WS_WEVOUT) + (size_t)i * DM * (EVEN_MIX / 2), T_TOK, DM, EVEN_MIX / 2, 0};
            pg8::gemm_phase<EpiResid, pg8::StaticOrder, true, true, true>(L, g, S, EpiResid{WSP(bf16, WS_XB), MODL, 2048, WSCALE_INV}); } SEAM(pb + 5); }
        if (IN(pb + 6)) { phase_router(L, WSP(bf16, WS_XB), a.in[5] + l * DM, MODL, a.in[17] + (size_t)l * DM * NEXP, a.in[18] + l * NEXP, WSP(bf16, WS_H), WSP(int, WS_RSLOT), WSP(float, WS_RGATE), COUNTSL, c0, G); if (PROBE_DUP & 2048) phase_router(L, WSP(bf16, WS_XB), a.in[5] + l * DM, MODL, a.in[17] + (size_t)l * DM * NEXP, a.in[18] + l * NEXP, WSP(bf16, 920 * MiB), WSP(int, 940 * MiB), WSP(float, 944 * MiB), WSP(int, 948 * MiB), c0, G); SEAM(pb + 6); }
        if (IN(pb + 8)) { LAS int* tab = (LAS int*)(L + LDS_CTL_OFF); LAS unsigned short* gath = (LAS unsigned short*)(L + 131072); moe_table(tab, COUNTSL, 8, G, c0, WSP(int, WS_RSLOT), gath);
            pg8::Gemm g{WSP(bf16, WS_H), WSP(bf16, WS_W1) + (size_t)l * NEXP * 2048 * (DM / 2), CAP, 2048, DM / 2, 0, gath};
            pg8::MoeOrder S; S.tab = tab;
            DUP(16, pg8::gemm_phase<EpiMoe1, pg8::MoeOrder, true, true, true, true>(L, g, S, EpiMoe1{WSP(bf16, WS_ACT), a.in[20] + (size_t)l * NEXP * 2048})); SEAM(pb + 8); }
        if (IN(pb + 9)) { LAS int* tab = (LAS int*)(L + LDS_CTL_OFF); moe_table(tab, COUNTSL, 4, G, c0, nullptr, nullptr); pg8::Gemm g{WSP(bf16, WS_ACT), WSP(bf16, WS_W2) + (size_t)l * NEXP * DM * (DFF / 2), CAP, DM, DFF / 2, 0};
            pg8::MoeOrder S; S.tab = tab;
            DUP(32, pg8::gemm_phase<EpiMoe2, pg8::MoeOrder, true, true, true>(L, g, S, EpiMoe2{WSP(bf16, WS_YS), a.in[22] + (size_t)l * NEXP * DM, WSP(int, WS_RSLOT), WSP(float, WS_RGATE), tab})); SEAM(pb + 9); }
        }
    {
        constexpr int l = 2;
        const int pb = 1 + 12 * l, i = l >> 1; const bool odd = (l & 1) != 0;
#define MODL (WSP(float, WS_MOD) + (size_t)l * 8 * 6144)
#define COUNTSL (WSP(int, WS_CTL) + CW_COUNTS + 64 * l)
        if (IN(pb + 0)) { if (l == 0) phase_norm1<true, false>(a.in[0], WSP(bf16, WS_XB), true, WSP(bf16, WS_YS), MODL, false, a.in[4] + l * DM, MODL, WSP(bf16, WS_H), true, GW, NGW, odd, odd ? nullptr : WSP(unsigned char, WS_H8)); else phase_norm1<false, false>(WSP(bf16, WS_XB), WSP(bf16, WS_XB), true, WSP(bf16, WS_YS), MODL - 8 * 6144, true, a.in[4] + l * DM, MODL, WSP(bf16, WS_H), true, GW, NGW, odd, odd ? nullptr : WSP(unsigned char, WS_H8)); SEAM(pb + 0); }
        if (IN(pb + 1)) {
            if (!odd) {
                { pg8::Gemm g{WSP(bf16, WS_H), WSP(bf16, WS_WEVIN) + (size_t)i * EVEN_IN * DM, T_TOK, 1024, DM, 0}; pg8::StaticOrder S; S.init(T_TOK, 1024, G, c0);
                  DUP(2, pg8::gemm_phase<EpiEvenIn, pg8::StaticOrder, true, true>(L, g, S, EpiEvenIn{WSP(bf16, WS_PROJ), WSP(float, WS_COS), WSP(float, WS_SIN), 0, 1.0f})); }
                { pg8::Gemm g{WSP(bf16, WS_H8), WSP(bf16, WS_WEVIN8) + ((size_t)i * EVEN_IN + 1024) * (DM / 2), T_TOK, 3072, DM / 2, 0}; pg8::StaticOrder S; S.init(T_TOK, 3072, G, c0);
                  DUP(2, pg8::gemm_phase<EpiEvenIn, pg8::StaticOrder, true, true, true>(L, g, S, EpiEvenIn{WSP(bf16, WS_PROJ), WSP(float, WS_COS), WSP(float, WS_SIN), 4, WSCALE_INV})); } }
            else { pg8::Gemm g{WSP(bf16, WS_H), WSP(bf16, WS_WODIN) + (size_t)i * 3072 * (DM / 2), T_TOK, 3072, DM / 2, 0}; pg8::StaticOrder S; S.init(T_TOK, 3072, G, c0);
                DUP(2, pg8::gemm_phase<EpiOddIn, pg8::StaticOrder, true, true, true>(L, g, S, EpiOddIn{WSP(bf16, WS_PROJ), a.in[14] + i * 64, a.in[15] + i * 64})); }
            SEAM(pb + 1); }
        if (!odd) {
            if (IN(pb + 2)) { DUP(4, phase_e1(L, WSP(bf16, WS_PROJ), WSP(bf16, WS_KV), a.in[8] + i * 512, a.in[9] + i * 512, a.in[10] + (size_t)i * 4 * 128 * 128, a.in[11] + i * 512, WSP(bf16, WS_MIX), c0, G, 0, 1280)); SEAM(pb + 2); }
            if (IN(pb + 3)) { DUP(256, phase_e2(WSP(bf16, WS_KV), WSP(bf16, WS_ST), c0 * 512 + opaque_tid(), G * 512)); SEAM(pb + 3); }
            if (IN(pb + 4)) { DUP(512, phase_e3(L, WSP(bf16, WS_PROJ), WSP(bf16, WS_ST), WSP(bf16, WS_MIX), c0, G)); SEAM(pb + 4); }
        } else {
            if (IN(pb + 2)) { DUP(128, phase_attn(L, WSP(bf16, WS_PROJ), a.in[16] + (size_t)i * 16 * 320, a.in[14] + i * 64, a.in[15] + i * 64, WSP(bf16, WS_MIX), c0, G)); SEAM(pb + 2); }
        }
        if (IN(pb + 5)) { pg8::StaticOrder S; S.init(T_TOK, DM, G, c0);
            if (odd) { pg8::Gemm g{WSP(bf16, WS_MIX), WSP(bf16, WS_WODOUT) + (size_t)i * DM * (DM / 2), T_TOK, DM, DM / 2, 0}; pg8::gemm_phase<EpiResid, pg8::StaticOrder, true, true, true>(L, g, S, EpiResid{WSP(bf16, WS_XB), MODL, 2048, WSCALE_INV}); }
            else { pg8::Gemm g{WSP(bf16, WS_MIX), WSP(bf16, WS_WEVOUT) + (size_t)i * DM * (EVEN_MIX / 2), T_TOK, DM, EVEN_MIX / 2, 0};
            pg8::gemm_phase<EpiResid, pg8::StaticOrder, true, true, true>(L, g, S, EpiResid{WSP(bf16, WS_XB), MODL, 2048, WSCALE_INV}); } SEAM(pb + 5); }
        if (IN(pb + 6)) { phase_router(L, WSP(bf16, WS_XB), a.in[5] + l * DM, MODL, a.in[17] + (size_t)l * DM * NEXP, a.in[18] + l * NEXP, WSP(bf16, WS_H), WSP(int, WS_RSLOT), WSP(float, WS_RGATE), COUNTSL, c0, G); if (PROBE_DUP & 2048) phase_router(L, WSP(bf16, WS_XB), a.in[5] + l * DM, MODL, a.in[17] + (size_t)l * DM * NEXP, a.in[18] + l * NEXP, WSP(bf16, 920 * MiB), WSP(int, 940 * MiB), WSP(float, 944 * MiB), WSP(int, 948 * MiB), c0, G); SEAM(pb + 6); }
        if (IN(pb + 8)) { LAS int* tab = (LAS int*)(L + LDS_CTL_OFF); LAS unsigned short* gath = (LAS unsigned short*)(L + 131072); moe_table(tab, COUNTSL, 8, G, c0, WSP(int, WS_RSLOT), gath);
            pg8::Gemm g{WSP(bf16, WS_H), WSP(bf16, WS_W1) + (size_t)l * NEXP * 2048 * (DM / 2), CAP, 2048, DM / 2, 0, gath};
            pg8::MoeOrder S; S.tab = tab;
            DUP(16, pg8::gemm_phase<EpiMoe1, pg8::MoeOrder, true, true, true, true>(L, g, S, EpiMoe1{WSP(bf16, WS_ACT), a.in[20] + (size_t)l * NEXP * 2048})); SEAM(pb + 8); }
        if (IN(pb + 9)) { LAS int* tab = (LAS int*)(L + LDS_CTL_OFF); moe_table(tab, COUNTSL, 4, G, c0, nullptr, nullptr); pg8::Gemm g{WSP(bf16, WS_ACT), WSP(bf16, WS_W2) + (size_t)l * NEXP * DM * (DFF / 2), CAP, DM, DFF / 2, 0};
            pg8::MoeOrder S; S.tab = tab;
            DUP(32, pg8::gemm_phase<EpiMoe2, pg8::MoeOrder, true, true, true>(L, g, S, EpiMoe2{WSP(bf16, WS_YS), a.in[22] + (size_t)l * NEXP * DM, WSP(int, WS_RSLOT), WSP(float, WS_RGATE), tab})); SEAM(pb + 9); }
        }
    {
        constexpr int l = 3;
        const int pb = 1 + 12 * l, i = l >> 1; const bool odd = (l & 1) != 0;
#define MODL (WSP(float, WS_MOD) + (size_t)l * 8 * 6144)
#define COUNTSL (WSP(int, WS_CTL) + CW_COUNTS + 64 * l)
        if (IN(pb + 0)) { if (l == 0) phase_norm1<true, false>(a.in[0], WSP(bf16, WS_XB), true, WSP(bf16, WS_YS), MODL, false, a.in[4] + l * DM, MODL, WSP(bf16, WS_H), true, GW, NGW, odd, odd ? nullptr : WSP(unsigned char, WS_H8)); else phase_norm1<false, false>(WSP(bf16, WS_XB), WSP(bf16, WS_XB), true, WSP(bf16, WS_YS), MODL - 8 * 6144, true, a.in[4] + l * DM, MODL, WSP(bf16, WS_H), true, GW, NGW, odd, odd ? nullptr : WSP(unsigned char, WS_H8)); SEAM(pb + 0); }
        if (IN(pb + 1)) {
            if (!odd) {
                { pg8::Gemm g{WSP(bf16, WS_H), WSP(bf16, WS_WEVIN) + (size_t)i * EVEN_IN * DM, T_TOK, 1024, DM, 0}; pg8::StaticOrder S; S.init(T_TOK, 1024, G, c0);
                  DUP(2, pg8::gemm_phase<EpiEvenIn, pg8::StaticOrder, true, true>(L, g, S, EpiEvenIn{WSP(bf16, WS_PROJ), WSP(float, WS_COS), WSP(float, WS_SIN), 0, 1.0f})); }
                { pg8::Gemm g{WSP(bf16, WS_H8), WSP(bf16, WS_WEVIN8) + ((size_t)i * EVEN_IN + 1024) * (DM / 2), T_TOK, 3072, DM / 2, 0}; pg8::StaticOrder S; S.init(T_TOK, 3072, G, c0);
                  DUP(2, pg8::gemm_phase<EpiEvenIn, pg8::StaticOrder, true, true, true>(L, g, S, EpiEvenIn{WSP(bf16, WS_PROJ), WSP(float, WS_COS), WSP(float, WS_SIN), 4, WSCALE_INV})); } }
            else { pg8::Gemm g{WSP(bf16, WS_H), WSP(bf16, WS_WODIN) + (size_t)i * 3072 * (DM / 2), T_TOK, 3072, DM / 2, 0}; pg8::StaticOrder S; S.init(T_TOK, 3072, G, c0);
                DUP(2, pg8::gemm_phase<EpiOddIn, pg8::StaticOrder, true, true, true>(L, g, S, EpiOddIn{WSP(bf16, WS_PROJ), a.in[14] + i * 64, a.in[15] + i * 64})); }
            SEAM(pb + 1); }
        if (!odd) {
            if (IN(pb + 2)) { DUP(4, phase_e1(L, WSP(bf16, WS_PROJ), WSP(bf16, WS_KV), a.in[8] + i * 512, a.in[9] + i * 512, a.in[10] + (size_t)i * 4 * 128 * 128, a.in[11] + i * 512, WSP(bf16, WS_MIX), c0, G, 0, 1280)); SEAM(pb + 2); }
            if (IN(pb + 3)) { DUP(256, phase_e2(WSP(bf16, WS_KV), WSP(bf16, WS_ST), c0 * 512 + opaque_tid(), G * 512)); SEAM(pb + 3); }
            if (IN(pb + 4)) { DUP(512, phase_e3(L, WSP(bf16, WS_PROJ), WSP(bf16, WS_ST), WSP(bf16, WS_MIX), c0, G)); SEAM(pb + 4); }
        } else {
            if (IN(pb + 2)) { DUP(128, phase_attn(L, WSP(bf16, WS_PROJ), a.in[16] + (size_t)i * 16 * 320, a.in[14] + i * 64, a.in[15] + i * 64, WSP(bf16, WS_MIX), c0, G)); SEAM(pb + 2); }
        }
        if (IN(pb + 5)) { pg8::StaticOrder S; S.init(T_TOK, DM, G, c0);
            if (odd) { pg8::Gemm g{WSP(bf16, WS_MIX), WSP(bf16, WS_WODOUT) + (size_t)i * DM * (DM / 2), T_TOK, DM, DM / 2, 0}; pg8::gemm_phase<EpiResid, pg8::StaticOrder, true, true, true>(L, g, S, EpiResid{WSP(bf16, WS_XB), MODL, 2048, WSCALE_INV}); }
            else { pg8::Gemm g{WSP(bf16, WS_MIX), WSP(bf16, WS_WEVOUT) + (size_t)i * DM * (EVEN_MIX / 2), T_TOK, DM, EVEN_MIX / 2, 0};
            pg8::gemm_phase<EpiResid, pg8::StaticOrder, true, true, true>(L, g, S, EpiResid{WSP(bf16, WS_XB), MODL, 2048, WSCALE_INV}); } SEAM(pb + 5); }
        if (IN(pb + 6)) { phase_router(L, WSP(bf16, WS_XB), a.in[5] + l * DM, MODL, a.in[17] + (size_t)l * DM * NEXP, a.in[18] + l * NEXP, WSP(bf16, WS_H), WSP(int, WS_RSLOT), WSP(float, WS_RGATE), COUNTSL, c0, G); if (PROBE_DUP & 2048) phase_router(L, WSP(bf16, WS_XB), a.in[5] + l * DM, MODL, a.in[17] + (size_t)l * DM * NEXP, a.in[18] + l * NEXP, WSP(bf16, 920 * MiB), WSP(int, 940 * MiB), WSP(float, 944 * MiB), WSP(int, 948 * MiB), c0, G); SEAM(pb + 6); }
        if (IN(pb + 8)) { LAS int* tab = (LAS int*)(L + LDS_CTL_OFF); LAS unsigned short* gath = (LAS unsigned short*)(L + 131072); moe_table(tab, COUNTSL, 8, G, c0, WSP(int, WS_RSLOT), gath);
            pg8::Gemm g{WSP(bf16, WS_H), WSP(bf16, WS_W1) + (size_t)l * NEXP * 2048 * (DM / 2), CAP, 2048, DM / 2, 0, gath};
            pg8::MoeOrder S; S.tab = tab;
            DUP(16, pg8::gemm_phase<EpiMoe1, pg8::MoeOrder, true, true, true, true>(L, g, S, EpiMoe1{WSP(bf16, WS_ACT), a.in[20] + (size_t)l * NEXP * 2048})); SEAM(pb + 8); }
        if (IN(pb + 9)) { LAS int* tab = (LAS int*)(L + LDS_CTL_OFF); moe_table(tab, COUNTSL, 4, G, c0, nullptr, nullptr); pg8::Gemm g{WSP(bf16, WS_ACT), WSP(bf16, WS_W2) + (size_t)l * NEXP * DM * (DFF / 2), CAP, DM, DFF / 2, 0};
            pg8::MoeOrder S; S.tab = tab;
            DUP(32, pg8::gemm_phase<EpiMoe2, pg8::MoeOrder, true, true, true>(L, g, S, EpiMoe2{WSP(bf16, WS_YS), a.in[22] + (size_t)l * NEXP * DM, WSP(int, WS_RSLOT), WSP(float, WS_RGATE), tab})); SEAM(pb + 9); }
        }
    if (IN(N_PHASES - 1)) phase_norm1<false, true>(WSP(bf16, WS_XB), a.out, true, WSP(bf16, WS_YS), WSP(float, WS_MOD) + (size_t)(DEPTH - 1) * 8 * 6144, true, nullptr, nullptr, nullptr, false, GW, NGW);
#undef IN
#undef SEAM
}
extern "C" void kernel_launch(void* const* d_in, const int* in_sizes, int n_in, void* d_out, int out_size, void* d_ws, size_t ws_size, hipStream_t stream) {
    (void)in_sizes; (void)out_size; (void)ws_size;
    static int grid = 0;
    if (!grid) {
        (void)hipFuncSetAttribute((const void*)mega, hipFuncAttributeMaxDynamicSharedMemorySize, LDS_BYTES);
        int dev = 0, cus = 0, per_cu = 0; (void)hipGetDevice(&dev); (void)hipDeviceGetAttribute(&cus, hipDeviceAttributeMultiprocessorCount, dev);
        (void)hipOccupancyMaxActiveBlocksPerMultiprocessor(&per_cu, (const void*)mega, 512, LDS_BYTES); (void)hipGetLastError();
        grid = cus > 0 ? cus : 256;
    }
    (void)hipMemsetAsync((unsigned char*)d_ws + WS_CTL, 0, CTL_ZERO_BYTES, stream);
    Args a{};
    for (int i = 0; i < 23 && i < n_in; ++i) a.in[i] = (const float*)d_in[i];
    a.out = (float*)d_out; a.ws = (unsigned char*)d_ws;
#if MK_PER_PHASE
    for (int p = 0; p < N_PHASES; ++p) {
        if (p >= 1 && p < N_PHASES - 1) { const int l = (p - 1) / 12, j = (p - 1) % 12; if (j >= 10) continue; if ((l & 1) && (j == 3 || j == 4)) continue; }
        a.ph_lo = p; a.ph_hi = p + 1; hipLaunchKernelGGL(mega, dim3(grid), dim3(512), LDS_BYTES, stream, a);
    }
#else
    a.ph_lo = 0; a.ph_hi = N_PHASES; hipLaunchKernelGGL(mega, dim3(grid), dim3(512), LDS_BYTES, stream, a);
#endif
}
```
